# Optimizing an MI355X kernel written in HIP

```python
import jax, jax.numpy as jnp
from jax import lax
import numpy as np

D_MODEL = 1024
BATCH = 16
SEQ = 2048
DEPTH = 2
DEC_BATCH = 16
DEC_SEQ = 32
PAST_LEN = 1024

CHUNK = 64
N_PREV_CHUNKS = 8
BAND_PAST = N_PREV_CHUNKS * CHUNK
BAND = BAND_PAST + CHUNK
HEAD_DIM = 64
D_MIX = D_MODEL
D_A = D_MIX // 2
D_B = D_MIX - D_A
N_HEADS_A = D_A // HEAD_DIM
N_HEADS_B = D_B // HEAD_DIM
REL_CLIP = 128
SB_BLOCK = 128
D_PLE = 256
RMS_EPS = 1e-6
D_IN = 4 * D_A + 4 * D_B
ATTN_SCALE = HEAD_DIM ** -0.5
NEG_INF = -1e30
SPLIT_IDX = [int(v) for v in np.cumsum([D_A] * 4 + [D_B] * 4)[:-1]]

kernel_name = "hybrid_band_stickbreaking_stream_step"


def rmsnorm(x, g):
    x32 = x.astype(jnp.float32)
    y = x32 * lax.rsqrt(jnp.mean(x32 * x32, axis=-1, keepdims=True) + RMS_EPS)
    return (y * g.astype(jnp.float32)).astype(x.dtype)


def heads(t, n):
    return t.reshape(t.shape[:-1] + (n, HEAD_DIM))


def in_proj(h, g_pre, w_in):
    u = rmsnorm(h, g_pre) @ w_in
    qa, ka, va, ga, qb, kb, vb, gb = jnp.split(u, SPLIT_IDX, axis=-1)
    return (heads(qa, N_HEADS_A), heads(ka, N_HEADS_A), heads(va, N_HEADS_A), ga,
            heads(qb, N_HEADS_B), heads(kb, N_HEADS_B), heads(vb, N_HEADS_B), gb)


def band_attention(q, k, v, q_pos, k_pos, bias_table):
    s = jnp.einsum('bqhd,bkhd->bhqk', q, k).astype(jnp.float32) * ATTN_SCALE
    rel = jnp.clip(k_pos[None, :] - q_pos[:, None], -REL_CLIP, REL_CLIP) + REL_CLIP
    s = s + bias_table[:, rel].astype(jnp.float32)[None]
    qc = q_pos // CHUNK
    kc = k_pos // CHUNK
    ok = ((k_pos[None, :] >= 0) & (kc[None, :] <= qc[:, None])
          & (kc[None, :] >= qc[:, None] - N_PREV_CHUNKS))
    s = jnp.where(ok[None, None], s, NEG_INF)
    w = jax.nn.softmax(s, axis=-1).astype(v.dtype)
    return jnp.einsum('bhqk,bkhd->bqhd', w, v)


def stick_breaking(q, k, v, q_pos, k_pos):
    z = jnp.einsum('bqhd,bkhd->bhqk', q, k).astype(jnp.float32) * ATTN_SCALE
    causal = (k_pos[None, :] < q_pos[:, None])[None, None]
    log_beta = jax.nn.log_sigmoid(z)
    log_1m = jnp.where(causal, jax.nn.log_sigmoid(-z), 0.0)
    after = lax.cumsum(log_1m, axis=3, reverse=True) - log_1m
    w = jnp.where(causal, jnp.exp(log_beta + after), 0.0).astype(v.dtype)
    return jnp.einsum('bhqk,bkhd->bqhd', w, v)


def mixer_a_prompt(q, k, v, bias_table):
    b, s = q.shape[0], q.shape[1]
    nc = s // CHUNK
    pad = ((0, 0), (BAND_PAST, 0), (0, 0), (0, 0))
    kp = jnp.pad(k, pad)
    vp = jnp.pad(v, pad)

    def one_chunk(c):
        start = c * CHUNK
        qi = lax.dynamic_slice_in_dim(q, start, CHUNK, axis=1)
        ki = lax.dynamic_slice_in_dim(kp, start, BAND, axis=1)
        vi = lax.dynamic_slice_in_dim(vp, start, BAND, axis=1)
        q_pos = start + jnp.arange(CHUNK, dtype=jnp.int32)
        k_pos = start - BAND_PAST + jnp.arange(BAND, dtype=jnp.int32)
        return band_attention(qi, ki, vi, q_pos, k_pos, bias_table)

    o = lax.map(one_chunk, jnp.arange(nc, dtype=jnp.int32))
    return jnp.moveaxis(o, 0, 1).reshape(b, s, N_HEADS_A * HEAD_DIM)


def mixer_b_prompt(q, k, v):
    b, s = q.shape[0], q.shape[1]
    nb = s // SB_BLOCK
    k_pos = jnp.arange(s, dtype=jnp.int32)

    def one_block(i):
        start = i * SB_BLOCK
        qi = lax.dynamic_slice_in_dim(q, start, SB_BLOCK, axis=1)
        q_pos = start + jnp.arange(SB_BLOCK, dtype=jnp.int32)
        return stick_breaking(qi, k, v, q_pos, k_pos)

    o = lax.map(one_block, jnp.arange(nb, dtype=jnp.int32))
    return jnp.moveaxis(o, 0, 1).reshape(b, s, N_HEADS_B * HEAD_DIM)


def mixer_a_sample(q, k, v, ca_k, ca_v, past, bias_table):
    b, t = q.shape[0], q.shape[1]
    la = ca_k.shape[1]
    k_all = jnp.concatenate([ca_k, k], axis=1)
    v_all = jnp.concatenate([ca_v, v], axis=1)
    k_pos = past - la + jnp.arange(la + t, dtype=jnp.int32)
    q_pos = past + jnp.arange(t, dtype=jnp.int32)
    o = band_attention(q, k_all, v_all, q_pos, k_pos, bias_table)
    return o.reshape(b, t, N_HEADS_A * HEAD_DIM)


def mixer_b_sample(q, k, v, cb_k, cb_v):
    b, t = q.shape[0], q.shape[1]
    past = cb_k.shape[1]
    k_all = jnp.concatenate([cb_k, k], axis=1)
    v_all = jnp.concatenate([cb_v, v], axis=1)
    k_pos = jnp.arange(past + t, dtype=jnp.int32)
    q_pos = past + jnp.arange(t, dtype=jnp.int32)
    o = stick_breaking(q, k_all, v_all, q_pos, k_pos)
    return o.reshape(b, t, N_HEADS_B * HEAD_DIM)


def finish(h, oa, ga, ob, gb, w_out, g_post, p, w_ple, w_ple_gate):
    y = jnp.concatenate([oa * jax.nn.silu(ga), ob * jax.nn.silu(gb)], axis=-1) @ w_out
    h = h + rmsnorm(y, g_post)
    return h + jax.nn.sigmoid(h @ w_ple_gate) * (p @ w_ple)


def setup_inputs(seed: int = 0) -> dict:
    key = jax.random.key(seed)
    ks = jax.random.split(key, 16)
    f32 = jnp.float32
    la = min(BAND_PAST, PAST_LEN)
    nrm = lambda k, shape: jax.random.normal(k, shape, f32)
    return {
        "x_prompt": nrm(ks[0], (BATCH, SEQ, D_MODEL)),
        "x_sample": nrm(ks[1], (DEC_BATCH, DEC_SEQ, D_MODEL)),
        "p_prompt": nrm(ks[2], (DEPTH, BATCH, SEQ, D_PLE)),
        "p_sample": nrm(ks[3], (DEPTH, DEC_BATCH, DEC_SEQ, D_PLE)),
        "cache_a_k": nrm(ks[4], (DEPTH, DEC_BATCH, la, N_HEADS_A, HEAD_DIM)),
        "cache_a_v": nrm(ks[5], (DEPTH, DEC_BATCH, la, N_HEADS_A, HEAD_DIM)),
        "cache_b_k": nrm(ks[6], (DEPTH, DEC_BATCH, PAST_LEN, N_HEADS_B, HEAD_DIM)),
        "cache_b_v": nrm(ks[7], (DEPTH, DEC_BATCH, PAST_LEN, N_HEADS_B, HEAD_DIM)),
        "g_pre": 1.0 + 0.05 * nrm(ks[8], (DEPTH, D_MODEL)),
        "w_in": nrm(ks[9], (DEPTH, D_MODEL, D_IN)) * D_MODEL ** -0.5,
        "rel_bias": 0.1 * nrm(ks[10], (DEPTH, N_HEADS_A, 2 * REL_CLIP + 1)),
        "w_out": nrm(ks[11], (DEPTH, D_MIX, D_MODEL)) * D_MIX ** -0.5,
        "g_post": 1.0 + 0.05 * nrm(ks[12], (DEPTH, D_MODEL)),
        "w_ple": nrm(ks[13], (DEPTH, D_PLE, D_MODEL)) * D_PLE ** -0.5,
        "w_ple_gate": nrm(ks[14], (DEPTH, D_MODEL, D_MODEL)) * D_MODEL ** -0.5,
    }


def reference(x_prompt, x_sample, p_prompt, p_sample, cache_a_k, cache_a_v,
              cache_b_k, cache_b_v, g_pre, w_in, rel_bias, w_out, g_post,
              w_ple, w_ple_gate):
    hp, hs = x_prompt, x_sample
    seq = x_prompt.shape[1]
    past = cache_b_k.shape[2]
    keep = min(BAND_PAST, seq)
    pak, pav, pbk, pbv = [], [], [], []
    sak, sav, sbk, sbv = [], [], [], []
    for i in range(DEPTH):
        qa, ka, va, ga, qb, kb, vb, gb = in_proj(hp, g_pre[i], w_in[i])
        oa = mixer_a_prompt(qa, ka, va, rel_bias[i])
        ob = mixer_b_prompt(qb, kb, vb)
        hp = finish(hp, oa, ga, ob, gb, w_out[i], g_post[i], p_prompt[i], w_ple[i], w_ple_gate[i])
        pak.append(ka[:, seq - keep:])
        pav.append(va[:, seq - keep:])
        pbk.append(kb)
        pbv.append(vb)
        qa, ka, va, ga, qb, kb, vb, gb = in_proj(hs, g_pre[i], w_in[i])
        oa = mixer_a_sample(qa, ka, va, cache_a_k[i], cache_a_v[i], past, rel_bias[i])
        ob = mixer_b_sample(qb, kb, vb, cache_b_k[i], cache_b_v[i])
        hs = finish(hs, oa, ga, ob, gb, w_out[i], g_post[i], p_sample[i], w_ple[i], w_ple_gate[i])
        sak.append(ka)
        sav.append(va)
        sbk.append(kb)
        sbv.append(vb)
    return (hp, hs,
            jnp.stack(pak), jnp.stack(pav), jnp.stack(pbk), jnp.stack(pbv),
            jnp.stack(sak), jnp.stack(sav), jnp.stack(sbk), jnp.stack(sbv))
```

```cpp
#include <hip/hip_runtime.h>
#include <hip/hip_cooperative_groups.h>
#include <stdint.h>
#include <stdio.h>
namespace cg = cooperative_groups;

#ifndef MK_COOP
#define MK_COOP 0
#endif

typedef __attribute__((ext_vector_type(8))) short bf16x8;
typedef __attribute__((ext_vector_type(4))) short bf16x4;
typedef __attribute__((ext_vector_type(16))) float f32x16;
typedef __attribute__((ext_vector_type(2))) __bf16 bf2_t;
typedef __attribute__((ext_vector_type(2))) float f2_t;
typedef unsigned short u16;
typedef __attribute__((ext_vector_type(4))) unsigned u32x4;

#define DI __device__ __forceinline__
#define MFMA32(a, b, c) __builtin_amdgcn_mfma_f32_32x32x16_bf16((a), (b), (c), 0, 0, 0)

DI unsigned pack2(float a, float b) { f2_t v = {a, b}; bf2_t r = __builtin_convertvector(v, bf2_t); return __builtin_bit_cast(unsigned, r); }
DI u16 f2bf(float a) { return (u16)(pack2(a, 0.f) & 0xffffu); }
DI float bflo(unsigned u) { return __uint_as_float(u << 16); }
DI float bfhi(unsigned u) { return __uint_as_float(u & 0xffff0000u); }
DI int crow(int i, int h) { return (i & 3) + 8 * (i >> 2) + 4 * h; }
DI int tid_opaque() { int t = threadIdx.x; asm volatile("" : "+v"(t)); return t; }

struct Params {
  const float *xp, *xs, *pp, *ps, *cak, *cav, *cbk, *cbv, *gpre, *win, *relb, *wout, *gpost, *wple, *wgate;
  float* out;
  unsigned char* ws;
};

constexpr int MP = 32768, MS = 512, MT = 33280;
constexpr float EPS = 1e-6f;

constexpr size_t SZ_ACT = (size_t)MT * 1024 * 2;
constexpr size_t SZ_QKV = (size_t)16 * 8 * 2048 * 64 * 2;
constexpr size_t OFF_WIN = 0;
constexpr size_t OFF_WOUT = OFF_WIN + (size_t)2 * 4096 * 1024 * 2;
constexpr size_t OFF_WGATE = OFF_WOUT + (size_t)2 * 1024 * 1024 * 2;
constexpr size_t OFF_WPLE = OFF_WGATE + (size_t)2 * 1024 * 1024 * 2;
constexpr size_t OFF_R0 = OFF_WPLE + (size_t)2 * 1024 * 256 * 2;
constexpr size_t OFF_R1 = OFF_R0 + SZ_ACT;
constexpr size_t OFF_PB = OFF_R1 + SZ_ACT;
constexpr size_t OFF_PSUM = OFF_PB + (size_t)2 * MT * 256 * 2;
constexpr size_t OFF_QA = OFF_PSUM + (size_t)MT * 16 * 4;
constexpr size_t OFF_KA = OFF_QA + SZ_QKV;
constexpr size_t OFF_VAT = OFF_KA + SZ_QKV;
constexpr size_t OFF_QB = OFF_VAT + SZ_QKV;
constexpr size_t OFF_KB = OFF_QB + SZ_QKV;
constexpr size_t OFF_VBT = OFF_KB + SZ_QKV;
constexpr size_t OFF_QAS = OFF_VBT + SZ_QKV;
constexpr size_t OFF_QBS = OFF_QAS + (size_t)128 * 32 * 64 * 2;
constexpr size_t OFF_KAS = OFF_QBS + (size_t)128 * 32 * 64 * 2;
constexpr size_t OFF_VAST = OFF_KAS + (size_t)2 * 128 * 544 * 64 * 2;
constexpr size_t OFF_KBS = OFF_VAST + (size_t)2 * 128 * 544 * 64 * 2;
constexpr size_t OFF_VBST = OFF_KBS + (size_t)2 * 128 * 1056 * 64 * 2;
constexpr size_t OFF_CTR = OFF_VBST + (size_t)2 * 128 * 1056 * 64 * 2;
constexpr size_t WS_TOTAL = OFF_CTR + 256;
static_assert(WS_TOTAL <= (size_t)536870912, "workspace too large");

constexpr size_t O_AKP = 34078720;
constexpr size_t O_AVP = O_AKP + 8388608;
constexpr size_t O_BKP = O_AVP + 8388608;
constexpr size_t O_BVP = O_BKP + 33554432;
constexpr size_t O_AKS = O_BVP + 33554432;
constexpr size_t O_AVS = O_AKS + 524288;
constexpr size_t O_BKS = O_AVS + 524288;
constexpr size_t O_BVS = O_BKS + 524288;

constexpr int BK = 64, LDT = BK + 8;
constexpr int SMEM_BYTES = 2 * 128 * LDT * 2 + 512;

DI void gemm_mainloop(const u16* __restrict__ A, int lda, const u16* __restrict__ Bt, int ldb, int K,
                      u16* sA, u16* sB, f32x16 (&acc)[2][2]) {
  const int tid = tid_opaque(), lane = tid & 63, wave = tid >> 6, wm = wave >> 1, wn = wave & 1, r = lane & 31, h = lane >> 5;
  const int lrow = tid >> 3, lcol = (tid & 7) * 8;
  const u16* gA = A + (size_t)lrow * lda + lcol;
  const u16* gB = Bt + (size_t)lrow * ldb + lcol;
  u32x4 ra[4], rb[4];
#pragma unroll
  for (int i = 0; i < 4; ++i) {
    ra[i] = *(const u32x4*)(gA + (size_t)(32 * i) * lda);
    rb[i] = *(const u32x4*)(gB + (size_t)(32 * i) * ldb);
  }
#pragma unroll
  for (int a = 0; a < 2; ++a)
#pragma unroll
    for (int b = 0; b < 2; ++b)
#pragma unroll
      for (int i = 0; i < 16; ++i) acc[a][b][i] = 0.f;
  const u16* rA = sA + (64 * wm + r) * LDT + 8 * h;
  const u16* rB = sB + (64 * wn + r) * LDT + 8 * h;
  for (int k0 = 0; k0 < K; k0 += BK) {
    __syncthreads();
#pragma unroll
    for (int i = 0; i < 4; ++i) {
      *(u32x4*)(sA + (lrow + 32 * i) * LDT + lcol) = ra[i];
      *(u32x4*)(sB + (lrow + 32 * i) * LDT + lcol) = rb[i];
    }
    __syncthreads();
    if (k0 + BK < K) {
      gA += BK; gB += BK;
#pragma unroll
      for (int i = 0; i < 4; ++i) {
        ra[i] = *(const u32x4*)(gA + (size_t)(32 * i) * lda);
        rb[i] = *(const u32x4*)(gB + (size_t)(32 * i) * ldb);
      }
    }
#pragma unroll
    for (int ks = 0; ks < 4; ++ks) {
      const bf16x8 a0 = *(const bf16x8*)(rA + 16 * ks);
      const bf16x8 a1 = *(const bf16x8*)(rA + 32 * LDT + 16 * ks);
      const bf16x8 b0 = *(const bf16x8*)(rB + 16 * ks);
      const bf16x8 b1 = *(const bf16x8*)(rB + 32 * LDT + 16 * ks);
      acc[0][0] = MFMA32(a0, b0, acc[0][0]);
      acc[0][1] = MFMA32(a0, b1, acc[0][1]);
      acc[1][0] = MFMA32(a1, b0, acc[1][0]);
      acc[1][1] = MFMA32(a1, b1, acc[1][1]);
    }
  }
}

DI void transpose_tile(const float* __restrict__ src, int sld, u16* __restrict__ dst, int dld,
                       const float* __restrict__ scale, float* sm) {
  const int tid = tid_opaque();
  const int nn = tid & 63, kq = tid >> 6;
#pragma unroll
  for (int i = 0; i < 16; ++i) {
    const int kk = kq + 4 * i;
    float v = src[(size_t)kk * sld + nn];
    if (scale) v *= scale[kk];
    sm[kk * 65 + nn] = v;
  }
  __syncthreads();
  const int kp = (tid & 31) * 2, nq = tid >> 5;
#pragma unroll
  for (int i = 0; i < 8; ++i) {
    const int n2 = nq + 8 * i;
    const unsigned u = pack2(sm[kp * 65 + n2], sm[(kp + 1) * 65 + n2]);
    *(unsigned*)(dst + (size_t)n2 * dld + kp) = u;
  }
  __syncthreads();
}

DI uint4 cvt8(const float* __restrict__ s) {
  const float4 a = *(const float4*)s, b = *(const float4*)(s + 4);
  uint4 o;
  o.x = pack2(a.x, a.y); o.y = pack2(a.z, a.w); o.z = pack2(b.x, b.y); o.w = pack2(b.z, b.w);
  return o;
}

DI void phase0(const Params& p, float* sm) {
  const int tid = tid_opaque();
  unsigned char* ws = p.ws;
  if (blockIdx.x == 0 && tid < 2) ((int*)(ws + OFF_CTR))[tid] = 0;
  for (int j = blockIdx.x; j < 9344; j += gridDim.x) {
    const float* src; u16* dst; const float* scale = nullptr; int sld, dld;
    if (j < 2048) {
      const int l = j >> 10, kt = (j >> 6) & 15, nt = j & 63;
      src = p.win + ((size_t)l * 1024 + kt * 64) * 4096 + nt * 64; sld = 4096;
      dst = (u16*)(ws + OFF_WIN) + ((size_t)l * 4096 + nt * 64) * 1024 + kt * 64; dld = 1024;
      scale = p.gpre + l * 1024 + kt * 64;
    } else if (j < 3072) {
      const int jj = (j - 2048) & 511;
      const bool gate = j >= 2560;
      const int l = jj >> 8, kt = (jj >> 4) & 15, nt = jj & 15;
      src = (gate ? p.wgate : p.wout) + ((size_t)l * 1024 + kt * 64) * 1024 + nt * 64; sld = 1024;
      dst = (u16*)(ws + (gate ? OFF_WGATE : OFF_WOUT)) + ((size_t)l * 1024 + nt * 64) * 1024 + kt * 64; dld = 1024;
    } else if (j < 3200) {
      const int jj = j - 3072;
      const int l = jj >> 6, kt = (jj >> 4) & 3, nt = jj & 15;
      src = p.wple + ((size_t)l * 256 + kt * 64) * 1024 + nt * 64; sld = 1024;
      dst = (u16*)(ws + OFF_WPLE) + ((size_t)l * 1024 + nt * 64) * 256 + kt * 64; dld = 256;
    } else if (j < 5248) {
      const int jj = j - 3200;
      const int lbh = jj >> 3, kt = jj & 7;
      const int lb = lbh >> 3, hd = lbh & 7;
      src = p.cav + ((size_t)lb * 512 + kt * 64) * 512 + hd * 64; sld = 512;
      dst = (u16*)(ws + OFF_VAST) + (size_t)lbh * 64 * 544 + kt * 64; dld = 544;
    } else {
      const int jj = j - 5248;
      const int lbh = jj >> 4, kt = jj & 15;
      const int lb = lbh >> 3, hd = lbh & 7;
      src = p.cbv + ((size_t)lb * 1024 + kt * 64) * 512 + hd * 64; sld = 512;
      dst = (u16*)(ws + OFF_VBST) + (size_t)lbh * 64 * 1056 + kt * 64; dld = 1056;
    }
    transpose_tile(src, sld, dst, dld, scale, sm);
  }
  const size_t gtid = (size_t)blockIdx.x * 256 + tid, gn = (size_t)gridDim.x * 256;
  for (size_t e = gtid; e < (size_t)1048576; e += gn) {
    const int d8 = e & 7, hd = (e >> 3) & 7, s = (e >> 6) & 511, lb = (int)(e >> 15);
    *(uint4*)((u16*)(ws + OFF_KAS) + (((size_t)lb * 8 + hd) * 544 + s) * 64 + d8 * 8) = cvt8(p.cak + e * 8);
  }
  for (size_t e = gtid; e < (size_t)2097152; e += gn) {
    const int d8 = e & 7, hd = (e >> 3) & 7, s = (e >> 6) & 1023, lb = (int)(e >> 16);
    *(uint4*)((u16*)(ws + OFF_KBS) + (((size_t)lb * 8 + hd) * 1056 + s) * 64 + d8 * 8) = cvt8(p.cbk + e * 8);
  }
  for (size_t e = gtid; e < (size_t)2 * MT * 32; e += gn) {
    const int c8 = e & 31;
    const size_t lr = e >> 5;
    const int l = (int)(lr / MT), row = (int)(lr % MT);
    const float* src = row < MP ? p.pp + ((size_t)l * MP + row) * 256 : p.ps + ((size_t)l * MS + (row - MP)) * 256;
    *(uint4*)((u16*)(ws + OFF_PB) + lr * 256 + c8 * 8) = cvt8(src + c8 * 8);
  }
  const int lane = tid & 63;
  const int gw = (int)(gtid >> 6), nw = (int)(gn >> 6);
  for (int row = gw; row < MT; row += nw) {
    const float* src = row < MP ? p.xp + (size_t)row * 1024 : p.xs + (size_t)(row - MP) * 1024;
    u16* dst = (u16*)(ws + OFF_R0) + (size_t)row * 1024;
    float ss = 0.f;
#pragma unroll
    for (int j = 0; j < 2; ++j) {
      const int c = 8 * lane + 512 * j;
      const float4 a = *(const float4*)(src + c), b = *(const float4*)(src + c + 4);
      ss += a.x * a.x + a.y * a.y + a.z * a.z + a.w * a.w + b.x * b.x + b.y * b.y + b.z * b.z + b.w * b.w;
      uint4 o;
      o.x = pack2(a.x, a.y); o.y = pack2(a.z, a.w); o.z = pack2(b.x, b.y); o.w = pack2(b.z, b.w);
      *(uint4*)(dst + c) = o;
    }
#pragma unroll
    for (int m = 32; m >= 1; m >>= 1) ss += __shfl_xor(ss, m);
    if (lane < 16) ((float*)(ws + OFF_PSUM))[(size_t)row * 16 + lane] = lane == 0 ? ss : 0.f;
  }
}

DI void p1_tile(const Params& p, int layer, int tile, u16* sA, u16* sB, float* rstd_s, const u16* HB, u16* Gbuf) {
  const int tid = tid_opaque();
  const int mt = tile >> 5, nt = tile & 31;
  const int m0 = mt * 128, n0 = nt * 128;
  unsigned char* ws = p.ws;
  __syncthreads();
  if (tid < 128) {
    const float4* ps = (const float4*)((const float*)(ws + OFF_PSUM) + (size_t)(m0 + tid) * 16);
    float s = 0.f;
#pragma unroll
    for (int j = 0; j < 4; ++j) { const float4 v = ps[j]; s += v.x + v.y + v.z + v.w; }
    rstd_s[tid] = rsqrtf(s * (1.0f / 1024.0f) + EPS);
  }
  f32x16 acc[2][2];
  gemm_mainloop(HB + (size_t)m0 * 1024, 1024, (const u16*)(ws + OFF_WIN) + ((size_t)layer * 4096 + n0) * 1024, 1024, 1024, sA, sB, acc);

  int tl = tid_opaque();
  const int lane = tl & 63, wave = tl >> 6, wm = wave >> 1, wn = wave & 1, r = lane & 31, h = lane >> 5;
  const int seg = n0 >> 9, kind = seg & 3, grp = seg >> 2;
  const int hd = ((n0 & 511) >> 6) + wn;
  const bool prompt = m0 < MP;
  float* out = p.out;
#pragma unroll
  for (int rb = 0; rb < 2; ++rb) {
    const int lrow0 = 64 * wm + 32 * rb;
    const int row0 = m0 + lrow0;
    int b, s0;
    if (prompt) { b = row0 >> 11; s0 = row0 & 2047; } else { b = (row0 - MP) >> 5; s0 = 0; }
    const int lb = layer * 16 + b;
    if (kind == 3) {
#pragma unroll
      for (int cb = 0; cb < 2; ++cb)
#pragma unroll
        for (int i = 0; i < 16; ++i) {
          const int t = crow(i, h);
          const float v = acc[rb][cb][i] * rstd_s[lrow0 + t];
          const float sv = v / (1.0f + __expf(-v));
          Gbuf[(size_t)(row0 + t) * 1024 + grp * 512 + hd * 64 + 32 * cb + r] = f2bf(sv);
        }
    } else if (kind == 0) {
      u16* base;
      if (prompt) base = (u16*)(ws + (grp ? OFF_QB : OFF_QA)) + (((size_t)b * 8 + hd) * 2048 + s0) * 64;
      else base = (u16*)(ws + (grp ? OFF_QBS : OFF_QAS)) + (((size_t)b * 8 + hd) * 32) * 64;
#pragma unroll
      for (int cb = 0; cb < 2; ++cb)
#pragma unroll
        for (int i = 0; i < 16; ++i) {
          const int t = crow(i, h);
          const float v = acc[rb][cb][i] * rstd_s[lrow0 + t] * 0.125f;
          base[t * 64 + 32 * cb + r] = f2bf(v);
        }
    } else {
      float* fo = nullptr;
      if (prompt) {
        if (grp == 0) {
          if (s0 >= 1536) fo = out + (kind == 1 ? O_AKP : O_AVP) + ((size_t)lb * 512 + (s0 - 1536)) * 512 + hd * 64;
        } else {
          fo = out + (kind == 1 ? O_BKP : O_BVP) + ((size_t)lb * 2048 + s0) * 512 + hd * 64;
        }
      } else {
        if (grp == 0) fo = out + (kind == 1 ? O_AKS : O_AVS) + ((size_t)lb * 32) * 512 + hd * 64;
        else fo = out + (kind == 1 ? O_BKS : O_BVS) + ((size_t)lb * 32) * 512 + hd * 64;
      }
      if (kind == 1) {
        u16* base;
        if (prompt) base = (u16*)(ws + (grp ? OFF_KB : OFF_KA)) + (((size_t)b * 8 + hd) * 2048 + s0) * 64;
        else if (grp == 0) base = (u16*)(ws + OFF_KAS) + (((size_t)lb * 8 + hd) * 544 + 512) * 64;
        else base = (u16*)(ws + OFF_KBS) + (((size_t)lb * 8 + hd) * 1056 + 1024) * 64;
#pragma unroll
        for (int cb = 0; cb < 2; ++cb)
#pragma unroll
          for (int i = 0; i < 16; ++i) {
            const int t = crow(i, h);
            const float v = acc[rb][cb][i] * rstd_s[lrow0 + t];
            base[t * 64 + 32 * cb + r] = f2bf(v);
            if (fo) fo[(size_t)t * 512 + 32 * cb + r] = v;
          }
      } else {
        u16* base; int ldv;
        if (prompt) { base = (u16*)(ws + (grp ? OFF_VBT : OFF_VAT)) + (((size_t)b * 8 + hd) * 64) * 2048 + s0; ldv = 2048; }
        else if (grp == 0) { base = (u16*)(ws + OFF_VAST) + (((size_t)lb * 8 + hd) * 64) * 544 + 512; ldv = 544; }
        else { base = (u16*)(ws + OFF_VBST) + (((size_t)lb * 8 + hd) * 64) * 1056 + 1024; ldv = 1056; }
#pragma unroll
        for (int cb = 0; cb < 2; ++cb)
#pragma unroll
          for (int g = 0; g < 4; ++g) {
            const int t0 = 8 * g + 4 * h;
            float v[4];
#pragma unroll
            for (int j = 0; j < 4; ++j) {
              v[j] = acc[rb][cb][4 * g + j] * rstd_s[lrow0 + t0 + j];
              if (fo) fo[(size_t)(t0 + j) * 512 + 32 * cb + r] = v[j];
            }
            uint2 o; o.x = pack2(v[0], v[1]); o.y = pack2(v[2], v[3]);
            *(uint2*)(base + (size_t)(32 * cb + r) * ldv + t0) = o;
          }
      }
    }
  }
}

DI void attn_store(const f32x16& o0, const f32x16& o1, float scale, const u16* Gp, u16* Mp, int r, int h) {
#pragma unroll
  for (int db = 0; db < 2; ++db)
#pragma unroll
    for (int g = 0; g < 4; ++g) {
      const int d0 = 32 * db + 8 * g + 4 * h;
      const uint2 gv = *(const uint2*)(Gp + (size_t)r * 1024 + d0);
      const float x0 = (db ? o1[4 * g] : o0[4 * g]) * scale * bflo(gv.x);
      const float x1 = (db ? o1[4 * g + 1] : o0[4 * g + 1]) * scale * bfhi(gv.x);
      const float x2 = (db ? o1[4 * g + 2] : o0[4 * g + 2]) * scale * bflo(gv.y);
      const float x3 = (db ? o1[4 * g + 3] : o0[4 * g + 3]) * scale * bfhi(gv.y);
      uint2 o; o.x = pack2(x0, x1); o.y = pack2(x2, x3);
      *(uint2*)(Mp + (size_t)r * 1024 + d0) = o;
    }
}

DI bf16x8 ldv8(const u16* vp) {
  const bf16x4 lo = *(const bf16x4*)vp;
  const bf16x4 hi = *(const bf16x4*)(vp + 8);
  return __builtin_shufflevector(lo, hi, 0, 1, 2, 3, 4, 5, 6, 7);
}

DI bf16x8 pack8(const float* v) {
  uint4 u;
  u.x = pack2(v[0], v[1]); u.y = pack2(v[2], v[3]); u.z = pack2(v[4], v[5]); u.w = pack2(v[6], v[7]);
  return __builtin_bit_cast(bf16x8, u);
}

DI void sb_item(const u16* __restrict__ Q, const u16* __restrict__ Kb, const u16* __restrict__ VT, int ldv,
                int qpos0, int ntiles, const u16* Gp, u16* Mp) {
  const int lane = tid_opaque() & 63, r = lane & 31, h = lane >> 5;
  bf16x8 qf[4];
#pragma unroll
  for (int ks = 0; ks < 4; ++ks) qf[ks] = *(const bf16x8*)(Q + r * 64 + 16 * ks + 8 * h);
  bf16x8 tf[2];
#pragma unroll
  for (int s = 0; s < 2; ++s)
#pragma unroll
    for (int j = 0; j < 8; ++j) tf[s][j] = (16 * s + 8 * (j >> 2) + 4 * h + (j & 3) > r) ? (short)0x3F80 : (short)0;
  f32x16 o0, o1;
#pragma unroll
  for (int i = 0; i < 16; ++i) { o0[i] = 0.f; o1[i] = 0.f; }
  float carry = 0.f;
  const int qpos = qpos0 + r;
  for (int kt = ntiles - 1; kt >= 0; --kt) {
    const int k0 = kt * 32;
    f32x16 st;
#pragma unroll
    for (int i = 0; i < 16; ++i) st[i] = 0.f;
    const u16* kp = Kb + (size_t)(k0 + r) * 64 + 8 * h;
#pragma unroll
    for (int ks = 0; ks < 4; ++ks) {
      const bf16x8 kf = *(const bf16x8*)(kp + 16 * ks);
      st = MFMA32(kf, qf[ks], st);
    }
    bf16x8 vf[2][2];
#pragma unroll
    for (int db = 0; db < 2; ++db)
#pragma unroll
      for (int s = 0; s < 2; ++s) vf[db][s] = ldv8(VT + (size_t)(32 * db + r) * ldv + k0 + 16 * s + 4 * h);
    float l1m[16], lb[16];
    float csum = 0.f;
#pragma unroll
    for (int i = 0; i < 16; ++i) {
      const float z = st[i];
      const bool c = (k0 + crow(i, h)) < qpos;
      const float e = __expf(-fabsf(z));
      const float sp = fmaxf(z, 0.f) + __logf(1.0f + e);
      l1m[i] = c ? -sp : 0.f;
      lb[i] = c ? (z - sp) : -1e30f;
      csum += l1m[i];
    }
    csum += __shfl_xor(csum, 32);
    f32x16 af;
#pragma unroll
    for (int i = 0; i < 16; ++i) af[i] = 0.f;
    af = MFMA32(tf[0], pack8(l1m), af);
    af = MFMA32(tf[1], pack8(l1m + 8), af);
    float w[16];
#pragma unroll
    for (int i = 0; i < 16; ++i) w[i] = __expf(lb[i] + af[i] + carry);
    carry += csum;
    const bf16x8 w0 = pack8(w), w1 = pack8(w + 8);
    o0 = MFMA32(vf[0][0], w0, o0);
    o0 = MFMA32(vf[0][1], w1, o0);
    o1 = MFMA32(vf[1][0], w0, o1);
    o1 = MFMA32(vf[1][1], w1, o1);
  }
  attn_store(o0, o1, 1.0f, Gp, Mp, r, h);
}

DI void band_item(const u16* __restrict__ Q, const u16* __restrict__ Kb, const u16* __restrict__ VT, int ldv,
                  int kt_begin, int kt_end, int relbase, const float* __restrict__ bias, const u16* Gp, u16* Mp) {
  const int lane = tid_opaque() & 63, r = lane & 31, h = lane >> 5;
  bf16x8 qf[4];
#pragma unroll
  for (int ks = 0; ks < 4; ++ks) qf[ks] = *(const bf16x8*)(Q + r * 64 + 16 * ks + 8 * h);
  f32x16 o0, o1;
#pragma unroll
  for (int i = 0; i < 16; ++i) { o0[i] = 0.f; o1[i] = 0.f; }
  float m = -1e30f, l = 0.f;
  const float b0 = bias[0];
  for (int kt = kt_begin; kt < kt_end; ++kt) {
    const int k0 = kt * 32;
    f32x16 st;
#pragma unroll
    for (int i = 0; i < 16; ++i) st[i] = 0.f;
    const u16* kp = Kb + (size_t)(k0 + r) * 64 + 8 * h;
#pragma unroll
    for (int ks = 0; ks < 4; ++ks) {
      const bf16x8 kf = *(const bf16x8*)(kp + 16 * ks);
      st = MFMA32(kf, qf[ks], st);
    }
    bf16x8 vf[2][2];
#pragma unroll
    for (int db = 0; db < 2; ++db)
#pragma unroll
      for (int s = 0; s < 2; ++s) vf[db][s] = ldv8(VT + (size_t)(32 * db + r) * ldv + k0 + 16 * s + 4 * h);
    float sv[16];
    if (k0 + 31 + relbase <= -128) {
#pragma unroll
      for (int i = 0; i < 16; ++i) sv[i] = st[i] + b0;
    } else {
      const int relc = k0 + relbase - r;
#pragma unroll
      for (int i = 0; i < 16; ++i) {
        int rel = relc + crow(i, h);
        rel = min(max(rel, -128), 128) + 128;
        sv[i] = st[i] + bias[rel];
      }
    }
    float mt = sv[0];
#pragma unroll
    for (int i = 1; i < 16; ++i) mt = fmaxf(mt, sv[i]);
    mt = fmaxf(mt, __shfl_xor(mt, 32));
    const float mnew = fmaxf(m, mt);
    const float alpha = __expf(m - mnew);
    m = mnew;
    float ps = 0.f;
#pragma unroll
    for (int i = 0; i < 16; ++i) { sv[i] = __expf(sv[i] - mnew); ps += sv[i]; }
    l = l * alpha + ps;
#pragma unroll
    for (int i = 0; i < 16; ++i) { o0[i] *= alpha; o1[i] *= alpha; }
    const bf16x8 w0 = pack8(sv), w1 = pack8(sv + 8);
    o0 = MFMA32(vf[0][0], w0, o0);
    o0 = MFMA32(vf[0][1], w1, o0);
    o1 = MFMA32(vf[1][0], w0, o1);
    o1 = MFMA32(vf[1][1], w1, o1);
  }
  l += __shfl_xor(l, 32);
  attn_store(o0, o1, 1.0f / l, Gp, Mp, r, h);
}

constexpr int N_ITEMS = 16640;

DI void phase2(const Params& p, int layer, const u16* Gbuf, u16* MIX) {
  unsigned char* ws = p.ws;
  int* ctr = (int*)(ws + OFF_CTR) + layer;
  const int lane = tid_opaque() & 63;
  for (;;) {
    int idx = 0;
    if (lane == 0) idx = atomicAdd(ctr, 1);
    idx = __shfl(idx, 0);
    if (idx >= N_ITEMS) break;
    if (idx < 128) {
      const int bh = idx, b = bh >> 3, hd = bh & 7;
      const size_t row0 = (size_t)MP + b * 32;
      sb_item((const u16*)(ws + OFF_QBS) + (size_t)bh * 32 * 64,
              (const u16*)(ws + OFF_KBS) + ((size_t)layer * 128 + bh) * 1056 * 64,
              (const u16*)(ws + OFF_VBST) + ((size_t)layer * 128 + bh) * 64 * 1056, 1056,
              1024, 33, Gbuf + row0 * 1024 + 512 + hd * 64, MIX + row0 * 1024 + 512 + hd * 64);
    } else if (idx < 8320) {
      const int j = idx - 128, bh = j >> 6, qt = 63 - (j & 63), b = bh >> 3, hd = bh & 7;
      const size_t row0 = (size_t)b * 2048 + qt * 32;
      sb_item((const u16*)(ws + OFF_QB) + ((size_t)bh * 2048 + qt * 32) * 64,
              (const u16*)(ws + OFF_KB) + (size_t)bh * 2048 * 64,
              (const u16*)(ws + OFF_VBT) + (size_t)bh * 64 * 2048, 2048,
              qt * 32, qt + 1, Gbuf + row0 * 1024 + 512 + hd * 64, MIX + row0 * 1024 + 512 + hd * 64);
    } else if (idx < 8448) {
      const int bh = idx - 8320, b = bh >> 3, hd = bh & 7;
      const size_t row0 = (size_t)MP + b * 32;
      band_item((const u16*)(ws + OFF_QAS) + (size_t)bh * 32 * 64,
                (const u16*)(ws + OFF_KAS) + ((size_t)layer * 128 + bh) * 544 * 64,
                (const u16*)(ws + OFF_VAST) + ((size_t)layer * 128 + bh) * 64 * 544, 544,
                0, 17, -512, p.relb + (size_t)(layer * 8 + hd) * 257,
                Gbuf + row0 * 1024 + hd * 64, MIX + row0 * 1024 + hd * 64);
    } else {
      const int j = idx - 8448, bh = j >> 6, qt = j & 63, b = bh >> 3, hd = bh & 7;
      const int c = qt >> 1;
      const size_t row0 = (size_t)b * 2048 + qt * 32;
      band_item((const u16*)(ws + OFF_QA) + ((size_t)bh * 2048 + qt * 32) * 64,
                (const u16*)(ws + OFF_KA) + (size_t)bh * 2048 * 64,
                (const u16*)(ws + OFF_VAT) + (size_t)bh * 64 * 2048, 2048,
                2 * max(0, c - 8), 2 * c + 2, -qt * 32, p.relb + (size_t)(layer * 8 + hd) * 257,
                Gbuf + row0 * 1024 + hd * 64, MIX + row0 * 1024 + hd * 64);
    }
  }
}

DI void p3_tile(const Params& p, int layer, int tile, u16* sA, u16* sB, const u16* MIX, u16* Y) {
  const int mt = tile >> 3, nt = tile & 7;
  const int m0 = mt * 128, n0 = nt * 128;
  f32x16 acc[2][2];
  gemm_mainloop(MIX + (size_t)m0 * 1024, 1024, (const u16*)(p.ws + OFF_WOUT) + ((size_t)layer * 1024 + n0) * 1024, 1024, 1024, sA, sB, acc);
  int tl = tid_opaque();
  const int lane = tl & 63, wave = tl >> 6, wm = wave >> 1, wn = wave & 1, r = lane & 31, h = lane >> 5;
#pragma unroll
  for (int rb = 0; rb < 2; ++rb)
#pragma unroll
    for (int cb = 0; cb < 2; ++cb)
#pragma unroll
      for (int i = 0; i < 16; ++i) {
        const int row = m0 + 64 * wm + 32 * rb + crow(i, h);
        Y[(size_t)row * 1024 + n0 + 64 * wn + 32 * cb + r] = f2bf(acc[rb][cb][i]);
      }
}

DI void phase4(const Params& p, int layer, const u16* Y, u16* H1B) {
  const int tid = tid_opaque(), lane = tid & 63;
  const int gw = (blockIdx.x * 256 + tid) >> 6, nw = (gridDim.x * 256) >> 6;
  const float* gp = p.gpost + layer * 1024;
  for (int row = gw; row < MT; row += nw) {
    const u16* yr = Y + (size_t)row * 1024;
    float yf[16];
    float ss = 0.f;
#pragma unroll
    for (int j = 0; j < 2; ++j) {
      const uint4 u = *(const uint4*)(yr + 8 * lane + 512 * j);
      yf[8 * j + 0] = bflo(u.x); yf[8 * j + 1] = bfhi(u.x); yf[8 * j + 2] = bflo(u.y); yf[8 * j + 3] = bfhi(u.y);
      yf[8 * j + 4] = bflo(u.z); yf[8 * j + 5] = bfhi(u.z); yf[8 * j + 6] = bflo(u.w); yf[8 * j + 7] = bfhi(u.w);
    }
#pragma unroll
    for (int i = 0; i < 16; ++i) ss += yf[i] * yf[i];
#pragma unroll
    for (int m = 32; m >= 1; m >>= 1) ss += __shfl_xor(ss, m);
    const float rs = rsqrtf(ss * (1.0f / 1024.0f) + EPS);
    const float* hs;
    if (layer == 0) hs = row < MP ? p.xp + (size_t)row * 1024 : p.xs + (size_t)(row - MP) * 1024;
    else hs = p.out + (size_t)row * 1024;
    float* ho = p.out + (size_t)row * 1024;
#pragma unroll
    for (int j = 0; j < 2; ++j) {
      const int c = 8 * lane + 512 * j;
      const float4 a = *(const float4*)(hs + c), b = *(const float4*)(hs + c + 4);
      const float4 ga = *(const float4*)(gp + c), gb = *(const float4*)(gp + c + 4);
      float4 oa, ob;
      oa.x = a.x + yf[8 * j + 0] * rs * ga.x; oa.y = a.y + yf[8 * j + 1] * rs * ga.y;
      oa.z = a.z + yf[8 * j + 2] * rs * ga.z; oa.w = a.w + yf[8 * j + 3] * rs * ga.w;
      ob.x = b.x + yf[8 * j + 4] * rs * gb.x; ob.y = b.y + yf[8 * j + 5] * rs * gb.y;
      ob.z = b.z + yf[8 * j + 6] * rs * gb.z; ob.w = b.w + yf[8 * j + 7] * rs * gb.w;
      *(float4*)(ho + c) = oa; *(float4*)(ho + c + 4) = ob;
      uint4 o;
      o.x = pack2(oa.x, oa.y); o.y = pack2(oa.z, oa.w); o.z = pack2(ob.x, ob.y); o.w = pack2(ob.z, ob.w);
      *(uint4*)(H1B + (size_t)row * 1024 + c) = o;
    }
  }
}

DI void p5_tile(const Params& p, int layer, int tile, u16* sA, u16* sB, const u16* H1B, u16* HBN) {
  const int mt = tile >> 3, nt = tile & 7;
  const int m0 = mt * 128, n0 = nt * 128;
  unsigned char* ws = p.ws;
  f32x16 acc[2][2];
  gemm_mainloop((const u16*)(ws + OFF_PB) + ((size_t)layer * MT + m0) * 256, 256,
                (const u16*)(ws + OFF_WPLE) + ((size_t)layer * 1024 + n0) * 256, 256, 256, sA, sB, acc);
  unsigned pl[2][2][8];
#pragma unroll
  for (int rb = 0; rb < 2; ++rb)
#pragma unroll
    for (int cb = 0; cb < 2; ++cb)
#pragma unroll
      for (int j = 0; j < 8; ++j) pl[rb][cb][j] = pack2(acc[rb][cb][2 * j], acc[rb][cb][2 * j + 1]);
  gemm_mainloop(H1B + (size_t)m0 * 1024, 1024, (const u16*)(ws + OFF_WGATE) + ((size_t)layer * 1024 + n0) * 1024, 1024, 1024, sA, sB, acc);
  int tl = tid_opaque();
  const int lane = tl & 63, wave = tl >> 6, wm = wave >> 1, wn = wave & 1, r = lane & 31, h = lane >> 5;
  float sq[32];
#pragma unroll
  for (int rb = 0; rb < 2; ++rb)
#pragma unroll
    for (int i = 0; i < 16; ++i) {
      const int row = m0 + 64 * wm + 32 * rb + crow(i, h);
      float s2 = 0.f;
#pragma unroll
      for (int cb = 0; cb < 2; ++cb) {
        const int col = n0 + 64 * wn + 32 * cb + r;
        float* hp = p.out + (size_t)row * 1024 + col;
        const float h1 = *hp;
        const float pv = (i & 1) ? bfhi(pl[rb][cb][i >> 1]) : bflo(pl[rb][cb][i >> 1]);
        const float g = 1.0f / (1.0f + __expf(-acc[rb][cb][i]));
        const float h2 = h1 + g * pv;
        *hp = h2;
        if (layer == 0) HBN[(size_t)row * 1024 + col] = f2bf(h2);
        s2 += h2 * h2;
      }
      sq[rb * 16 + i] = s2;
    }
  if (layer == 0) {
#pragma unroll
    for (int j = 0; j < 16; ++j) {
      const float send = (r & 16) ? sq[j] : sq[j + 16];
      const float keep = (r & 16) ? sq[j + 16] : sq[j];
      sq[j] = keep + __shfl_xor(send, 16);
    }
#pragma unroll
    for (int j = 0; j < 8; ++j) {
      const float send = (r & 8) ? sq[j] : sq[j + 8];
      const float keep = (r & 8) ? sq[j + 8] : sq[j];
      sq[j] = keep + __shfl_xor(send, 8);
    }
#pragma unroll
    for (int j = 0; j < 4; ++j) {
      const float send = (r & 4) ? sq[j] : sq[j + 4];
      const float keep = (r & 4) ? sq[j + 4] : sq[j];
      sq[j] = keep + __shfl_xor(send, 4);
    }
#pragma unroll
    for (int j = 0; j < 2; ++j) {
      const float send = (r & 2) ? sq[j] : sq[j + 2];
      const float keep = (r & 2) ? sq[j + 2] : sq[j];
      sq[j] = keep + __shfl_xor(send, 2);
    }
    {
      const float send = (r & 1) ? sq[0] : sq[1];
      const float keep = (r & 1) ? sq[1] : sq[0];
      sq[0] = keep + __shfl_xor(send, 1);
    }
    const int row = m0 + 64 * wm + 32 * (r >> 4) + crow(r & 15, h);
    ((float*)(ws + OFF_PSUM))[(size_t)row * 16 + nt * 2 + wn] = sq[0];
  }
}

__global__ void __launch_bounds__(256, 2) mega(Params p, int ph_begin, int ph_end) {
  __shared__ __attribute__((aligned(16))) unsigned char smem[SMEM_BYTES];
  u16* sA = (u16*)smem;
  u16* sB = sA + 128 * LDT;
  float* rstd_s = (float*)(smem + 2 * 128 * LDT * 2);
  unsigned char* ws = p.ws;
#define PHASE_GATE(PH) if ((PH) >= ph_begin && (PH) < ph_end) { if ((PH) > ph_begin) cg::this_grid().sync();
  PHASE_GATE(0) phase0(p, (float*)smem); }
#pragma unroll 1
  for (int layer = 0; layer < 2; ++layer) {
    asm volatile("" : "+s"(layer));
    u16* RA = (u16*)(ws + ((layer & 1) ? OFF_R1 : OFF_R0));
    u16* RB = (u16*)(ws + ((layer & 1) ? OFF_R0 : OFF_R1));
    const int pb = 1 + 5 * layer;
    PHASE_GATE(pb + 0)
#pragma unroll 1
      for (int t = blockIdx.x; t < 260 * 32; t += gridDim.x) p1_tile(p, layer, t, sA, sB, rstd_s, RA, RB);
    }
    PHASE_GATE(pb + 1) phase2(p, layer, RB, RA); }
    PHASE_GATE(pb + 2)
#pragma unroll 1
      for (int t = blockIdx.x; t < 260 * 8; t += gridDim.x) p3_tile(p, layer, t, sA, sB, RA, RB);
    }
    PHASE_GATE(pb + 3) phase4(p, layer, RB, RA); }
    PHASE_GATE(pb + 4)
#pragma unroll 1
      for (int t = blockIdx.x; t < 260 * 8; t += gridDim.x) p5_tile(p, layer, t, sA, sB, RA, RB);
    }
  }
}

extern "C" void kernel_launch(void* const* d_in, const int* in_sizes, int n_in, void* d_out, int out_size,
                              void* d_ws, size_t ws_size, hipStream_t stream) {
  Params p{};
  p.xp = (const float*)d_in[0]; p.xs = (const float*)d_in[1]; p.pp = (const float*)d_in[2]; p.ps = (const float*)d_in[3];
  p.cak = (const float*)d_in[4]; p.cav = (const float*)d_in[5]; p.cbk = (const float*)d_in[6]; p.cbv = (const float*)d_in[7];
  p.gpre = (const float*)d_in[8]; p.win = (const float*)d_in[9]; p.relb = (const float*)d_in[10]; p.wout = (const float*)d_in[11];
  p.gpost = (const float*)d_in[12]; p.wple = (const float*)d_in[13]; p.wgate = (const float*)d_in[14];
  p.out = (float*)d_out;
  p.ws = (unsigned char*)d_ws;
  static int grid_blocks = 0;
  if (!grid_blocks) {
    int dev = 0, cus = 0, per_cu = 0;
    hipGetDevice(&dev);
    hipDeviceGetAttribute(&cus, hipDeviceAttributeMultiprocessorCount, dev);
    hipOccupancyMaxActiveBlocksPerMultiprocessor(&per_cu, mega, 256, 0);
    if (per_cu < 1) per_cu = 1;
    grid_blocks = cus * per_cu;
  }
#if MK_COOP
  int pb = 0, pe = 11;
  void* args[] = {&p, &pb, &pe};
  hipError_t e = hipLaunchCooperativeKernel((void*)mega, dim3(grid_blocks), dim3(256), args, 0, stream);
  if (e != hipSuccess) fprintf(stderr, "cooperative launch failed: %s (grid %d)\n", hipGetErrorString(e), grid_blocks);
#else
  for (int ph = 0; ph < 11; ++ph) mega<<<dim3(grid_blocks), dim3(256), 0, stream>>>(p, ph, ph + 1);
#endif
}
```

```cpp
#include <hip/hip_runtime.h>
#include <hip/hip_cooperative_groups.h>
#include <stdint.h>
#include <stdio.h>
namespace cg = cooperative_groups;

#ifndef MK_COOP
#define MK_COOP 1
#endif

typedef __attribute__((ext_vector_type(8))) short bf16x8;
typedef __attribute__((ext_vector_type(4))) short bf16x4;
typedef __attribute__((ext_vector_type(16))) float f32x16;
typedef __attribute__((ext_vector_type(2))) __bf16 bf2_t;
typedef __attribute__((ext_vector_type(2))) float f2_t;
typedef unsigned short u16;
typedef __attribute__((ext_vector_type(4))) unsigned u32x4;

#define DI __device__ __forceinline__
#define MFMA32(a, b, c) __builtin_amdgcn_mfma_f32_32x32x16_bf16((a), (b), (c), 0, 0, 0)

DI unsigned pack2(float a, float b) { f2_t v = {a, b}; bf2_t r = __builtin_convertvector(v, bf2_t); return __builtin_bit_cast(unsigned, r); }
DI u16 f2bf(float a) { return (u16)(pack2(a, 0.f) & 0xffffu); }
DI float bflo(unsigned u) { return __uint_as_float(u << 16); }
DI float bfhi(unsigned u) { return __uint_as_float(u & 0xffff0000u); }
DI int crow(int i, int h) { return (i & 3) + 8 * (i >> 2) + 4 * h; }
DI int tid_opaque() { int t = threadIdx.x; asm volatile("" : "+v"(t)); return t; }

struct Params {
  const float *xp, *xs, *pp, *ps, *cak, *cav, *cbk, *cbv, *gpre, *win, *relb, *wout, *gpost, *wple, *wgate;
  float* out;
  unsigned char* ws;
};

constexpr int MP = 32768, MS = 512, MT = 33280;
constexpr float EPS = 1e-6f;

constexpr size_t SZ_ACT = (size_t)MT * 1024 * 2;
constexpr size_t SZ_QKV = (size_t)16 * 8 * 2048 * 64 * 2;
constexpr size_t OFF_WIN = 0;
constexpr size_t OFF_WOUT = OFF_WIN + (size_t)2 * 4096 * 1024 * 2;
constexpr size_t OFF_WGATE = OFF_WOUT + (size_t)2 * 1024 * 1024 * 2;
constexpr size_t OFF_WPLE = OFF_WGATE + (size_t)2 * 1024 * 1024 * 2;
constexpr size_t OFF_R0 = OFF_WPLE + (size_t)2 * 1024 * 256 * 2;
constexpr size_t OFF_R1 = OFF_R0 + SZ_ACT;
constexpr size_t OFF_PB = OFF_R1 + SZ_ACT;
constexpr size_t OFF_PSUM = OFF_PB + (size_t)2 * MT * 256 * 2;
constexpr size_t OFF_QA = OFF_PSUM + (size_t)MT * 16 * 4;
constexpr size_t OFF_KA = OFF_QA + SZ_QKV;
constexpr size_t OFF_VAT = OFF_KA + SZ_QKV;
constexpr size_t OFF_QB = OFF_VAT + SZ_QKV;
constexpr size_t OFF_KB = OFF_QB + SZ_QKV;
constexpr size_t OFF_VBT = OFF_KB + SZ_QKV;
constexpr size_t OFF_QAS = OFF_VBT + SZ_QKV;
constexpr size_t OFF_QBS = OFF_QAS + (size_t)128 * 32 * 64 * 2;
constexpr size_t OFF_KAS = OFF_QBS + (size_t)128 * 32 * 64 * 2;
constexpr size_t OFF_VAST = OFF_KAS + (size_t)2 * 128 * 544 * 64 * 2;
constexpr size_t OFF_KBS = OFF_VAST + (size_t)2 * 128 * 544 * 64 * 2;
constexpr size_t OFF_VBST = OFF_KBS + (size_t)2 * 128 * 1056 * 64 * 2;
constexpr size_t OFF_CTR = OFF_VBST + (size_t)2 * 128 * 1056 * 64 * 2;
constexpr size_t WS_TOTAL = OFF_CTR + 256;
static_assert(WS_TOTAL <= (size_t)536870912, "workspace too large");

constexpr size_t O_AKP = 34078720;
constexpr size_t O_AVP = O_AKP + 8388608;
constexpr size_t O_BKP = O_AVP + 8388608;
constexpr size_t O_BVP = O_BKP + 33554432;
constexpr size_t O_AKS = O_BVP + 33554432;
constexpr size_t O_AVS = O_AKS + 524288;
constexpr size_t O_BKS = O_AVS + 524288;
constexpr size_t O_BVS = O_BKS + 524288;

constexpr int BK = 64, LDT = BK + 8;
constexpr int SMEM_BYTES = 2 * 128 * LDT * 2 + 512;

DI void gemm_mainloop(const u16* __restrict__ A, int lda, const u16* __restrict__ Bt, int ldb, int K,
                      u16* sA, u16* sB, f32x16 (&acc)[2][2]) {
  const int tid = tid_opaque(), lane = tid & 63, wave = tid >> 6, wm = wave >> 1, wn = wave & 1, r = lane & 31, h = lane >> 5;
  const int lrow = tid >> 3, lcol = (tid & 7) * 8;
  const u16* gA = A + (size_t)lrow * lda + lcol;
  const u16* gB = Bt + (size_t)lrow * ldb + lcol;
  u32x4 ra[4], rb[4];
#pragma unroll
  for (int i = 0; i < 4; ++i) {
    ra[i] = *(const u32x4*)(gA + (size_t)(32 * i) * lda);
    rb[i] = *(const u32x4*)(gB + (size_t)(32 * i) * ldb);
  }
#pragma unroll
  for (int a = 0; a < 2; ++a)
#pragma unroll
    for (int b = 0; b < 2; ++b)
#pragma unroll
      for (int i = 0; i < 16; ++i) acc[a][b][i] = 0.f;
  const u16* rA = sA + (64 * wm + r) * LDT + 8 * h;
  const u16* rB = sB + (64 * wn + r) * LDT + 8 * h;
  for (int k0 = 0; k0 < K; k0 += BK) {
    __syncthreads();
#pragma unroll
    for (int i = 0; i < 4; ++i) {
      *(u32x4*)(sA + (lrow + 32 * i) * LDT + lcol) = ra[i];
      *(u32x4*)(sB + (lrow + 32 * i) * LDT + lcol) = rb[i];
    }
    __syncthreads();
    if (k0 + BK < K) {
      gA += BK; gB += BK;
#pragma unroll
      for (int i = 0; i < 4; ++i) {
        ra[i] = *(const u32x4*)(gA + (size_t)(32 * i) * lda);
        rb[i] = *(const u32x4*)(gB + (size_t)(32 * i) * ldb);
      }
    }
#pragma unroll
    for (int ks = 0; ks < 4; ++ks) {
      const bf16x8 a0 = *(const bf16x8*)(rA + 16 * ks);
      const bf16x8 a1 = *(const bf16x8*)(rA + 32 * LDT + 16 * ks);
      const bf16x8 b0 = *(const bf16x8*)(rB + 16 * ks);
      const bf16x8 b1 = *(const bf16x8*)(rB + 32 * LDT + 16 * ks);
      acc[0][0] = MFMA32(a0, b0, acc[0][0]);
      acc[0][1] = MFMA32(a0, b1, acc[0][1]);
      acc[1][0] = MFMA32(a1, b0, acc[1][0]);
      acc[1][1] = MFMA32(a1, b1, acc[1][1]);
    }
  }
}

DI void transpose_tile(const float* __restrict__ src, int sld, u16* __restrict__ dst, int dld,
                       const float* __restrict__ scale, float* sm) {
  const int tid = tid_opaque();
  const int nn = tid & 63, kq = tid >> 6;
#pragma unroll
  for (int i = 0; i < 16; ++i) {
    const int kk = kq + 4 * i;
    float v = src[(size_t)kk * sld + nn];
    if (scale) v *= scale[kk];
    sm[kk * 65 + nn] = v;
  }
  __syncthreads();
  const int kp = (tid & 31) * 2, nq = tid >> 5;
#pragma unroll
  for (int i = 0; i < 8; ++i) {
    const int n2 = nq + 8 * i;
    const unsigned u = pack2(sm[kp * 65 + n2], sm[(kp + 1) * 65 + n2]);
    *(unsigned*)(dst + (size_t)n2 * dld + kp) = u;
  }
  __syncthreads();
}

DI uint4 cvt8(const float* __restrict__ s) {
  const float4 a = *(const float4*)s, b = *(const float4*)(s + 4);
  uint4 o;
  o.x = pack2(a.x, a.y); o.y = pack2(a.z, a.w); o.z = pack2(b.x, b.y); o.w = pack2(b.z, b.w);
  return o;
}

DI void phase0(const Params& p, float* sm) {
  const int tid = tid_opaque();
  unsigned char* ws = p.ws;
  if (blockIdx.x == 0 && tid < 2) ((int*)(ws + OFF_CTR))[tid] = 0;
  for (int j = blockIdx.x; j < 9344; j += gridDim.x) {
    const float* src; u16* dst; const float* scale = nullptr; int sld, dld;
    if (j < 2048) {
      const int l = j >> 10, kt = (j >> 6) & 15, nt = j & 63;
      src = p.win + ((size_t)l * 1024 + kt * 64) * 4096 + nt * 64; sld = 4096;
      dst = (u16*)(ws + OFF_WIN) + ((size_t)l * 4096 + nt * 64) * 1024 + kt * 64; dld = 1024;
      scale = p.gpre + l * 1024 + kt * 64;
    } else if (j < 3072) {
      const int jj = (j - 2048) & 511;
      const bool gate = j >= 2560;
      const int l = jj >> 8, kt = (jj >> 4) & 15, nt = jj & 15;
      src = (gate ? p.wgate : p.wout) + ((size_t)l * 1024 + kt * 64) * 1024 + nt * 64; sld = 1024;
      dst = (u16*)(ws + (gate ? OFF_WGATE : OFF_WOUT)) + ((size_t)l * 1024 + nt * 64) * 1024 + kt * 64; dld = 1024;
    } else if (j < 3200) {
      const int jj = j - 3072;
      const int l = jj >> 6, kt = (jj >> 4) & 3, nt = jj & 15;
      src = p.wple + ((size_t)l * 256 + kt * 64) * 1024 + nt * 64; sld = 1024;
      dst = (u16*)(ws + OFF_WPLE) + ((size_t)l * 1024 + nt * 64) * 256 + kt * 64; dld = 256;
    } else if (j < 5248) {
      const int jj = j - 3200;
      const int lbh = jj >> 3, kt = jj & 7;
      const int lb = lbh >> 3, hd = lbh & 7;
      src = p.cav + ((size_t)lb * 512 + kt * 64) * 512 + hd * 64; sld = 512;
      dst = (u16*)(ws + OFF_VAST) + (size_t)lbh * 64 * 544 + kt * 64; dld = 544;
    } else {
      const int jj = j - 5248;
      const int lbh = jj >> 4, kt = jj & 15;
      const int lb = lbh >> 3, hd = lbh & 7;
      src = p.cbv + ((size_t)lb * 1024 + kt * 64) * 512 + hd * 64; sld = 512;
      dst = (u16*)(ws + OFF_VBST) + (size_t)lbh * 64 * 1056 + kt * 64; dld = 1056;
    }
    transpose_tile(src, sld, dst, dld, scale, sm);
  }
  const size_t gtid = (size_t)blockIdx.x * 256 + tid, gn = (size_t)gridDim.x * 256;
  for (size_t e = gtid; e < (size_t)1048576; e += gn) {
    const int d8 = e & 7, hd = (e >> 3) & 7, s = (e >> 6) & 511, lb = (int)(e >> 15);
    *(uint4*)((u16*)(ws + OFF_KAS) + (((size_t)lb * 8 + hd) * 544 + s) * 64 + d8 * 8) = cvt8(p.cak + e * 8);
  }
  for (size_t e = gtid; e < (size_t)2097152; e += gn) {
    const int d8 = e & 7, hd = (e >> 3) & 7, s = (e >> 6) & 1023, lb = (int)(e >> 16);
    *(uint4*)((u16*)(ws + OFF_KBS) + (((size_t)lb * 8 + hd) * 1056 + s) * 64 + d8 * 8) = cvt8(p.cbk + e * 8);
  }
  for (size_t e = gtid; e < (size_t)2 * MT * 32; e += gn) {
    const int c8 = e & 31;
    const size_t lr = e >> 5;
    const int l = (int)(lr / MT), row = (int)(lr % MT);
    const float* src = row < MP ? p.pp + ((size_t)l * MP + row) * 256 : p.ps + ((size_t)l * MS + (row - MP)) * 256;
    *(uint4*)((u16*)(ws + OFF_PB) + lr * 256 + c8 * 8) = cvt8(src + c8 * 8);
  }
  const int lane = tid & 63;
  const int gw = (int)(gtid >> 6), nw = (int)(gn >> 6);
  for (int row = gw; row < MT; row += nw) {
    const float* src = row < MP ? p.xp + (size_t)row * 1024 : p.xs + (size_t)(row - MP) * 1024;
    u16* dst = (u16*)(ws + OFF_R0) + (size_t)row * 1024;
    float ss = 0.f;
#pragma unroll
    for (int j = 0; j < 2; ++j) {
      const int c = 8 * lane + 512 * j;
      const float4 a = *(const float4*)(src + c), b = *(const float4*)(src + c + 4);
      ss += a.x * a.x + a.y * a.y + a.z * a.z + a.w * a.w + b.x * b.x + b.y * b.y + b.z * b.z + b.w * b.w;
      uint4 o;
      o.x = pack2(a.x, a.y); o.y = pack2(a.z, a.w); o.z = pack2(b.x, b.y); o.w = pack2(b.z, b.w);
      *(uint4*)(dst + c) = o;
    }
#pragma unroll
    for (int m = 32; m >= 1; m >>= 1) ss += __shfl_xor(ss, m);
    if (lane < 16) ((float*)(ws + OFF_PSUM))[(size_t)row * 16 + lane] = lane == 0 ? ss : 0.f;
  }
}

DI void p1_tile(const Params& p, int layer, int tile, u16* sA, u16* sB, float* rstd_s, const u16* HB, u16* Gbuf) {
  const int tid = tid_opaque();
  const int mt = tile >> 5, nt = tile & 31;
  const int m0 = mt * 128, n0 = nt * 128;
  unsigned char* ws = p.ws;
  __syncthreads();
  if (tid < 128) {
    const float4* ps = (const float4*)((const float*)(ws + OFF_PSUM) + (size_t)(m0 + tid) * 16);
    float s = 0.f;
#pragma unroll
    for (int j = 0; j < 4; ++j) { const float4 v = ps[j]; s += v.x + v.y + v.z + v.w; }
    rstd_s[tid] = rsqrtf(s * (1.0f / 1024.0f) + EPS);
  }
  f32x16 acc[2][2];
  gemm_mainloop(HB + (size_t)m0 * 1024, 1024, (const u16*)(ws + OFF_WIN) + ((size_t)layer * 4096 + n0) * 1024, 1024, 1024, sA, sB, acc);

  int tl = tid_opaque();
  const int lane = tl & 63, wave = tl >> 6, wm = wave >> 1, wn = wave & 1, r = lane & 31, h = lane >> 5;
  const int seg = n0 >> 9, kind = seg & 3, grp = seg >> 2;
  const int hd = ((n0 & 511) >> 6) + wn;
  const bool prompt = m0 < MP;
  float* out = p.out;
#pragma unroll
  for (int rb = 0; rb < 2; ++rb) {
    const int lrow0 = 64 * wm + 32 * rb;
    const int row0 = m0 + lrow0;
    int b, s0;
    if (prompt) { b = row0 >> 11; s0 = row0 & 2047; } else { b = (row0 - MP) >> 5; s0 = 0; }
    const int lb = layer * 16 + b;
    if (kind == 3) {
#pragma unroll
      for (int cb = 0; cb < 2; ++cb)
#pragma unroll
        for (int i = 0; i < 16; ++i) {
          const int t = crow(i, h);
          const float v = acc[rb][cb][i] * rstd_s[lrow0 + t];
          const float sv = v / (1.0f + __expf(-v));
          Gbuf[(size_t)(row0 + t) * 1024 + grp * 512 + hd * 64 + 32 * cb + r] = f2bf(sv);
        }
    } else if (kind == 0) {
      u16* base;
      if (prompt) base = (u16*)(ws + (grp ? OFF_QB : OFF_QA)) + (((size_t)b * 8 + hd) * 2048 + s0) * 64;
      else base = (u16*)(ws + (grp ? OFF_QBS : OFF_QAS)) + (((size_t)b * 8 + hd) * 32) * 64;
#pragma unroll
      for (int cb = 0; cb < 2; ++cb)
#pragma unroll
        for (int i = 0; i < 16; ++i) {
          const int t = crow(i, h);
          const float v = acc[rb][cb][i] * rstd_s[lrow0 + t] * 0.125f;
          base[t * 64 + 32 * cb + r] = f2bf(v);
        }
    } else {
      float* fo = nullptr;
      if (prompt) {
        if (grp == 0) {
          if (s0 >= 1536) fo = out + (kind == 1 ? O_AKP : O_AVP) + ((size_t)lb * 512 + (s0 - 1536)) * 512 + hd * 64;
        } else {
          fo = out + (kind == 1 ? O_BKP : O_BVP) + ((size_t)lb * 2048 + s0) * 512 + hd * 64;
        }
      } else {
        if (grp == 0) fo = out + (kind == 1 ? O_AKS : O_AVS) + ((size_t)lb * 32) * 512 + hd * 64;
        else fo = out + (kind == 1 ? O_BKS : O_BVS) + ((size_t)lb * 32) * 512 + hd * 64;
      }
      if (kind == 1) {
        u16* base;
        if (prompt) base = (u16*)(ws + (grp ? OFF_KB : OFF_KA)) + (((size_t)b * 8 + hd) * 2048 + s0) * 64;
        else if (grp == 0) base = (u16*)(ws + OFF_KAS) + (((size_t)lb * 8 + hd) * 544 + 512) * 64;
        else base = (u16*)(ws + OFF_KBS) + (((size_t)lb * 8 + hd) * 1056 + 1024) * 64;
#pragma unroll
        for (int cb = 0; cb < 2; ++cb)
#pragma unroll
          for (int i = 0; i < 16; ++i) {
            const int t = crow(i, h);
            const float v = acc[rb][cb][i] * rstd_s[lrow0 + t];
            base[t * 64 + 32 * cb + r] = f2bf(v);
            if (fo) fo[(size_t)t * 512 + 32 * cb + r] = v;
          }
      } else {
        u16* base; int ldv;
        if (prompt) { base = (u16*)(ws + (grp ? OFF_VBT : OFF_VAT)) + (((size_t)b * 8 + hd) * 64) * 2048 + s0; ldv = 2048; }
        else if (grp == 0) { base = (u16*)(ws + OFF_VAST) + (((size_t)lb * 8 + hd) * 64) * 544 + 512; ldv = 544; }
        else { base = (u16*)(ws + OFF_VBST) + (((size_t)lb * 8 + hd) * 64) * 1056 + 1024; ldv = 1056; }
#pragma unroll
        for (int cb = 0; cb < 2; ++cb)
#pragma unroll
          for (int g = 0; g < 4; ++g) {
            const int t0 = 8 * g + 4 * h;
            float v[4];
#pragma unroll
            for (int j = 0; j < 4; ++j) {
              v[j] = acc[rb][cb][4 * g + j] * rstd_s[lrow0 + t0 + j];
              if (fo) fo[(size_t)(t0 + j) * 512 + 32 * cb + r] = v[j];
            }
            uint2 o; o.x = pack2(v[0], v[1]); o.y = pack2(v[2], v[3]);
            *(uint2*)(base + (size_t)(32 * cb + r) * ldv + t0) = o;
          }
      }
    }
  }
}

DI void attn_store(const f32x16& o0, const f32x16& o1, float scale, const u16* Gp, u16* Mp, int r, int h) {
#pragma unroll
  for (int db = 0; db < 2; ++db)
#pragma unroll
    for (int g = 0; g < 4; ++g) {
      const int d0 = 32 * db + 8 * g + 4 * h;
      const uint2 gv = *(const uint2*)(Gp + (size_t)r * 1024 + d0);
      const float x0 = (db ? o1[4 * g] : o0[4 * g]) * scale * bflo(gv.x);
      const float x1 = (db ? o1[4 * g + 1] : o0[4 * g + 1]) * scale * bfhi(gv.x);
      const float x2 = (db ? o1[4 * g + 2] : o0[4 * g + 2]) * scale * bflo(gv.y);
      const float x3 = (db ? o1[4 * g + 3] : o0[4 * g + 3]) * scale * bfhi(gv.y);
      uint2 o; o.x = pack2(x0, x1); o.y = pack2(x2, x3);
      *(uint2*)(Mp + (size_t)r * 1024 + d0) = o;
    }
}

DI bf16x8 ldv8(const u16* vp) {
  const bf16x4 lo = *(const bf16x4*)vp;
  const bf16x4 hi = *(const bf16x4*)(vp + 8);
  return __builtin_shufflevector(lo, hi, 0, 1, 2, 3, 4, 5, 6, 7);
}

DI bf16x8 pack8(const float* v) {
  uint4 u;
  u.x = pack2(v[0], v[1]); u.y = pack2(v[2], v[3]); u.z = pack2(v[4], v[5]); u.w = pack2(v[6], v[7]);
  return __builtin_bit_cast(bf16x8, u);
}

DI void sb_item(const u16* __restrict__ Q, const u16* __restrict__ Kb, const u16* __restrict__ VT, int ldv,
                int qpos0, int ntiles, const u16* Gp, u16* Mp) {
  const int lane = tid_opaque() & 63, r = lane & 31, h = lane >> 5;
  bf16x8 qf[4];
#pragma unroll
  for (int ks = 0; ks < 4; ++ks) qf[ks] = *(const bf16x8*)(Q + r * 64 + 16 * ks + 8 * h);
  bf16x8 tf[2];
#pragma unroll
  for (int s = 0; s < 2; ++s)
#pragma unroll
    for (int j = 0; j < 8; ++j) tf[s][j] = (16 * s + 8 * (j >> 2) + 4 * h + (j & 3) > r) ? (short)0x3F80 : (short)0;
  f32x16 o0, o1;
#pragma unroll
  for (int i = 0; i < 16; ++i) { o0[i] = 0.f; o1[i] = 0.f; }
  float carry = 0.f;
  const int qpos = qpos0 + r;
  for (int kt = ntiles - 1; kt >= 0; --kt) {
    const int k0 = kt * 32;
    f32x16 st;
#pragma unroll
    for (int i = 0; i < 16; ++i) st[i] = 0.f;
    const u16* kp = Kb + (size_t)(k0 + r) * 64 + 8 * h;
#pragma unroll
    for (int ks = 0; ks < 4; ++ks) {
      const bf16x8 kf = *(const bf16x8*)(kp + 16 * ks);
      st = MFMA32(kf, qf[ks], st);
    }
    bf16x8 vf[2][2];
#pragma unroll
    for (int db = 0; db < 2; ++db)
#pragma unroll
      for (int s = 0; s < 2; ++s) vf[db][s] = ldv8(VT + (size_t)(32 * db + r) * ldv + k0 + 16 * s + 4 * h);
    float l1m[16], lb[16];
    float csum = 0.f;
#pragma unroll
    for (int i = 0; i < 16; ++i) {
      const float z = st[i];
      const bool c = (k0 + crow(i, h)) < qpos;
      const float e = __expf(-fabsf(z));
      const float sp = fmaxf(z, 0.f) + __logf(1.0f + e);
      l1m[i] = c ? -sp : 0.f;
      lb[i] = c ? (z - sp) : -1e30f;
      csum += l1m[i];
    }
    csum += __shfl_xor(csum, 32);
    f32x16 af;
#pragma unroll
    for (int i = 0; i < 16; ++i) af[i] = 0.f;
    af = MFMA32(tf[0], pack8(l1m), af);
    af = MFMA32(tf[1], pack8(l1m + 8), af);
    float w[16];
#pragma unroll
    for (int i = 0; i < 16; ++i) w[i] = __expf(lb[i] + af[i] + carry);
    carry += csum;
    const bf16x8 w0 = pack8(w), w1 = pack8(w + 8);
    o0 = MFMA32(vf[0][0], w0, o0);
    o0 = MFMA32(vf[0][1], w1, o0);
    o1 = MFMA32(vf[1][0], w0, o1);
    o1 = MFMA32(vf[1][1], w1, o1);
  }
  attn_store(o0, o1, 1.0f, Gp, Mp, r, h);
}

DI void band_item(const u16* __restrict__ Q, const u16* __restrict__ Kb, const u16* __restrict__ VT, int ldv,
                  int kt_begin, int kt_end, int relbase, const float* __restrict__ bias, const u16* Gp, u16* Mp) {
  const int lane = tid_opaque() & 63, r = lane & 31, h = lane >> 5;
  bf16x8 qf[4];
#pragma unroll
  for (int ks = 0; ks < 4; ++ks) qf[ks] = *(const bf16x8*)(Q + r * 64 + 16 * ks + 8 * h);
  f32x16 o0, o1;
#pragma unroll
  for (int i = 0; i < 16; ++i) { o0[i] = 0.f; o1[i] = 0.f; }
  float m = -1e30f, l = 0.f;
  const float b0 = bias[0];
  for (int kt = kt_begin; kt < kt_end; ++kt) {
    const int k0 = kt * 32;
    f32x16 st;
#pragma unroll
    for (int i = 0; i < 16; ++i) st[i] = 0.f;
    const u16* kp = Kb + (size_t)(k0 + r) * 64 + 8 * h;
#pragma unroll
    for (int ks = 0; ks < 4; ++ks) {
      const bf16x8 kf = *(const bf16x8*)(kp + 16 * ks);
      st = MFMA32(kf, qf[ks], st);
    }
    bf16x8 vf[2][2];
#pragma unroll
    for (int db = 0; db < 2; ++db)
#pragma unroll
      for (int s = 0; s < 2; ++s) vf[db][s] = ldv8(VT + (size_t)(32 * db + r) * ldv + k0 + 16 * s + 4 * h);
    float sv[16];
    if (k0 + 31 + relbase <= -128) {
#pragma unroll
      for (int i = 0; i < 16; ++i) sv[i] = st[i] + b0;
    } else {
      const int relc = k0 + relbase - r;
#pragma unroll
      for (int i = 0; i < 16; ++i) {
        int rel = relc + crow(i, h);
        rel = min(max(rel, -128), 128) + 128;
        sv[i] = st[i] + bias[rel];
      }
    }
    float mt = sv[0];
#pragma unroll
    for (int i = 1; i < 16; ++i) mt = fmaxf(mt, sv[i]);
    mt = fmaxf(mt, __shfl_xor(mt, 32));
    const float mnew = fmaxf(m, mt);
    const float alpha = __expf(m - mnew);
    m = mnew;
    float ps = 0.f;
#pragma unroll
    for (int i = 0; i < 16; ++i) { sv[i] = __expf(sv[i] - mnew); ps += sv[i]; }
    l = l * alpha + ps;
#pragma unroll
    for (int i = 0; i < 16; ++i) { o0[i] *= alpha; o1[i] *= alpha; }
    const bf16x8 w0 = pack8(sv), w1 = pack8(sv + 8);
    o0 = MFMA32(vf[0][0], w0, o0);
    o0 = MFMA32(vf[0][1], w1, o0);
    o1 = MFMA32(vf[1][0], w0, o1);
    o1 = MFMA32(vf[1][1], w1, o1);
  }
  l += __shfl_xor(l, 32);
  attn_store(o0, o1, 1.0f / l, Gp, Mp, r, h);
}

constexpr int N_ITEMS = 16640;

DI void phase2(const Params& p, int layer, const u16* Gbuf, u16* MIX) {
  unsigned char* ws = p.ws;
  int* ctr = (int*)(ws + OFF_CTR) + layer;
  const int lane = tid_opaque() & 63;
  for (;;) {
    int idx = 0;
    if (lane == 0) idx = atomicAdd(ctr, 1);
    idx = __shfl(idx, 0);
    if (idx >= N_ITEMS) break;
    if (idx < 128) {
      const int bh = idx, b = bh >> 3, hd = bh & 7;
      const size_t row0 = (size_t)MP + b * 32;
      sb_item((const u16*)(ws + OFF_QBS) + (size_t)bh * 32 * 64,
              (const u16*)(ws + OFF_KBS) + ((size_t)layer * 128 + bh) * 1056 * 64,
              (const u16*)(ws + OFF_VBST) + ((size_t)layer * 128 + bh) * 64 * 1056, 1056,
              1024, 33, Gbuf + row0 * 1024 + 512 + hd * 64, MIX + row0 * 1024 + 512 + hd * 64);
    } else if (idx < 8320) {
      const int j = idx - 128, bh = j >> 6, qt = 63 - (j & 63), b = bh >> 3, hd = bh & 7;
      const size_t row0 = (size_t)b * 2048 + qt * 32;
      sb_item((const u16*)(ws + OFF_QB) + ((size_t)bh * 2048 + qt * 32) * 64,
              (const u16*)(ws + OFF_KB) + (size_t)bh * 2048 * 64,
              (const u16*)(ws + OFF_VBT) + (size_t)bh * 64 * 2048, 2048,
              qt * 32, qt + 1, Gbuf + row0 * 1024 + 512 + hd * 64, MIX + row0 * 1024 + 512 + hd * 64);
    } else if (idx < 8448) {
      const int bh = idx - 8320, b = bh >> 3, hd = bh & 7;
      const size_t row0 = (size_t)MP + b * 32;
      band_item((const u16*)(ws + OFF_QAS) + (size_t)bh * 32 * 64,
                (const u16*)(ws + OFF_KAS) + ((size_t)layer * 128 + bh) * 544 * 64,
                (const u16*)(ws + OFF_VAST) + ((size_t)layer * 128 + bh) * 64 * 544, 544,
                0, 17, -512, p.relb + (size_t)(layer * 8 + hd) * 257,
                Gbuf + row0 * 1024 + hd * 64, MIX + row0 * 1024 + hd * 64);
    } else {
      const int j = idx - 8448, bh = j >> 6, qt = j & 63, b = bh >> 3, hd = bh & 7;
      const int c = qt >> 1;
      const size_t row0 = (size_t)b * 2048 + qt * 32;
      band_item((const u16*)(ws + OFF_QA) + ((size_t)bh * 2048 + qt * 32) * 64,
                (const u16*)(ws + OFF_KA) + (size_t)bh * 2048 * 64,
                (const u16*)(ws + OFF_VAT) + (size_t)bh * 64 * 2048, 2048,
                2 * max(0, c - 8), 2 * c + 2, -qt * 32, p.relb + (size_t)(layer * 8 + hd) * 257,
                Gbuf + row0 * 1024 + hd * 64, MIX + row0 * 1024 + hd * 64);
    }
  }
}

DI void p3_tile(const Params& p, int layer, int tile, u16* sA, u16* sB, const u16* MIX, u16* Y) {
  const int mt = tile >> 3, nt = tile & 7;
  const int m0 = mt * 128, n0 = nt * 128;
  f32x16 acc[2][2];
  gemm_mainloop(MIX + (size_t)m0 * 1024, 1024, (const u16*)(p.ws + OFF_WOUT) + ((size_t)layer * 1024 + n0) * 1024, 1024, 1024, sA, sB, acc);
  int tl = tid_opaque();
  const int lane = tl & 63, wave = tl >> 6, wm = wave >> 1, wn = wave & 1, r = lane & 31, h = lane >> 5;
#pragma unroll
  for (int rb = 0; rb < 2; ++rb)
#pragma unroll
    for (int cb = 0; cb < 2; ++cb)
#pragma unroll
      for (int i = 0; i < 16; ++i) {
        const int row = m0 + 64 * wm + 32 * rb + crow(i, h);
        Y[(size_t)row * 1024 + n0 + 64 * wn + 32 * cb + r] = f2bf(acc[rb][cb][i]);
      }
}

DI void phase4(const Params& p, int layer, const u16* Y, u16* H1B) {
  const int tid = tid_opaque(), lane = tid & 63;
  const int gw = (blockIdx.x * 256 + tid) >> 6, nw = (gridDim.x * 256) >> 6;
  const float* gp = p.gpost + layer * 1024;
  for (int row = gw; row < MT; row += nw) {
    const u16* yr = Y + (size_t)row * 1024;
    float yf[16];
    float ss = 0.f;
#pragma unroll
    for (int j = 0; j < 2; ++j) {
      const uint4 u = *(const uint4*)(yr + 8 * lane + 512 * j);
      yf[8 * j + 0] = bflo(u.x); yf[8 * j + 1] = bfhi(u.x); yf[8 * j + 2] = bflo(u.y); yf[8 * j + 3] = bfhi(u.y);
      yf[8 * j + 4] = bflo(u.z); yf[8 * j + 5] = bfhi(u.z); yf[8 * j + 6] = bflo(u.w); yf[8 * j + 7] = bfhi(u.w);
    }
#pragma unroll
    for (int i = 0; i < 16; ++i) ss += yf[i] * yf[i];
#pragma unroll
    for (int m = 32; m >= 1; m >>= 1) ss += __shfl_xor(ss, m);
    const float rs = rsqrtf(ss * (1.0f / 1024.0f) + EPS);
    const float* hs;
    if (layer == 0) hs = row < MP ? p.xp + (size_t)row * 1024 : p.xs + (size_t)(row - MP) * 1024;
    else hs = p.out + (size_t)row * 1024;
    float* ho = p.out + (size_t)row * 1024;
#pragma unroll
    for (int j = 0; j < 2; ++j) {
      const int c = 8 * lane + 512 * j;
      const float4 a = *(const float4*)(hs + c), b = *(const float4*)(hs + c + 4);
      const float4 ga = *(const float4*)(gp + c), gb = *(const float4*)(gp + c + 4);
      float4 oa, ob;
      oa.x = a.x + yf[8 * j + 0] * rs * ga.x; oa.y = a.y + yf[8 * j + 1] * rs * ga.y;
      oa.z = a.z + yf[8 * j + 2] * rs * ga.z; oa.w = a.w + yf[8 * j + 3] * rs * ga.w;
      ob.x = b.x + yf[8 * j + 4] * rs * gb.x; ob.y = b.y + yf[8 * j + 5] * rs * gb.y;
      ob.z = b.z + yf[8 * j + 6] * rs * gb.z; ob.w = b.w + yf[8 * j + 7] * rs * gb.w;
      *(float4*)(ho + c) = oa; *(float4*)(ho + c + 4) = ob;
      uint4 o;
      o.x = pack2(oa.x, oa.y); o.y = pack2(oa.z, oa.w); o.z = pack2(ob.x, ob.y); o.w = pack2(ob.z, ob.w);
      *(uint4*)(H1B + (size_t)row * 1024 + c) = o;
    }
  }
}

DI void p5_tile(const Params& p, int layer, int tile, u16* sA, u16* sB, const u16* H1B, u16* HBN) {
  const int mt = tile >> 3, nt = tile & 7;
  const int m0 = mt * 128, n0 = nt * 128;
  unsigned char* ws = p.ws;
  f32x16 acc[2][2];
  gemm_mainloop((const u16*)(ws + OFF_PB) + ((size_t)layer * MT + m0) * 256, 256,
                (const u16*)(ws + OFF_WPLE) + ((size_t)layer * 1024 + n0) * 256, 256, 256, sA, sB, acc);
  unsigned pl[2][2][8];
#pragma unroll
  for (int rb = 0; rb < 2; ++rb)
#pragma unroll
    for (int cb = 0; cb < 2; ++cb)
#pragma unroll
      for (int j = 0; j < 8; ++j) pl[rb][cb][j] = pack2(acc[rb][cb][2 * j], acc[rb][cb][2 * j + 1]);
  gemm_mainloop(H1B + (size_t)m0 * 1024, 1024, (const u16*)(ws + OFF_WGATE) + ((size_t)layer * 1024 + n0) * 1024, 1024, 1024, sA, sB, acc);
  int tl = tid_opaque();
  const int lane = tl & 63, wave = tl >> 6, wm = wave >> 1, wn = wave & 1, r = lane & 31, h = lane >> 5;
  float sq[32];
#pragma unroll
  for (int rb = 0; rb < 2; ++rb)
#pragma unroll
    for (int i = 0; i < 16; ++i) {
      const int row = m0 + 64 * wm + 32 * rb + crow(i, h);
      float s2 = 0.f;
#pragma unroll
      for (int cb = 0; cb < 2; ++cb) {
        const int col = n0 + 64 * wn + 32 * cb + r;
        float* hp = p.out + (size_t)row * 1024 + col;
        const float h1 = *hp;
        const float pv = (i & 1) ? bfhi(pl[rb][cb][i >> 1]) : bflo(pl[rb][cb][i >> 1]);
        const float g = 1.0f / (1.0f + __expf(-acc[rb][cb][i]));
        const float h2 = h1 + g * pv;
        *hp = h2;
        if (layer == 0) HBN[(size_t)row * 1024 + col] = f2bf(h2);
        s2 += h2 * h2;
      }
      sq[rb * 16 + i] = s2;
    }
  if (layer == 0) {
#pragma unroll
    for (int j = 0; j < 16; ++j) {
      const float send = (r & 16) ? sq[j] : sq[j + 16];
      const float keep = (r & 16) ? sq[j + 16] : sq[j];
      sq[j] = keep + __shfl_xor(send, 16);
    }
#pragma unroll
    for (int j = 0; j < 8; ++j) {
      const float send = (r & 8) ? sq[j] : sq[j + 8];
      const float keep = (r & 8) ? sq[j + 8] : sq[j];
      sq[j] = keep + __shfl_xor(send, 8);
    }
#pragma unroll
    for (int j = 0; j < 4; ++j) {
      const float send = (r & 4) ? sq[j] : sq[j + 4];
      const float keep = (r & 4) ? sq[j + 4] : sq[j];
      sq[j] = keep + __shfl_xor(send, 4);
    }
#pragma unroll
    for (int j = 0; j < 2; ++j) {
      const float send = (r & 2) ? sq[j] : sq[j + 2];
      const float keep = (r & 2) ? sq[j + 2] : sq[j];
      sq[j] = keep + __shfl_xor(send, 2);
    }
    {
      const float send = (r & 1) ? sq[0] : sq[1];
      const float keep = (r & 1) ? sq[1] : sq[0];
      sq[0] = keep + __shfl_xor(send, 1);
    }
    const int row = m0 + 64 * wm + 32 * (r >> 4) + crow(r & 15, h);
    ((float*)(ws + OFF_PSUM))[(size_t)row * 16 + nt * 2 + wn] = sq[0];
  }
}

__global__ void __launch_bounds__(256, 2) mega(Params p, int ph_begin, int ph_end) {
  __shared__ __attribute__((aligned(16))) unsigned char smem[SMEM_BYTES];
  u16* sA = (u16*)smem;
  u16* sB = sA + 128 * LDT;
  float* rstd_s = (float*)(smem + 2 * 128 * LDT * 2);
  unsigned char* ws = p.ws;
#define PHASE_GATE(PH) if ((PH) >= ph_begin && (PH) < ph_end) { if ((PH) > ph_begin) cg::this_grid().sync();
  PHASE_GATE(0) phase0(p, (float*)smem); }
#pragma unroll 1
  for (int layer = 0; layer < 2; ++layer) {
    asm volatile("" : "+s"(layer));
    u16* RA = (u16*)(ws + ((layer & 1) ? OFF_R1 : OFF_R0));
    u16* RB = (u16*)(ws + ((layer & 1) ? OFF_R0 : OFF_R1));
    const int pb = 1 + 5 * layer;
    PHASE_GATE(pb + 0)
#pragma unroll 1
      for (int t = blockIdx.x; t < 260 * 32; t += gridDim.x) p1_tile(p, layer, t, sA, sB, rstd_s, RA, RB);
    }
    PHASE_GATE(pb + 1) phase2(p, layer, RB, RA); }
    PHASE_GATE(pb + 2)
#pragma unroll 1
      for (int t = blockIdx.x; t < 260 * 8; t += gridDim.x) p3_tile(p, layer, t, sA, sB, RA, RB);
    }
    PHASE_GATE(pb + 3) phase4(p, layer, RB, RA); }
    PHASE_GATE(pb + 4)
#pragma unroll 1
      for (int t = blockIdx.x; t < 260 * 8; t += gridDim.x) p5_tile(p, layer, t, sA, sB, RA, RB);
    }
  }
}

extern "C" void kernel_launch(void* const* d_in, const int* in_sizes, int n_in, void* d_out, int out_size,
                              void* d_ws, size_t ws_size, hipStream_t stream) {
  Params p{};
  p.xp = (const float*)d_in[0]; p.xs = (const float*)d_in[1]; p.pp = (const float*)d_in[2]; p.ps = (const float*)d_in[3];
  p.cak = (const float*)d_in[4]; p.cav = (const float*)d_in[5]; p.cbk = (const float*)d_in[6]; p.cbv = (const float*)d_in[7];
  p.gpre = (const float*)d_in[8]; p.win = (const float*)d_in[9]; p.relb = (const float*)d_in[10]; p.wout = (const float*)d_in[11];
  p.gpost = (const float*)d_in[12]; p.wple = (const float*)d_in[13]; p.wgate = (const float*)d_in[14];
  p.out = (float*)d_out;
  p.ws = (unsigned char*)d_ws;
  static int grid_blocks = 0;
  if (!grid_blocks) {
    int dev = 0, cus = 0, per_cu = 0;
    hipGetDevice(&dev);
    hipDeviceGetAttribute(&cus, hipDeviceAttributeMultiprocessorCount, dev);
    hipOccupancyMaxActiveBlocksPerMultiprocessor(&per_cu, mega, 256, 0);
    if (per_cu < 1) per_cu = 1;
    grid_blocks = cus * per_cu;
  }
#if MK_COOP
  int pb = 0, pe = 11;
  void* args[] = {&p, &pb, &pe};
  hipError_t e = hipLaunchCooperativeKernel((void*)mega, dim3(grid_blocks), dim3(256), args, 0, stream);
  if (e != hipSuccess) fprintf(stderr, "cooperative launch failed: %s (grid %d)\n", hipGetErrorString(e), grid_blocks);
#else
  for (int ph = 0; ph < 11; ++ph) mega<<<dim3(grid_blocks), dim3(256), 0, stream>>>(p, ph, ph + 1);
#endif
}
```

```cpp
#include <hip/hip_runtime.h>
#include <hip/hip_cooperative_groups.h>
#include <stdint.h>
#include <stdio.h>
namespace cg = cooperative_groups;

#ifndef MK_COOP
#define MK_COOP 1
#endif

typedef __attribute__((ext_vector_type(8))) short bf16x8;
typedef __attribute__((ext_vector_type(4))) short bf16x4;
typedef __attribute__((ext_vector_type(16))) float f32x16;
typedef __attribute__((ext_vector_type(2))) __bf16 bf2_t;
typedef __attribute__((ext_vector_type(2))) float f2_t;
typedef unsigned short u16;
typedef __attribute__((ext_vector_type(4))) unsigned u32x4;

#define DI __device__ __forceinline__
#define MFMA32(a, b, c) __builtin_amdgcn_mfma_f32_32x32x16_bf16((a), (b), (c), 0, 0, 0)

DI unsigned pack2(float a, float b) { f2_t v = {a, b}; bf2_t r = __builtin_convertvector(v, bf2_t); return __builtin_bit_cast(unsigned, r); }
DI u16 f2bf(float a) { return (u16)(pack2(a, 0.f) & 0xffffu); }
DI float bflo(unsigned u) { return __uint_as_float(u << 16); }
DI float bfhi(unsigned u) { return __uint_as_float(u & 0xffff0000u); }
DI int crow(int i, int h) { return (i & 3) + 8 * (i >> 2) + 4 * h; }
DI int tid_opaque() { int t = threadIdx.x; asm volatile("" : "+v"(t)); return t; }

struct Params {
  const float *xp, *xs, *pp, *ps, *cak, *cav, *cbk, *cbv, *gpre, *win, *relb, *wout, *gpost, *wple, *wgate;
  float* out;
  unsigned char* ws;
};

constexpr int MP = 32768, MS = 512, MT = 33280;
constexpr float EPS = 1e-6f;

#define XCD_BAR_WORDS 3456
constexpr size_t SZ_ACT = (size_t)MT * 1024 * 2;
constexpr size_t SZ_QKV = (size_t)16 * 8 * 2048 * 64 * 2;
constexpr size_t OFF_WIN = 0;
constexpr size_t OFF_WOUT = OFF_WIN + (size_t)2 * 4096 * 1024 * 2;
constexpr size_t OFF_WGATE = OFF_WOUT + (size_t)2 * 1024 * 1024 * 2;
constexpr size_t OFF_WPLE = OFF_WGATE + (size_t)2 * 1024 * 1024 * 2;
constexpr size_t OFF_R0 = OFF_WPLE + (size_t)2 * 1024 * 256 * 2;
constexpr size_t OFF_R1 = OFF_R0 + SZ_ACT;
constexpr size_t OFF_PB = OFF_R1 + SZ_ACT;
constexpr size_t OFF_PSUM = OFF_PB + (size_t)2 * MT * 256 * 2;
constexpr size_t OFF_QA = OFF_PSUM + (size_t)MT * 16 * 4;
constexpr size_t OFF_KA = OFF_QA + SZ_QKV;
constexpr size_t OFF_VAT = OFF_KA + SZ_QKV;
constexpr size_t OFF_QB = OFF_VAT + SZ_QKV;
constexpr size_t OFF_KB = OFF_QB + SZ_QKV;
constexpr size_t OFF_VBT = OFF_KB + SZ_QKV;
constexpr size_t OFF_QAS = OFF_VBT + SZ_QKV;
constexpr size_t OFF_QBS = OFF_QAS + (size_t)128 * 32 * 64 * 2;
constexpr size_t OFF_KAS = OFF_QBS + (size_t)128 * 32 * 64 * 2;
constexpr size_t OFF_VAST = OFF_KAS + (size_t)2 * 128 * 544 * 64 * 2;
constexpr size_t OFF_KBS = OFF_VAST + (size_t)2 * 128 * 544 * 64 * 2;
constexpr size_t OFF_VBST = OFF_KBS + (size_t)2 * 128 * 1056 * 64 * 2;
constexpr size_t OFF_CTR = OFF_VBST + (size_t)2 * 128 * 1056 * 64 * 2;
constexpr size_t OFF_BAR = OFF_CTR + 256;
constexpr size_t WS_TOTAL = OFF_BAR + (size_t)XCD_BAR_WORDS * 4;
static_assert(WS_TOTAL <= (size_t)536870912, "workspace too large");

constexpr size_t O_AKP = 34078720;
constexpr size_t O_AVP = O_AKP + 8388608;
constexpr size_t O_BKP = O_AVP + 8388608;
constexpr size_t O_BVP = O_BKP + 33554432;
constexpr size_t O_AKS = O_BVP + 33554432;
constexpr size_t O_AVS = O_AKS + 524288;
constexpr size_t O_BKS = O_AVS + 524288;
constexpr size_t O_BVS = O_BKS + 524288;


#define XB_TMO      128
#define XB_XCNT(j)  (256  + 64 * (j))
#define XB_XSUB(j)  (1280 + 64 * (j))
#define XB_XGEN(j)  (2304 + 64 * (j))
#define XB_TOP      3328
#define XB_TOPGEN   3392
#define XB_SPIN_CAP (1u << 22)
#define LAS __attribute__((address_space(3)))
DI unsigned xb_ld(unsigned* p) { return __hip_atomic_load(p, __ATOMIC_RELAXED, __HIP_MEMORY_SCOPE_AGENT); }
DI unsigned xb_add(unsigned* p, unsigned v) { return __hip_atomic_fetch_add(p, v, __ATOMIC_RELAXED, __HIP_MEMORY_SCOPE_AGENT); }
DI unsigned xb_xcc_id() { return (unsigned)__builtin_amdgcn_s_getreg((3 << 11) | 20) & 0xFu; }
#define XB_SPIN(cond, bar) do { unsigned _sp = 0; while (cond) { __builtin_amdgcn_s_sleep(1); \
    if ((++_sp & 255u) == 0u) { if (xb_ld(&(bar)[XB_TMO])) break; if (_sp > XB_SPIN_CAP) { atomicAdd(&(bar)[XB_TMO], 1u); break; } } } } while (0)
struct XcdBarrier { unsigned* bar; unsigned x; volatile LAS unsigned* st; };
DI XcdBarrier xcd_barrier_post(unsigned* bar, volatile LAS unsigned* st) {
  XcdBarrier b; b.bar = bar; b.x = xb_xcc_id(); b.st = st;
  if (threadIdx.x == 0) (void)xb_add(&bar[XB_XCNT(b.x)], 1u);
  return b;
}
DI void xcd_barrier_complete(unsigned* bar, unsigned x, unsigned& nloc, unsigned& nx) {
  const unsigned G = gridDim.x * gridDim.y * gridDim.z;
  unsigned sum, cnt, mine, sp = 0u;
  for (;;) {
    sum = 0u; cnt = 0u; mine = 0u;
#pragma unroll
    for (unsigned j = 0; j < 16; ++j) { const unsigned c = xb_ld(&bar[XB_XCNT(j)]); sum += c; cnt += (c > 0u) ? 1u : 0u; mine = (j == x) ? c : mine; }
    if (sum == G) break;
    __builtin_amdgcn_s_sleep(1);
    if ((++sp & 255u) == 0u) { if (xb_ld(&bar[XB_TMO])) break; if (sp > XB_SPIN_CAP) { atomicAdd(&bar[XB_TMO], 1u); break; } }
  }
  nloc = mine > 0u ? mine : 1u; nx = cnt > 0u ? cnt : 1u;
}
DI void xcd_barrier(const XcdBarrier& b) {
  asm volatile("s_waitcnt vmcnt(0)" ::: "memory");
  __syncthreads();
  if (threadIdx.x == 0) {
    unsigned* bar = b.bar;
    __builtin_amdgcn_s_waitcnt(0);
    unsigned nloc = b.st[0], nx = b.st[1];
    if (nloc == 0u) { xcd_barrier_complete(bar, b.x, nloc, nx); b.st[0] = nloc; b.st[1] = nx; }
    const unsigned old = xb_add(&bar[XB_XSUB(b.x)], 1u);
    const unsigned gen = old / nloc;
    if (old + 1u == (gen + 1u) * nloc) {
      __builtin_amdgcn_fence(__ATOMIC_RELEASE, "agent");
      asm volatile("s_waitcnt vmcnt(0)" ::: "memory");
      const unsigned og = xb_add(&bar[XB_TOP], 1u);
      const unsigned tg = og / nx;
      if (og + 1u == (tg + 1u) * nx) xb_add(&bar[XB_TOPGEN], 1u);
      else XB_SPIN(xb_ld(&bar[XB_TOPGEN]) == tg, bar);
      __builtin_amdgcn_fence(__ATOMIC_ACQUIRE, "agent");
      xb_add(&bar[XB_XGEN(b.x)], 1u);
      asm volatile("s_waitcnt vmcnt(0)" ::: "memory");
    } else {
      XB_SPIN(xb_ld(&bar[XB_XGEN(b.x)]) == gen, bar);
      __builtin_amdgcn_fence(__ATOMIC_ACQUIRE, "agent");
      asm volatile("s_waitcnt vmcnt(0)" ::: "memory");
    }
  }
  __syncthreads();
}

constexpr int BK = 64, LDT = BK + 8;
constexpr int SMEM_BYTES = 2 * 128 * LDT * 2 + 512;

DI void gemm_mainloop(const u16* __restrict__ A, int lda, const u16* __restrict__ Bt, int ldb, int K,
                      u16* sA, u16* sB, f32x16 (&acc)[2][2]) {
  const int tid = tid_opaque(), lane = tid & 63, wave = tid >> 6, wm = wave >> 1, wn = wave & 1, r = lane & 31, h = lane >> 5;
  const int lrow = tid >> 3, lcol = (tid & 7) * 8;
  const u16* gA = A + (size_t)lrow * lda + lcol;
  const u16* gB = Bt + (size_t)lrow * ldb + lcol;
  u32x4 ra[4], rb[4];
#pragma unroll
  for (int i = 0; i < 4; ++i) {
    ra[i] = *(const u32x4*)(gA + (size_t)(32 * i) * lda);
    rb[i] = *(const u32x4*)(gB + (size_t)(32 * i) * ldb);
  }
#pragma unroll
  for (int a = 0; a < 2; ++a)
#pragma unroll
    for (int b = 0; b < 2; ++b)
#pragma unroll
      for (int i = 0; i < 16; ++i) acc[a][b][i] = 0.f;
  const u16* rA = sA + (64 * wm + r) * LDT + 8 * h;
  const u16* rB = sB + (64 * wn + r) * LDT + 8 * h;
  for (int k0 = 0; k0 < K; k0 += BK) {
    __syncthreads();
#pragma unroll
    for (int i = 0; i < 4; ++i) {
      *(u32x4*)(sA + (lrow + 32 * i) * LDT + lcol) = ra[i];
      *(u32x4*)(sB + (lrow + 32 * i) * LDT + lcol) = rb[i];
    }
    __syncthreads();
    if (k0 + BK < K) {
      gA += BK; gB += BK;
#pragma unroll
      for (int i = 0; i < 4; ++i) {
        ra[i] = *(const u32x4*)(gA + (size_t)(32 * i) * lda);
        rb[i] = *(const u32x4*)(gB + (size_t)(32 * i) * ldb);
      }
    }
#pragma unroll
    for (int ks = 0; ks < 4; ++ks) {
      const bf16x8 a0 = *(const bf16x8*)(rA + 16 * ks);
      const bf16x8 a1 = *(const bf16x8*)(rA + 32 * LDT + 16 * ks);
      const bf16x8 b0 = *(const bf16x8*)(rB + 16 * ks);
      const bf16x8 b1 = *(const bf16x8*)(rB + 32 * LDT + 16 * ks);
      acc[0][0] = MFMA32(a0, b0, acc[0][0]);
      acc[0][1] = MFMA32(a0, b1, acc[0][1]);
      acc[1][0] = MFMA32(a1, b0, acc[1][0]);
      acc[1][1] = MFMA32(a1, b1, acc[1][1]);
    }
  }
}

DI void transpose_tile(const float* __restrict__ src, int sld, u16* __restrict__ dst, int dld,
                       const float* __restrict__ scale, float* sm) {
  const int tid = tid_opaque();
  const int nn = tid & 63, kq = tid >> 6;
#pragma unroll
  for (int i = 0; i < 16; ++i) {
    const int kk = kq + 4 * i;
    float v = src[(size_t)kk * sld + nn];
    if (scale) v *= scale[kk];
    sm[kk * 65 + nn] = v;
  }
  __syncthreads();
  const int kp = (tid & 31) * 2, nq = tid >> 5;
#pragma unroll
  for (int i = 0; i < 8; ++i) {
    const int n2 = nq + 8 * i;
    const unsigned u = pack2(sm[kp * 65 + n2], sm[(kp + 1) * 65 + n2]);
    *(unsigned*)(dst + (size_t)n2 * dld + kp) = u;
  }
  __syncthreads();
}

DI uint4 cvt8(const float* __restrict__ s) {
  const float4 a = *(const float4*)s, b = *(const float4*)(s + 4);
  uint4 o;
  o.x = pack2(a.x, a.y); o.y = pack2(a.z, a.w); o.z = pack2(b.x, b.y); o.w = pack2(b.z, b.w);
  return o;
}

DI void phase0(const Params& p, float* sm) {
  const int tid = tid_opaque();
  unsigned char* ws = p.ws;
  if (blockIdx.x == 0 && tid < 2) ((int*)(ws + OFF_CTR))[tid] = 0;
  for (int j = blockIdx.x; j < 9344; j += gridDim.x) {
    const float* src; u16* dst; const float* scale = nullptr; int sld, dld;
    if (j < 2048) {
      const int l = j >> 10, kt = (j >> 6) & 15, nt = j & 63;
      src = p.win + ((size_t)l * 1024 + kt * 64) * 4096 + nt * 64; sld = 4096;
      dst = (u16*)(ws + OFF_WIN) + ((size_t)l * 4096 + nt * 64) * 1024 + kt * 64; dld = 1024;
      scale = p.gpre + l * 1024 + kt * 64;
    } else if (j < 3072) {
      const int jj = (j - 2048) & 511;
      const bool gate = j >= 2560;
      const int l = jj >> 8, kt = (jj >> 4) & 15, nt = jj & 15;
      src = (gate ? p.wgate : p.wout) + ((size_t)l * 1024 + kt * 64) * 1024 + nt * 64; sld = 1024;
      dst = (u16*)(ws + (gate ? OFF_WGATE : OFF_WOUT)) + ((size_t)l * 1024 + nt * 64) * 1024 + kt * 64; dld = 1024;
    } else if (j < 3200) {
      const int jj = j - 3072;
      const int l = jj >> 6, kt = (jj >> 4) & 3, nt = jj & 15;
      src = p.wple + ((size_t)l * 256 + kt * 64) * 1024 + nt * 64; sld = 1024;
      dst = (u16*)(ws + OFF_WPLE) + ((size_t)l * 1024 + nt * 64) * 256 + kt * 64; dld = 256;
    } else if (j < 5248) {
      const int jj = j - 3200;
      const int lbh = jj >> 3, kt = jj & 7;
      const int lb = lbh >> 3, hd = lbh & 7;
      src = p.cav + ((size_t)lb * 512 + kt * 64) * 512 + hd * 64; sld = 512;
      dst = (u16*)(ws + OFF_VAST) + (size_t)lbh * 64 * 544 + kt * 64; dld = 544;
    } else {
      const int jj = j - 5248;
      const int lbh = jj >> 4, kt = jj & 15;
      const int lb = lbh >> 3, hd = lbh & 7;
      src = p.cbv + ((size_t)lb * 1024 + kt * 64) * 512 + hd * 64; sld = 512;
      dst = (u16*)(ws + OFF_VBST) + (size_t)lbh * 64 * 1056 + kt * 64; dld = 1056;
    }
    transpose_tile(src, sld, dst, dld, scale, sm);
  }
  const size_t gtid = (size_t)blockIdx.x * 256 + tid, gn = (size_t)gridDim.x * 256;
  for (size_t e = gtid; e < (size_t)1048576; e += gn) {
    const int d8 = e & 7, hd = (e >> 3) & 7, s = (e >> 6) & 511, lb = (int)(e >> 15);
    *(uint4*)((u16*)(ws + OFF_KAS) + (((size_t)lb * 8 + hd) * 544 + s) * 64 + d8 * 8) = cvt8(p.cak + e * 8);
  }
  for (size_t e = gtid; e < (size_t)2097152; e += gn) {
    const int d8 = e & 7, hd = (e >> 3) & 7, s = (e >> 6) & 1023, lb = (int)(e >> 16);
    *(uint4*)((u16*)(ws + OFF_KBS) + (((size_t)lb * 8 + hd) * 1056 + s) * 64 + d8 * 8) = cvt8(p.cbk + e * 8);
  }
  for (size_t e = gtid; e < (size_t)2 * MT * 32; e += gn) {
    const int c8 = e & 31;
    const size_t lr = e >> 5;
    const int l = (int)(lr / MT), row = (int)(lr % MT);
    const float* src = row < MP ? p.pp + ((size_t)l * MP + row) * 256 : p.ps + ((size_t)l * MS + (row - MP)) * 256;
    *(uint4*)((u16*)(ws + OFF_PB) + lr * 256 + c8 * 8) = cvt8(src + c8 * 8);
  }
  const int lane = tid & 63;
  const int gw = (int)(gtid >> 6), nw = (int)(gn >> 6);
  for (int row = gw; row < MT; row += nw) {
    const float* src = row < MP ? p.xp + (size_t)row * 1024 : p.xs + (size_t)(row - MP) * 1024;
    u16* dst = (u16*)(ws + OFF_R0) + (size_t)row * 1024;
    float ss = 0.f;
#pragma unroll
    for (int j = 0; j < 2; ++j) {
      const int c = 8 * lane + 512 * j;
      const float4 a = *(const float4*)(src + c), b = *(const float4*)(src + c + 4);
      ss += a.x * a.x + a.y * a.y + a.z * a.z + a.w * a.w + b.x * b.x + b.y * b.y + b.z * b.z + b.w * b.w;
      uint4 o;
      o.x = pack2(a.x, a.y); o.y = pack2(a.z, a.w); o.z = pack2(b.x, b.y); o.w = pack2(b.z, b.w);
      *(uint4*)(dst + c) = o;
    }
#pragma unroll
    for (int m = 32; m >= 1; m >>= 1) ss += __shfl_xor(ss, m);
    if (lane < 16) ((float*)(ws + OFF_PSUM))[(size_t)row * 16 + lane] = lane == 0 ? ss : 0.f;
  }
}

DI void p1_tile(const Params& p, int layer, int tile, u16* sA, u16* sB, float* rstd_s, const u16* HB, u16* Gbuf) {
  const int tid = tid_opaque();
  const int mt = tile >> 5, nt = tile & 31;
  const int m0 = mt * 128, n0 = nt * 128;
  unsigned char* ws = p.ws;
  __syncthreads();
  if (tid < 128) {
    const float4* ps = (const float4*)((const float*)(ws + OFF_PSUM) + (size_t)(m0 + tid) * 16);
    float s = 0.f;
#pragma unroll
    for (int j = 0; j < 4; ++j) { const float4 v = ps[j]; s += v.x + v.y + v.z + v.w; }
    rstd_s[tid] = rsqrtf(s * (1.0f / 1024.0f) + EPS);
  }
  f32x16 acc[2][2];
  gemm_mainloop(HB + (size_t)m0 * 1024, 1024, (const u16*)(ws + OFF_WIN) + ((size_t)layer * 4096 + n0) * 1024, 1024, 1024, sA, sB, acc);

  int tl = tid_opaque();
  const int lane = tl & 63, wave = tl >> 6, wm = wave >> 1, wn = wave & 1, r = lane & 31, h = lane >> 5;
  const int seg = n0 >> 9, kind = seg & 3, grp = seg >> 2;
  const int hd = ((n0 & 511) >> 6) + wn;
  const bool prompt = m0 < MP;
  float* out = p.out;
#pragma unroll
  for (int rb = 0; rb < 2; ++rb) {
    const int lrow0 = 64 * wm + 32 * rb;
    const int row0 = m0 + lrow0;
    int b, s0;
    if (prompt) { b = row0 >> 11; s0 = row0 & 2047; } else { b = (row0 - MP) >> 5; s0 = 0; }
    const int lb = layer * 16 + b;
    if (kind == 3) {
#pragma unroll
      for (int cb = 0; cb < 2; ++cb)
#pragma unroll
        for (int i = 0; i < 16; ++i) {
          const int t = crow(i, h);
          const float v = acc[rb][cb][i] * rstd_s[lrow0 + t];
          const float sv = v / (1.0f + __expf(-v));
          Gbuf[(size_t)(row0 + t) * 1024 + grp * 512 + hd * 64 + 32 * cb + r] = f2bf(sv);
        }
    } else if (kind == 0) {
      u16* base;
      if (prompt) base = (u16*)(ws + (grp ? OFF_QB : OFF_QA)) + (((size_t)b * 8 + hd) * 2048 + s0) * 64;
      else base = (u16*)(ws + (grp ? OFF_QBS : OFF_QAS)) + (((size_t)b * 8 + hd) * 32) * 64;
#pragma unroll
      for (int cb = 0; cb < 2; ++cb)
#pragma unroll
        for (int i = 0; i < 16; ++i) {
          const int t = crow(i, h);
          const float v = acc[rb][cb][i] * rstd_s[lrow0 + t] * 0.125f;
          base[t * 64 + 32 * cb + r] = f2bf(v);
        }
    } else {
      float* fo = nullptr;
      if (prompt) {
        if (grp == 0) {
          if (s0 >= 1536) fo = out + (kind == 1 ? O_AKP : O_AVP) + ((size_t)lb * 512 + (s0 - 1536)) * 512 + hd * 64;
        } else {
          fo = out + (kind == 1 ? O_BKP : O_BVP) + ((size_t)lb * 2048 + s0) * 512 + hd * 64;
        }
      } else {
        if (grp == 0) fo = out + (kind == 1 ? O_AKS : O_AVS) + ((size_t)lb * 32) * 512 + hd * 64;
        else fo = out + (kind == 1 ? O_BKS : O_BVS) + ((size_t)lb * 32) * 512 + hd * 64;
      }
      if (kind == 1) {
        u16* base;
        if (prompt) base = (u16*)(ws + (grp ? OFF_KB : OFF_KA)) + (((size_t)b * 8 + hd) * 2048 + s0) * 64;
        else if (grp == 0) base = (u16*)(ws + OFF_KAS) + (((size_t)lb * 8 + hd) * 544 + 512) * 64;
        else base = (u16*)(ws + OFF_KBS) + (((size_t)lb * 8 + hd) * 1056 + 1024) * 64;
#pragma unroll
        for (int cb = 0; cb < 2; ++cb)
#pragma unroll
          for (int i = 0; i < 16; ++i) {
            const int t = crow(i, h);
            const float v = acc[rb][cb][i] * rstd_s[lrow0 + t];
            base[t * 64 + 32 * cb + r] = f2bf(v);
            if (fo) fo[(size_t)t * 512 + 32 * cb + r] = v;
          }
      } else {
        u16* base; int ldv;
        if (prompt) { base = (u16*)(ws + (grp ? OFF_VBT : OFF_VAT)) + (((size_t)b * 8 + hd) * 64) * 2048 + s0; ldv = 2048; }
        else if (grp == 0) { base = (u16*)(ws + OFF_VAST) + (((size_t)lb * 8 + hd) * 64) * 544 + 512; ldv = 544; }
        else { base = (u16*)(ws + OFF_VBST) + (((size_t)lb * 8 + hd) * 64) * 1056 + 1024; ldv = 1056; }
#pragma unroll
        for (int cb = 0; cb < 2; ++cb)
#pragma unroll
          for (int g = 0; g < 4; ++g) {
            const int t0 = 8 * g + 4 * h;
            float v[4];
#pragma unroll
            for (int j = 0; j < 4; ++j) {
              v[j] = acc[rb][cb][4 * g + j] * rstd_s[lrow0 + t0 + j];
              if (fo) fo[(size_t)(t0 + j) * 512 + 32 * cb + r] = v[j];
            }
            uint2 o; o.x = pack2(v[0], v[1]); o.y = pack2(v[2], v[3]);
            *(uint2*)(base + (size_t)(32 * cb + r) * ldv + t0) = o;
          }
      }
    }
  }
}

DI void attn_store(const f32x16& o0, const f32x16& o1, float scale, const u16* Gp, u16* Mp, int r, int h) {
#pragma unroll
  for (int db = 0; db < 2; ++db)
#pragma unroll
    for (int g = 0; g < 4; ++g) {
      const int d0 = 32 * db + 8 * g + 4 * h;
      const uint2 gv = *(const uint2*)(Gp + (size_t)r * 1024 + d0);
      const float x0 = (db ? o1[4 * g] : o0[4 * g]) * scale * bflo(gv.x);
      const float x1 = (db ? o1[4 * g + 1] : o0[4 * g + 1]) * scale * bfhi(gv.x);
      const float x2 = (db ? o1[4 * g + 2] : o0[4 * g + 2]) * scale * bflo(gv.y);
      const float x3 = (db ? o1[4 * g + 3] : o0[4 * g + 3]) * scale * bfhi(gv.y);
      uint2 o; o.x = pack2(x0, x1); o.y = pack2(x2, x3);
      *(uint2*)(Mp + (size_t)r * 1024 + d0) = o;
    }
}

DI bf16x8 ldv8(const u16* vp) {
  const bf16x4 lo = *(const bf16x4*)vp;
  const bf16x4 hi = *(const bf16x4*)(vp + 8);
  return __builtin_shufflevector(lo, hi, 0, 1, 2, 3, 4, 5, 6, 7);
}

DI bf16x8 pack8(const float* v) {
  uint4 u;
  u.x = pack2(v[0], v[1]); u.y = pack2(v[2], v[3]); u.z = pack2(v[4], v[5]); u.w = pack2(v[6], v[7]);
  return __builtin_bit_cast(bf16x8, u);
}

DI void sb_item(const u16* __restrict__ Q, const u16* __restrict__ Kb, const u16* __restrict__ VT, int ldv,
                int qpos0, int ntiles, const u16* Gp, u16* Mp) {
  const int lane = tid_opaque() & 63, r = lane & 31, h = lane >> 5;
  bf16x8 qf[4];
#pragma unroll
  for (int ks = 0; ks < 4; ++ks) qf[ks] = *(const bf16x8*)(Q + r * 64 + 16 * ks + 8 * h);
  bf16x8 tf[2];
#pragma unroll
  for (int s = 0; s < 2; ++s)
#pragma unroll
    for (int j = 0; j < 8; ++j) tf[s][j] = (16 * s + 8 * (j >> 2) + 4 * h + (j & 3) > r) ? (short)0x3F80 : (short)0;
  f32x16 o0, o1;
#pragma unroll
  for (int i = 0; i < 16; ++i) { o0[i] = 0.f; o1[i] = 0.f; }
  float carry = 0.f;
  const int qpos = qpos0 + r;
  for (int kt = ntiles - 1; kt >= 0; --kt) {
    const int k0 = kt * 32;
    f32x16 st;
#pragma unroll
    for (int i = 0; i < 16; ++i) st[i] = 0.f;
    const u16* kp = Kb + (size_t)(k0 + r) * 64 + 8 * h;
#pragma unroll
    for (int ks = 0; ks < 4; ++ks) {
      const bf16x8 kf = *(const bf16x8*)(kp + 16 * ks);
      st = MFMA32(kf, qf[ks], st);
    }
    bf16x8 vf[2][2];
#pragma unroll
    for (int db = 0; db < 2; ++db)
#pragma unroll
      for (int s = 0; s < 2; ++s) vf[db][s] = ldv8(VT + (size_t)(32 * db + r) * ldv + k0 + 16 * s + 4 * h);
    float l1m[16], lb[16];
    float csum = 0.f;
#pragma unroll
    for (int i = 0; i < 16; ++i) {
      const float z = st[i];
      const bool c = (k0 + crow(i, h)) < qpos;
      const float e = __expf(-fabsf(z));
      const float sp = fmaxf(z, 0.f) + __logf(1.0f + e);
      l1m[i] = c ? -sp : 0.f;
      lb[i] = c ? (z - sp) : -1e30f;
      csum += l1m[i];
    }
    csum += __shfl_xor(csum, 32);
    f32x16 af;
#pragma unroll
    for (int i = 0; i < 16; ++i) af[i] = 0.f;
    af = MFMA32(tf[0], pack8(l1m), af);
    af = MFMA32(tf[1], pack8(l1m + 8), af);
    float w[16];
#pragma unroll
    for (int i = 0; i < 16; ++i) w[i] = __expf(lb[i] + af[i] + carry);
    carry += csum;
    const bf16x8 w0 = pack8(w), w1 = pack8(w + 8);
    o0 = MFMA32(vf[0][0], w0, o0);
    o0 = MFMA32(vf[0][1], w1, o0);
    o1 = MFMA32(vf[1][0], w0, o1);
    o1 = MFMA32(vf[1][1], w1, o1);
  }
  attn_store(o0, o1, 1.0f, Gp, Mp, r, h);
}

DI void band_item(const u16* __restrict__ Q, const u16* __restrict__ Kb, const u16* __restrict__ VT, int ldv,
                  int kt_begin, int kt_end, int relbase, const float* __restrict__ bias, const u16* Gp, u16* Mp) {
  const int lane = tid_opaque() & 63, r = lane & 31, h = lane >> 5;
  bf16x8 qf[4];
#pragma unroll
  for (int ks = 0; ks < 4; ++ks) qf[ks] = *(const bf16x8*)(Q + r * 64 + 16 * ks + 8 * h);
  f32x16 o0, o1;
#pragma unroll
  for (int i = 0; i < 16; ++i) { o0[i] = 0.f; o1[i] = 0.f; }
  float m = -1e30f, l = 0.f;
  const float b0 = bias[0];
  for (int kt = kt_begin; kt < kt_end; ++kt) {
    const int k0 = kt * 32;
    f32x16 st;
#pragma unroll
    for (int i = 0; i < 16; ++i) st[i] = 0.f;
    const u16* kp = Kb + (size_t)(k0 + r) * 64 + 8 * h;
#pragma unroll
    for (int ks = 0; ks < 4; ++ks) {
      const bf16x8 kf = *(const bf16x8*)(kp + 16 * ks);
      st = MFMA32(kf, qf[ks], st);
    }
    bf16x8 vf[2][2];
#pragma unroll
    for (int db = 0; db < 2; ++db)
#pragma unroll
      for (int s = 0; s < 2; ++s) vf[db][s] = ldv8(VT + (size_t)(32 * db + r) * ldv + k0 + 16 * s + 4 * h);
    float sv[16];
    if (k0 + 31 + relbase <= -128) {
#pragma unroll
      for (int i = 0; i < 16; ++i) sv[i] = st[i] + b0;
    } else {
      const int relc = k0 + relbase - r;
#pragma unroll
      for (int i = 0; i < 16; ++i) {
        int rel = relc + crow(i, h);
        rel = min(max(rel, -128), 128) + 128;
        sv[i] = st[i] + bias[rel];
      }
    }
    float mt = sv[0];
#pragma unroll
    for (int i = 1; i < 16; ++i) mt = fmaxf(mt, sv[i]);
    mt = fmaxf(mt, __shfl_xor(mt, 32));
    const float mnew = fmaxf(m, mt);
    const float alpha = __expf(m - mnew);
    m = mnew;
    float ps = 0.f;
#pragma unroll
    for (int i = 0; i < 16; ++i) { sv[i] = __expf(sv[i] - mnew); ps += sv[i]; }
    l = l * alpha + ps;
#pragma unroll
    for (int i = 0; i < 16; ++i) { o0[i] *= alpha; o1[i] *= alpha; }
    const bf16x8 w0 = pack8(sv), w1 = pack8(sv + 8);
    o0 = MFMA32(vf[0][0], w0, o0);
    o0 = MFMA32(vf[0][1], w1, o0);
    o1 = MFMA32(vf[1][0], w0, o1);
    o1 = MFMA32(vf[1][1], w1, o1);
  }
  l += __shfl_xor(l, 32);
  attn_store(o0, o1, 1.0f / l, Gp, Mp, r, h);
}

constexpr int N_ITEMS = 16640;

DI void phase2(const Params& p, int layer, const u16* Gbuf, u16* MIX) {
  unsigned char* ws = p.ws;
  int* ctr = (int*)(ws + OFF_CTR) + layer;
  const int lane = tid_opaque() & 63;
  for (;;) {
    int idx = 0;
    if (lane == 0) idx = atomicAdd(ctr, 1);
    idx = __shfl(idx, 0);
    if (idx >= N_ITEMS) break;
    if (idx < 128) {
      const int bh = idx, b = bh >> 3, hd = bh & 7;
      const size_t row0 = (size_t)MP + b * 32;
      sb_item((const u16*)(ws + OFF_QBS) + (size_t)bh * 32 * 64,
              (const u16*)(ws + OFF_KBS) + ((size_t)layer * 128 + bh) * 1056 * 64,
              (const u16*)(ws + OFF_VBST) + ((size_t)layer * 128 + bh) * 64 * 1056, 1056,
              1024, 33, Gbuf + row0 * 1024 + 512 + hd * 64, MIX + row0 * 1024 + 512 + hd * 64);
    } else if (idx < 8320) {
      const int j = idx - 128, bh = j >> 6, qt = 63 - (j & 63), b = bh >> 3, hd = bh & 7;
      const size_t row0 = (size_t)b * 2048 + qt * 32;
      sb_item((const u16*)(ws + OFF_QB) + ((size_t)bh * 2048 + qt * 32) * 64,
              (const u16*)(ws + OFF_KB) + (size_t)bh * 2048 * 64,
              (const u16*)(ws + OFF_VBT) + (size_t)bh * 64 * 2048, 2048,
              qt * 32, qt + 1, Gbuf + row0 * 1024 + 512 + hd * 64, MIX + row0 * 1024 + 512 + hd * 64);
    } else if (idx < 8448) {
      const int bh = idx - 8320, b = bh >> 3, hd = bh & 7;
      const size_t row0 = (size_t)MP + b * 32;
      band_item((const u16*)(ws + OFF_QAS) + (size_t)bh * 32 * 64,
                (const u16*)(ws + OFF_KAS) + ((size_t)layer * 128 + bh) * 544 * 64,
                (const u16*)(ws + OFF_VAST) + ((size_t)layer * 128 + bh) * 64 * 544, 544,
                0, 17, -512, p.relb + (size_t)(layer * 8 + hd) * 257,
                Gbuf + row0 * 1024 + hd * 64, MIX + row0 * 1024 + hd * 64);
    } else {
      const int j = idx - 8448, bh = j >> 6, qt = j & 63, b = bh >> 3, hd = bh & 7;
      const int c = qt >> 1;
      const size_t row0 = (size_t)b * 2048 + qt * 32;
      band_item((const u16*)(ws + OFF_QA) + ((size_t)bh * 2048 + qt * 32) * 64,
                (const u16*)(ws + OFF_KA) + (size_t)bh * 2048 * 64,
                (const u16*)(ws + OFF_VAT) + (size_t)bh * 64 * 2048, 2048,
                2 * max(0, c - 8), 2 * c + 2, -qt * 32, p.relb + (size_t)(layer * 8 + hd) * 257,
                Gbuf + row0 * 1024 + hd * 64, MIX + row0 * 1024 + hd * 64);
    }
  }
}

DI void p3_tile(const Params& p, int layer, int tile, u16* sA, u16* sB, const u16* MIX, u16* Y) {
  const int mt = tile >> 3, nt = tile & 7;
  const int m0 = mt * 128, n0 = nt * 128;
  f32x16 acc[2][2];
  gemm_mainloop(MIX + (size_t)m0 * 1024, 1024, (const u16*)(p.ws + OFF_WOUT) + ((size_t)layer * 1024 + n0) * 1024, 1024, 1024, sA, sB, acc);
  int tl = tid_opaque();
  const int lane = tl & 63, wave = tl >> 6, wm = wave >> 1, wn = wave & 1, r = lane & 31, h = lane >> 5;
#pragma unroll
  for (int rb = 0; rb < 2; ++rb)
#pragma unroll
    for (int cb = 0; cb < 2; ++cb)
#pragma unroll
      for (int i = 0; i < 16; ++i) {
        const int row = m0 + 64 * wm + 32 * rb + crow(i, h);
        Y[(size_t)row * 1024 + n0 + 64 * wn + 32 * cb + r] = f2bf(acc[rb][cb][i]);
      }
}

DI void phase4(const Params& p, int layer, const u16* Y, u16* H1B) {
  const int tid = tid_opaque(), lane = tid & 63;
  const int gw = (blockIdx.x * 256 + tid) >> 6, nw = (gridDim.x * 256) >> 6;
  const float* gp = p.gpost + layer * 1024;
  for (int row = gw; row < MT; row += nw) {
    const u16* yr = Y + (size_t)row * 1024;
    float yf[16];
    float ss = 0.f;
#pragma unroll
    for (int j = 0; j < 2; ++j) {
      const uint4 u = *(const uint4*)(yr + 8 * lane + 512 * j);
      yf[8 * j + 0] = bflo(u.x); yf[8 * j + 1] = bfhi(u.x); yf[8 * j + 2] = bflo(u.y); yf[8 * j + 3] = bfhi(u.y);
      yf[8 * j + 4] = bflo(u.z); yf[8 * j + 5] = bfhi(u.z); yf[8 * j + 6] = bflo(u.w); yf[8 * j + 7] = bfhi(u.w);
    }
#pragma unroll
    for (int i = 0; i < 16; ++i) ss += yf[i] * yf[i];
#pragma unroll
    for (int m = 32; m >= 1; m >>= 1) ss += __shfl_xor(ss, m);
    const float rs = rsqrtf(ss * (1.0f / 1024.0f) + EPS);
    const float* hs;
    if (layer == 0) hs = row < MP ? p.xp + (size_t)row * 1024 : p.xs + (size_t)(row - MP) * 1024;
    else hs = p.out + (size_t)row * 1024;
    float* ho = p.out + (size_t)row * 1024;
#pragma unroll
    for (int j = 0; j < 2; ++j) {
      const int c = 8 * lane + 512 * j;
      const float4 a = *(const float4*)(hs + c), b = *(const float4*)(hs + c + 4);
      const float4 ga = *(const float4*)(gp + c), gb = *(const float4*)(gp + c + 4);
      float4 oa, ob;
      oa.x = a.x + yf[8 * j + 0] * rs * ga.x; oa.y = a.y + yf[8 * j + 1] * rs * ga.y;
      oa.z = a.z + yf[8 * j + 2] * rs * ga.z; oa.w = a.w + yf[8 * j + 3] * rs * ga.w;
      ob.x = b.x + yf[8 * j + 4] * rs * gb.x; ob.y = b.y + yf[8 * j + 5] * rs * gb.y;
      ob.z = b.z + yf[8 * j + 6] * rs * gb.z; ob.w = b.w + yf[8 * j + 7] * rs * gb.w;
      *(float4*)(ho + c) = oa; *(float4*)(ho + c + 4) = ob;
      uint4 o;
      o.x = pack2(oa.x, oa.y); o.y = pack2(oa.z, oa.w); o.z = pack2(ob.x, ob.y); o.w = pack2(ob.z, ob.w);
      *(uint4*)(H1B + (size_t)row * 1024 + c) = o;
    }
  }
}

DI void p5_tile(const Params& p, int layer, int tile, u16* sA, u16* sB, const u16* H1B, u16* HBN) {
  const int mt = tile >> 3, nt = tile & 7;
  const int m0 = mt * 128, n0 = nt * 128;
  unsigned char* ws = p.ws;
  f32x16 acc[2][2];
  gemm_mainloop((const u16*)(ws + OFF_PB) + ((size_t)layer * MT + m0) * 256, 256,
                (const u16*)(ws + OFF_WPLE) + ((size_t)layer * 1024 + n0) * 256, 256, 256, sA, sB, acc);
  unsigned pl[2][2][8];
#pragma unroll
  for (int rb = 0; rb < 2; ++rb)
#pragma unroll
    for (int cb = 0; cb < 2; ++cb)
#pragma unroll
      for (int j = 0; j < 8; ++j) pl[rb][cb][j] = pack2(acc[rb][cb][2 * j], acc[rb][cb][2 * j + 1]);
  gemm_mainloop(H1B + (size_t)m0 * 1024, 1024, (const u16*)(ws + OFF_WGATE) + ((size_t)layer * 1024 + n0) * 1024, 1024, 1024, sA, sB, acc);
  int tl = tid_opaque();
  const int lane = tl & 63, wave = tl >> 6, wm = wave >> 1, wn = wave & 1, r = lane & 31, h = lane >> 5;
  float sq[32];
#pragma unroll
  for (int rb = 0; rb < 2; ++rb)
#pragma unroll
    for (int i = 0; i < 16; ++i) {
      const int row = m0 + 64 * wm + 32 * rb + crow(i, h);
      float s2 = 0.f;
#pragma unroll
      for (int cb = 0; cb < 2; ++cb) {
        const int col = n0 + 64 * wn + 32 * cb + r;
        float* hp = p.out + (size_t)row * 1024 + col;
        const float h1 = *hp;
        const float pv = (i & 1) ? bfhi(pl[rb][cb][i >> 1]) : bflo(pl[rb][cb][i >> 1]);
        const float g = 1.0f / (1.0f + __expf(-acc[rb][cb][i]));
        const float h2 = h1 + g * pv;
        *hp = h2;
        if (layer == 0) HBN[(size_t)row * 1024 + col] = f2bf(h2);
        s2 += h2 * h2;
      }
      sq[rb * 16 + i] = s2;
    }
  if (layer == 0) {
#pragma unroll
    for (int j = 0; j < 16; ++j) {
      const float send = (r & 16) ? sq[j] : sq[j + 16];
      const float keep = (r & 16) ? sq[j + 16] : sq[j];
      sq[j] = keep + __shfl_xor(send, 16);
    }
#pragma unroll
    for (int j = 0; j < 8; ++j) {
      const float send = (r & 8) ? sq[j] : sq[j + 8];
      const float keep = (r & 8) ? sq[j + 8] : sq[j];
      sq[j] = keep + __shfl_xor(send, 8);
    }
#pragma unroll
    for (int j = 0; j < 4; ++j) {
      const float send = (r & 4) ? sq[j] : sq[j + 4];
      const float keep = (r & 4) ? sq[j + 4] : sq[j];
      sq[j] = keep + __shfl_xor(send, 4);
    }
#pragma unroll
    for (int j = 0; j < 2; ++j) {
      const float send = (r & 2) ? sq[j] : sq[j + 2];
      const float keep = (r & 2) ? sq[j + 2] : sq[j];
      sq[j] = keep + __shfl_xor(send, 2);
    }
    {
      const float send = (r & 1) ? sq[0] : sq[1];
      const float keep = (r & 1) ? sq[1] : sq[0];
      sq[0] = keep + __shfl_xor(send, 1);
    }
    const int row = m0 + 64 * wm + 32 * (r >> 4) + crow(r & 15, h);
    ((float*)(ws + OFF_PSUM))[(size_t)row * 16 + nt * 2 + wn] = sq[0];
  }
}

__global__ void __launch_bounds__(256, 2) mega(Params p, int ph_begin, int ph_end) {
  __shared__ __attribute__((aligned(16))) unsigned char smem[SMEM_BYTES];
  u16* sA = (u16*)smem;
  u16* sB = sA + 128 * LDT;
  float* rstd_s = (float*)(smem + 2 * 128 * LDT * 2);
  unsigned char* ws = p.ws;
  __shared__ uint4 xb_words;
  if (threadIdx.x == 0) xb_words = make_uint4(0u, 0u, 0u, 0u);
  __syncthreads();
  XcdBarrier xb = xcd_barrier_post((unsigned*)(ws + OFF_BAR), (volatile LAS unsigned*)&xb_words);
  if (ph_end < 0) cg::this_grid().sync();
#define PHASE_GATE(PH) if ((PH) >= ph_begin && (PH) < ph_end) { if ((PH) > ph_begin) xcd_barrier(xb);
  PHASE_GATE(0) phase0(p, (float*)smem); }
#pragma unroll 1
  for (int layer = 0; layer < 2; ++layer) {
    asm volatile("" : "+s"(layer));
    u16* RA = (u16*)(ws + ((layer & 1) ? OFF_R1 : OFF_R0));
    u16* RB = (u16*)(ws + ((layer & 1) ? OFF_R0 : OFF_R1));
    const int pb = 1 + 5 * layer;
    PHASE_GATE(pb + 0)
#pragma unroll 1
      for (int t = blockIdx.x; t < 260 * 32; t += gridDim.x) p1_tile(p, layer, t, sA, sB, rstd_s, RA, RB);
    }
    PHASE_GATE(pb + 1) phase2(p, layer, RB, RA); }
    PHASE_GATE(pb + 2)
#pragma unroll 1
      for (int t = blockIdx.x; t < 260 * 8; t += gridDim.x) p3_tile(p, layer, t, sA, sB, RA, RB);
    }
    PHASE_GATE(pb + 3) phase4(p, layer, RB, RA); }
    PHASE_GATE(pb + 4)
#pragma unroll 1
      for (int t = blockIdx.x; t < 260 * 8; t += gridDim.x) p5_tile(p, layer, t, sA, sB, RA, RB);
    }
  }
}

extern "C" void kernel_launch(void* const* d_in, const int* in_sizes, int n_in, void* d_out, int out_size,
                              void* d_ws, size_t ws_size, hipStream_t stream) {
  Params p{};
  p.xp = (const float*)d_in[0]; p.xs = (const float*)d_in[1]; p.pp = (const float*)d_in[2]; p.ps = (const float*)d_in[3];
  p.cak = (const float*)d_in[4]; p.cav = (const float*)d_in[5]; p.cbk = (const float*)d_in[6]; p.cbv = (const float*)d_in[7];
  p.gpre = (const float*)d_in[8]; p.win = (const float*)d_in[9]; p.relb = (const float*)d_in[10]; p.wout = (const float*)d_in[11];
  p.gpost = (const float*)d_in[12]; p.wple = (const float*)d_in[13]; p.wgate = (const float*)d_in[14];
  p.out = (float*)d_out;
  p.ws = (unsigned char*)d_ws;
  static int grid_blocks = 0;
  if (!grid_blocks) {
    int dev = 0, cus = 0, per_cu = 0;
    hipGetDevice(&dev);
    hipDeviceGetAttribute(&cus, hipDeviceAttributeMultiprocessorCount, dev);
    hipOccupancyMaxActiveBlocksPerMultiprocessor(&per_cu, mega, 256, 0);
    if (per_cu < 1) per_cu = 1;
    grid_blocks = cus * per_cu;
  }
#if MK_COOP
  hipMemsetAsync((unsigned char*)d_ws + OFF_BAR, 0, (size_t)XCD_BAR_WORDS * 4, stream);
  int pb = 0, pe = 11;
  void* args[] = {&p, &pb, &pe};
  hipError_t e = hipLaunchCooperativeKernel((void*)mega, dim3(grid_blocks), dim3(256), args, 0, stream);
  if (e != hipSuccess) fprintf(stderr, "cooperative launch failed: %s (grid %d)\n", hipGetErrorString(e), grid_blocks);
#else
  for (int ph = 0; ph < 11; ++ph) mega<<<dim3(grid_blocks), dim3(256), 0, stream>>>(p, ph, ph + 1);
#endif
}
```

```cpp
#include <hip/hip_runtime.h>
#include <hip/hip_cooperative_groups.h>
#include <stdint.h>
#include <stdio.h>
namespace cg = cooperative_groups;

#ifndef PROBE_DUP
#define PROBE_DUP 0
#endif
#ifndef MK_COOP
#define MK_COOP 1
#endif

typedef __attribute__((ext_vector_type(8))) short bf16x8;
typedef __attribute__((ext_vector_type(4))) short bf16x4;
typedef __attribute__((ext_vector_type(16))) float f32x16;
typedef __attribute__((ext_vector_type(2))) __bf16 bf2_t;
typedef __attribute__((ext_vector_type(2))) float f2_t;
typedef unsigned short u16;
typedef __attribute__((ext_vector_type(4))) unsigned u32x4;

#define DI __device__ __forceinline__
#define MFMA32(a, b, c) __builtin_amdgcn_mfma_f32_32x32x16_bf16((a), (b), (c), 0, 0, 0)

DI unsigned pack2(float a, float b) { f2_t v = {a, b}; bf2_t r = __builtin_convertvector(v, bf2_t); return __builtin_bit_cast(unsigned, r); }
DI u16 f2bf(float a) { return (u16)(pack2(a, 0.f) & 0xffffu); }
DI float bflo(unsigned u) { return __uint_as_float(u << 16); }
DI float bfhi(unsigned u) { return __uint_as_float(u & 0xffff0000u); }
DI int crow(int i, int h) { return (i & 3) + 8 * (i >> 2) + 4 * h; }
DI int tid_opaque() { int t = threadIdx.x; asm volatile("" : "+v"(t)); return t; }

struct Params {
  const float *xp, *xs, *pp, *ps, *cak, *cav, *cbk, *cbv, *gpre, *win, *relb, *wout, *gpost, *wple, *wgate;
  float* out;
  unsigned char* ws;
};

constexpr int MP = 32768, MS = 512, MT = 33280;
constexpr float EPS = 1e-6f;
constexpr float QSCALE = 0.125f * 1.4426950408889634f;

#define XCD_BAR_WORDS 3456
constexpr size_t SZ_ACT = (size_t)MT * 1024 * 2;
constexpr size_t SZ_QKV = (size_t)16 * 8 * 2048 * 64 * 2;
constexpr size_t OFF_WIN = 0;
constexpr size_t OFF_WOUT = OFF_WIN + (size_t)2 * 4096 * 1024 * 2;
constexpr size_t OFF_WGATE = OFF_WOUT + (size_t)2 * 1024 * 1024 * 2;
constexpr size_t OFF_WPLE = OFF_WGATE + (size_t)2 * 1024 * 1024 * 2;
constexpr size_t OFF_R0 = OFF_WPLE + (size_t)2 * 1024 * 256 * 2;
constexpr size_t OFF_R1 = OFF_R0 + SZ_ACT;
constexpr size_t OFF_PB = OFF_R1 + SZ_ACT;
constexpr size_t OFF_PSUM = OFF_PB + (size_t)2 * MT * 256 * 2;
constexpr size_t OFF_QA = OFF_PSUM + (size_t)MT * 32 * 4;
constexpr size_t OFF_KA = OFF_QA + SZ_QKV;
constexpr size_t OFF_VAT = OFF_KA + SZ_QKV;
constexpr size_t OFF_QB = OFF_VAT + SZ_QKV;
constexpr size_t OFF_KB = OFF_QB + SZ_QKV;
constexpr size_t OFF_VBT = OFF_KB + SZ_QKV;
constexpr size_t OFF_QAS = OFF_VBT + SZ_QKV;
constexpr size_t OFF_QBS = OFF_QAS + (size_t)128 * 32 * 64 * 2;
constexpr size_t OFF_KAS = OFF_QBS + (size_t)128 * 32 * 64 * 2;
constexpr size_t OFF_VAST = OFF_KAS + (size_t)2 * 128 * 544 * 64 * 2;
constexpr size_t OFF_KBS = OFF_VAST + (size_t)2 * 128 * 544 * 64 * 2;
constexpr size_t OFF_VBST = OFF_KBS + (size_t)2 * 128 * 1056 * 64 * 2;
constexpr size_t OFF_CTR = OFF_VBST + (size_t)2 * 128 * 1056 * 64 * 2;
constexpr size_t OFF_BAR = OFF_CTR + 256;
constexpr size_t WS_TOTAL = OFF_BAR + (size_t)XCD_BAR_WORDS * 4;
static_assert(WS_TOTAL <= (size_t)536870912, "workspace too large");

constexpr size_t O_AKP = 34078720;
constexpr size_t O_AVP = O_AKP + 8388608;
constexpr size_t O_BKP = O_AVP + 8388608;
constexpr size_t O_BVP = O_BKP + 33554432;
constexpr size_t O_AKS = O_BVP + 33554432;
constexpr size_t O_AVS = O_AKS + 524288;
constexpr size_t O_BKS = O_AVS + 524288;
constexpr size_t O_BVS = O_BKS + 524288;


#define XB_TMO      128
#define XB_XCNT(j)  (256  + 64 * (j))
#define XB_XSUB(j)  (1280 + 64 * (j))
#define XB_XGEN(j)  (2304 + 64 * (j))
#define XB_TOP      3328
#define XB_TOPGEN   3392
#define XB_SPIN_CAP (1u << 22)
#define LAS __attribute__((address_space(3)))
DI unsigned xb_ld(unsigned* p) { return __hip_atomic_load(p, __ATOMIC_RELAXED, __HIP_MEMORY_SCOPE_AGENT); }
DI unsigned xb_add(unsigned* p, unsigned v) { return __hip_atomic_fetch_add(p, v, __ATOMIC_RELAXED, __HIP_MEMORY_SCOPE_AGENT); }
DI unsigned xb_xcc_id() { return (unsigned)__builtin_amdgcn_s_getreg((3 << 11) | 20) & 0xFu; }
#define XB_SPIN(cond, bar) do { unsigned _sp = 0; while (cond) { __builtin_amdgcn_s_sleep(1); \
    if ((++_sp & 255u) == 0u) { if (xb_ld(&(bar)[XB_TMO])) break; if (_sp > XB_SPIN_CAP) { atomicAdd(&(bar)[XB_TMO], 1u); break; } } } } while (0)
struct XcdBarrier { unsigned* bar; unsigned x; volatile LAS unsigned* st; };
DI XcdBarrier xcd_barrier_post(unsigned* bar, volatile LAS unsigned* st) {
  XcdBarrier b; b.bar = bar; b.x = xb_xcc_id(); b.st = st;
  if (threadIdx.x == 0) (void)xb_add(&bar[XB_XCNT(b.x)], 1u);
  return b;
}
DI void xcd_barrier_complete(unsigned* bar, unsigned x, unsigned& nloc, unsigned& nx) {
  const unsigned G = gridDim.x * gridDim.y * gridDim.z;
  unsigned sum, cnt, mine, sp = 0u;
  for (;;) {
    sum = 0u; cnt = 0u; mine = 0u;
#pragma unroll
    for (unsigned j = 0; j < 16; ++j) { const unsigned c = xb_ld(&bar[XB_XCNT(j)]); sum += c; cnt += (c > 0u) ? 1u : 0u; mine = (j == x) ? c : mine; }
    if (sum == G) break;
    __builtin_amdgcn_s_sleep(1);
    if ((++sp & 255u) == 0u) { if (xb_ld(&bar[XB_TMO])) break; if (sp > XB_SPIN_CAP) { atomicAdd(&bar[XB_TMO], 1u); break; } }
  }
  nloc = mine > 0u ? mine : 1u; nx = cnt > 0u ? cnt : 1u;
}
DI void xcd_barrier(const XcdBarrier& b) {
  asm volatile("s_waitcnt vmcnt(0)" ::: "memory");
  __syncthreads();
  if (threadIdx.x == 0) {
    unsigned* bar = b.bar;
    __builtin_amdgcn_s_waitcnt(0);
    unsigned nloc = b.st[0], nx = b.st[1];
    if (nloc == 0u) { xcd_barrier_complete(bar, b.x, nloc, nx); b.st[0] = nloc; b.st[1] = nx; }
    const unsigned old = xb_add(&bar[XB_XSUB(b.x)], 1u);
    const unsigned gen = old / nloc;
    if (old + 1u == (gen + 1u) * nloc) {
      __builtin_amdgcn_fence(__ATOMIC_RELEASE, "agent");
      asm volatile("s_waitcnt vmcnt(0)" ::: "memory");
      const unsigned og = xb_add(&bar[XB_TOP], 1u);
      const unsigned tg = og / nx;
      if (og + 1u == (tg + 1u) * nx) xb_add(&bar[XB_TOPGEN], 1u);
      else XB_SPIN(xb_ld(&bar[XB_TOPGEN]) == tg, bar);
      __builtin_amdgcn_fence(__ATOMIC_ACQUIRE, "agent");
      xb_add(&bar[XB_XGEN(b.x)], 1u);
      asm volatile("s_waitcnt vmcnt(0)" ::: "memory");
    } else {
      XB_SPIN(xb_ld(&bar[XB_XGEN(b.x)]) == gen, bar);
      __builtin_amdgcn_fence(__ATOMIC_ACQUIRE, "agent");
      asm volatile("s_waitcnt vmcnt(0)" ::: "memory");
    }
  }
  __syncthreads();
}

constexpr int BK = 64, LDT = BK + 8;
constexpr int NTHR = 512;
constexpr int SMEM_BYTES = 2 * 256 * LDT * 2 + 1024;

template <int NCB>
DI void gemm_mainloop(const u16* __restrict__ A, int lda, const u16* __restrict__ Bt, int ldb, int K,
                      u16* sA, u16* sB, f32x16 (&acc)[4][NCB]) {
  const int tid = tid_opaque(), lane = tid & 63, wave = tid >> 6, wm = wave >> 2, wn = wave & 3, r = lane & 31, h = lane >> 5;
  const int lrow = tid >> 3, lcol = (tid & 7) * 8;
  constexpr int NB = 2 * NCB;
  const u16* gA = A + (size_t)lrow * lda + lcol;
  const u16* gB = Bt + (size_t)lrow * ldb + lcol;
  u32x4 ra0[4], rb0[NB], ra1[4], rb1[NB];
#pragma unroll
  for (int i = 0; i < 4; ++i) ra0[i] = *(const u32x4*)(gA + (size_t)(64 * i) * lda);
#pragma unroll
  for (int i = 0; i < NB; ++i) rb0[i] = *(const u32x4*)(gB + (size_t)(64 * i) * ldb);
  asm volatile("" ::: "memory");
#pragma unroll
  for (int i = 0; i < 4; ++i) ra1[i] = *(const u32x4*)(gA + BK + (size_t)(64 * i) * lda);
#pragma unroll
  for (int i = 0; i < NB; ++i) rb1[i] = *(const u32x4*)(gB + BK + (size_t)(64 * i) * ldb);
#pragma unroll
  for (int a = 0; a < 4; ++a)
#pragma unroll
    for (int b = 0; b < NCB; ++b)
#pragma unroll
      for (int i = 0; i < 16; ++i) acc[a][b][i] = 0.f;
  const u16* rA = sA + (128 * wm + r) * LDT + 8 * h;
  const u16* rB = sB + (32 * NCB * wn + r) * LDT + 8 * h;
#define GEMM_STEP(RA_, RB_, KNEXT)                                                              \
  {                                                                                             \
    __syncthreads();                                                                            \
    _Pragma("unroll") for (int i = 0; i < 4; ++i) *(u32x4*)(sA + (lrow + 64 * i) * LDT + lcol) = RA_[i];  \
    _Pragma("unroll") for (int i = 0; i < NB; ++i) *(u32x4*)(sB + (lrow + 64 * i) * LDT + lcol) = RB_[i]; \
    __syncthreads();                                                                            \
    {                                                                                           \
      const int kn = min((KNEXT), K - BK);     \
      _Pragma("unroll") for (int i = 0; i < 4; ++i) RA_[i] = *(const u32x4*)(gA + kn + (size_t)(64 * i) * lda);  \
      _Pragma("unroll") for (int i = 0; i < NB; ++i) RB_[i] = *(const u32x4*)(gB + kn + (size_t)(64 * i) * ldb); \
    }                                                                                           \
    _Pragma("unroll") for (int ks = 0; ks < 4; ++ks) {                                          \
      bf16x8 af[4], bf[NCB];                                                                    \
      _Pragma("unroll") for (int a = 0; a < 4; ++a) af[a] = *(const bf16x8*)(rA + 32 * a * LDT + 16 * ks);   \
      _Pragma("unroll") for (int b = 0; b < NCB; ++b) bf[b] = *(const bf16x8*)(rB + 32 * b * LDT + 16 * ks); \
      _Pragma("unroll") for (int a = 0; a < 4; ++a)                                             \
        _Pragma("unroll") for (int b = 0; b < NCB; ++b) acc[a][b] = MFMA32(af[a], bf[b], acc[a][b]);         \
    }                                                                                           \
  }
  for (int k0 = 0; k0 < K; k0 += 2 * BK) {
    GEMM_STEP(ra0, rb0, k0 + 2 * BK)
    GEMM_STEP(ra1, rb1, k0 + 3 * BK)
  }
#undef GEMM_STEP
}

DI void transpose_tile(const float* __restrict__ src, int sld, u16* __restrict__ dst, int dld,
                       const float* __restrict__ scale, float* sm) {
  const int tid = tid_opaque();
  const int nn = tid & 63, kq = tid >> 6;
#pragma unroll
  for (int i = 0; i < 8; ++i) {
    const int kk = kq + 8 * i;
    float v = src[(size_t)kk * sld + nn];
    if (scale) v *= scale[kk];
    sm[kk * 65 + nn] = v;
  }
  __syncthreads();
  const int kp = (tid & 31) * 2, nq = tid >> 5;
#pragma unroll
  for (int i = 0; i < 4; ++i) {
    const int n2 = nq + 16 * i;
    const unsigned u = pack2(sm[kp * 65 + n2], sm[(kp + 1) * 65 + n2]);
    *(unsigned*)(dst + (size_t)n2 * dld + kp) = u;
  }
  __syncthreads();
}

DI uint4 cvt8(const float* __restrict__ s) {
  const float4 a = *(const float4*)s, b = *(const float4*)(s + 4);
  uint4 o;
  o.x = pack2(a.x, a.y); o.y = pack2(a.z, a.w); o.z = pack2(b.x, b.y); o.w = pack2(b.z, b.w);
  return o;
}

DI void phase0(const Params& p, float* sm) {
  const int tid = tid_opaque();
  unsigned char* ws = p.ws;
  if (blockIdx.x == 0 && tid < 4) ((int*)(ws + OFF_CTR))[tid] = 0;
  for (int j = blockIdx.x; j < 9344; j += gridDim.x) {
    const float* src; u16* dst; const float* scale = nullptr; int sld, dld;
    if (j < 2048) {
      const int l = j >> 10, kt = (j >> 6) & 15, nt = j & 63;
      src = p.win + ((size_t)l * 1024 + kt * 64) * 4096 + nt * 64; sld = 4096;
      dst = (u16*)(ws + OFF_WIN) + ((size_t)l * 4096 + nt * 64) * 1024 + kt * 64; dld = 1024;
      scale = p.gpre + l * 1024 + kt * 64;
    } else if (j < 3072) {
      const int jj = (j - 2048) & 511;
      const bool gate = j >= 2560;
      const int l = jj >> 8, kt = (jj >> 4) & 15, nt = jj & 15;
      src = (gate ? p.wgate : p.wout) + ((size_t)l * 1024 + kt * 64) * 1024 + nt * 64; sld = 1024;
      dst = (u16*)(ws + (gate ? OFF_WGATE : OFF_WOUT)) + ((size_t)l * 1024 + nt * 64) * 1024 + kt * 64; dld = 1024;
    } else if (j < 3200) {
      const int jj = j - 3072;
      const int l = jj >> 6, kt = (jj >> 4) & 3, nt = jj & 15;
      src = p.wple + ((size_t)l * 256 + kt * 64) * 1024 + nt * 64; sld = 1024;
      dst = (u16*)(ws + OFF_WPLE) + ((size_t)l * 1024 + nt * 64) * 256 + kt * 64; dld = 256;
    } else if (j < 5248) {
      const int jj = j - 3200;
      const int lbh = jj >> 3, kt = jj & 7;
      const int lb = lbh >> 3, hd = lbh & 7;
      src = p.cav + ((size_t)lb * 512 + kt * 64) * 512 + hd * 64; sld = 512;
      dst = (u16*)(ws + OFF_VAST) + (size_t)lbh * 64 * 544 + kt * 64; dld = 544;
    } else {
      const int jj = j - 5248;
      const int lbh = jj >> 4, kt = jj & 15;
      const int lb = lbh >> 3, hd = lbh & 7;
      src = p.cbv + ((size_t)lb * 1024 + kt * 64) * 512 + hd * 64; sld = 512;
      dst = (u16*)(ws + OFF_VBST) + (size_t)lbh * 64 * 1056 + kt * 64; dld = 1056;
    }
    transpose_tile(src, sld, dst, dld, scale, sm);
  }
  const size_t gtid = (size_t)blockIdx.x * NTHR + tid, gn = (size_t)gridDim.x * NTHR;
  for (size_t e = gtid; e < (size_t)1048576; e += gn) {
    const int d8 = e & 7, hd = (e >> 3) & 7, s = (e >> 6) & 511, lb = (int)(e >> 15);
    *(uint4*)((u16*)(ws + OFF_KAS) + (((size_t)lb * 8 + hd) * 544 + s) * 64 + d8 * 8) = cvt8(p.cak + e * 8);
  }
  for (size_t e = gtid; e < (size_t)2097152; e += gn) {
    const int d8 = e & 7, hd = (e >> 3) & 7, s = (e >> 6) & 1023, lb = (int)(e >> 16);
    *(uint4*)((u16*)(ws + OFF_KBS) + (((size_t)lb * 8 + hd) * 1056 + s) * 64 + d8 * 8) = cvt8(p.cbk + e * 8);
  }
  for (size_t e = gtid; e < (size_t)2 * MT * 32; e += gn) {
    const int c8 = e & 31;
    const size_t lr = e >> 5;
    const int l = (int)(lr / MT), row = (int)(lr % MT);
    const float* src = row < MP ? p.pp + ((size_t)l * MP + row) * 256 : p.ps + ((size_t)l * MS + (row - MP)) * 256;
    *(uint4*)((u16*)(ws + OFF_PB) + lr * 256 + c8 * 8) = cvt8(src + c8 * 8);
  }
  const int lane = tid & 63;
  const int gw = (int)(gtid >> 6), nw = (int)(gn >> 6);
  for (int row = gw; row < MT; row += nw) {
    const float* src = row < MP ? p.xp + (size_t)row * 1024 : p.xs + (size_t)(row - MP) * 1024;
    u16* dst = (u16*)(ws + OFF_R0) + (size_t)row * 1024;
    float ss = 0.f;
#pragma unroll
    for (int j = 0; j < 2; ++j) {
      const int c = 8 * lane + 512 * j;
      const float4 a = *(const float4*)(src + c), b = *(const float4*)(src + c + 4);
      ss += a.x * a.x + a.y * a.y + a.z * a.z + a.w * a.w + b.x * b.x + b.y * b.y + b.z * b.z + b.w * b.w;
      uint4 o;
      o.x = pack2(a.x, a.y); o.y = pack2(a.z, a.w); o.z = pack2(b.x, b.y); o.w = pack2(b.z, b.w);
      *(uint4*)(dst + c) = o;
    }
#pragma unroll
    for (int m = 32; m >= 1; m >>= 1) ss += __shfl_xor(ss, m);
    if (lane < 32) ((float*)(ws + OFF_PSUM))[(size_t)row * 32 + lane] = lane == 0 ? ss : 0.f;
  }
}

DI void p1_tile(const Params& p, int layer, int mt, int nt, u16* sA, u16* sB, float* rstd_s, const u16* HB, u16* Gbuf) {
  const int tid = tid_opaque();
  const int m0 = mt * 256, n0 = nt * 256;
  unsigned char* ws = p.ws;
  __syncthreads();
  if (tid < 256) {
    const float4* ps = (const float4*)((const float*)(ws + OFF_PSUM) + (size_t)(m0 + tid) * 32);
    float s = 0.f;
#pragma unroll
    for (int j = 0; j < 8; ++j) { const float4 v = ps[j]; s += v.x + v.y + v.z + v.w; }
    rstd_s[tid] = rsqrtf(s * (1.0f / 1024.0f) + EPS);
  }
  f32x16 acc[4][2];
  gemm_mainloop<2>(HB + (size_t)m0 * 1024, 1024, (const u16*)(ws + OFF_WIN) + ((size_t)layer * 4096 + n0) * 1024, 1024, 1024, sA, sB, acc);
#if PROBE_DUP == 3
  gemm_mainloop<2>(HB + (size_t)m0 * 1024, 1024, (const u16*)(ws + OFF_WIN) + ((size_t)layer * 4096 + n0) * 1024, 1024, 1024, sA, sB, acc);
#endif

  int tl = tid_opaque();
  const int lane = tl & 63, wave = tl >> 6, wm = wave >> 2, wn = wave & 3, r = lane & 31, h = lane >> 5;
  const int seg = n0 >> 9, kind = seg & 3, grp = seg >> 2;
  const int hd = ((n0 & 511) >> 6) + wn;
  const bool prompt = m0 < MP;
  float* out = p.out;
  __syncthreads();
  float* st = (float*)sA + wave * (32 * 68);
#if PROBE_DUP == 4
#pragma unroll 1
  for (int rbx = 0; rbx < 8; ++rbx) {
    const int rb = rbx & 3;
#else
#pragma unroll 1
  for (int rb = 0; rb < 4; ++rb) {
#endif
    const int lrow0 = 128 * wm + 32 * rb;
    const int row0 = m0 + lrow0;
    int b, s0;
    if (prompt) { b = row0 >> 11; s0 = row0 & 2047; } else { b = (row0 - MP) >> 5; s0 = 0; }
    const int lb = layer * 16 + b;
#pragma unroll
    for (int cb = 0; cb < 2; ++cb)
#pragma unroll
      for (int i = 0; i < 16; ++i) {
        const int t = crow(i, h);
        const float a = rb == 0 ? acc[0][cb][i] : rb == 1 ? acc[1][cb][i] : rb == 2 ? acc[2][cb][i] : acc[3][cb][i];
        st[t * 68 + 32 * cb + r] = a * rstd_s[lrow0 + t];
      }
    if (kind == 3) {
      u16* gp = Gbuf + (size_t)row0 * 1024 + grp * 512 + hd * 64;
#pragma unroll
      for (int j = 0; j < 8; ++j) {
        const int c = lane + 64 * j, t = c >> 4, c4 = (c & 15) * 4;
        const float4 x = *(const float4*)(st + t * 68 + c4);
        uint2 o;
        o.x = pack2(x.x / (1.0f + __expf(-x.x)), x.y / (1.0f + __expf(-x.y)));
        o.y = pack2(x.z / (1.0f + __expf(-x.z)), x.w / (1.0f + __expf(-x.w)));
        *(uint2*)(gp + (size_t)t * 1024 + c4) = o;
      }
    } else if (kind == 0) {
      u16* base;
      if (prompt) base = (u16*)(ws + (grp ? OFF_QB : OFF_QA)) + (((size_t)b * 8 + hd) * 2048 + s0) * 64;
      else base = (u16*)(ws + (grp ? OFF_QBS : OFF_QAS)) + (((size_t)b * 8 + hd) * 32) * 64;
#pragma unroll
      for (int j = 0; j < 8; ++j) {
        const int c = lane + 64 * j, t = c >> 4, c4 = (c & 15) * 4;
        const float4 x = *(const float4*)(st + t * 68 + c4);
        uint2 o;
        o.x = pack2(x.x * QSCALE, x.y * QSCALE);
        o.y = pack2(x.z * QSCALE, x.w * QSCALE);
        *(uint2*)(base + t * 64 + c4) = o;
      }
    } else {
      float* fo = nullptr;
      if (prompt) {
        if (grp == 0) {
          if (s0 >= 1536) fo = out + (kind == 1 ? O_AKP : O_AVP) + ((size_t)lb * 512 + (s0 - 1536)) * 512 + hd * 64;
        } else {
          fo = out + (kind == 1 ? O_BKP : O_BVP) + ((size_t)lb * 2048 + s0) * 512 + hd * 64;
        }
      } else {
        if (grp == 0) fo = out + (kind == 1 ? O_AKS : O_AVS) + ((size_t)lb * 32) * 512 + hd * 64;
        else fo = out + (kind == 1 ? O_BKS : O_BVS) + ((size_t)lb * 32) * 512 + hd * 64;
      }
      u16* base = nullptr;
      if (kind == 1) {
        if (prompt) base = (u16*)(ws + (grp ? OFF_KB : OFF_KA)) + (((size_t)b * 8 + hd) * 2048 + s0) * 64;
        else if (grp == 0) base = (u16*)(ws + OFF_KAS) + (((size_t)lb * 8 + hd) * 544 + 512) * 64;
        else base = (u16*)(ws + OFF_KBS) + (((size_t)lb * 8 + hd) * 1056 + 1024) * 64;
      }
#pragma unroll
      for (int j = 0; j < 8; ++j) {
        const int c = lane + 64 * j, t = c >> 4, c4 = (c & 15) * 4;
        const float4 x = *(const float4*)(st + t * 68 + c4);
        if (fo) *(float4*)(fo + (size_t)t * 512 + c4) = x;
        if (kind == 1) {
          uint2 o; o.x = pack2(x.x, x.y); o.y = pack2(x.z, x.w);
          *(uint2*)(base + t * 64 + c4) = o;
        }
      }
      if (kind == 2) {
        u16* vb; int ldv;
        if (prompt) { vb = (u16*)(ws + (grp ? OFF_VBT : OFF_VAT)) + (((size_t)b * 8 + hd) * 64) * 2048 + s0; ldv = 2048; }
        else if (grp == 0) { vb = (u16*)(ws + OFF_VAST) + (((size_t)lb * 8 + hd) * 64) * 544 + 512; ldv = 544; }
        else { vb = (u16*)(ws + OFF_VBST) + (((size_t)lb * 8 + hd) * 64) * 1056 + 1024; ldv = 1056; }
#pragma unroll
        for (int t8 = 0; t8 < 4; ++t8) {
          float x[8];
#pragma unroll
          for (int jj = 0; jj < 8; ++jj) x[jj] = st[(8 * t8 + jj) * 68 + lane];
          u32x4 o;
          o[0] = pack2(x[0], x[1]); o[1] = pack2(x[2], x[3]); o[2] = pack2(x[4], x[5]); o[3] = pack2(x[6], x[7]);
          *(u32x4*)(vb + (size_t)lane * ldv + 8 * t8) = o;
        }
      }
    }
  }
}

constexpr float LOG2E = 1.4426950408889634f;
constexpr float SB_EXIT = -180.0f;
DI float ex2(float x) { return __builtin_amdgcn_exp2f(x); }
DI float lg2(float x) { return __builtin_amdgcn_logf(x); }

DI void attn_store(const f32x16& o0, const f32x16& o1, float scale, const u16* Gp, u16* Mp, int r, int h) {
#pragma unroll
  for (int db = 0; db < 2; ++db)
#pragma unroll
    for (int g = 0; g < 4; ++g) {
      const int d0 = 32 * db + 8 * g + 4 * h;
      const uint2 gv = *(const uint2*)(Gp + (size_t)r * 1024 + d0);
      const float x0 = (db ? o1[4 * g] : o0[4 * g]) * scale * bflo(gv.x);
      const float x1 = (db ? o1[4 * g + 1] : o0[4 * g + 1]) * scale * bfhi(gv.x);
      const float x2 = (db ? o1[4 * g + 2] : o0[4 * g + 2]) * scale * bflo(gv.y);
      const float x3 = (db ? o1[4 * g + 3] : o0[4 * g + 3]) * scale * bfhi(gv.y);
      uint2 o; o.x = pack2(x0, x1); o.y = pack2(x2, x3);
      *(uint2*)(Mp + (size_t)r * 1024 + d0) = o;
    }
}

DI bf16x8 ldv8(const u16* vp) {
  const bf16x4 lo = *(const bf16x4*)vp;
  const bf16x4 hi = *(const bf16x4*)(vp + 8);
  return __builtin_shufflevector(lo, hi, 0, 1, 2, 3, 4, 5, 6, 7);
}

DI bf16x8 pack8(const float* v) {
  u32x4 u;
  u[0] = pack2(v[0], v[1]); u[1] = pack2(v[2], v[3]); u[2] = pack2(v[4], v[5]); u[3] = pack2(v[6], v[7]);
  return __builtin_bit_cast(bf16x8, u);
}

DI void make_tf(bf16x8 (&tf)[2], int r, int h) {
#pragma unroll
  for (int s = 0; s < 2; ++s)
#pragma unroll
    for (int j = 0; j < 8; ++j) tf[s][j] = (16 * s + 8 * (j >> 2) + 4 * h + (j & 3) > r) ? (short)0x3F80 : (short)0;
}

DI void sb_step(const f32x16& st, const bf16x8 (&vf)[2][2], const bf16x8 (&tf)[2], int k0, int qpos, int h,
                f32x16& o0, f32x16& o1, float& carry) {
  float l1m[16], lb[16];
  float csum = 0.f;
#pragma unroll
  for (int i = 0; i < 16; ++i) {
    const float z = st[i];
    const bool c = (k0 + crow(i, h)) < qpos;
    const float sp = fmaxf(z, 0.f) + lg2(1.0f + ex2(-fabsf(z)));
    l1m[i] = c ? -sp : 0.f;
    lb[i] = c ? (z - sp) : -1e30f;
    csum += l1m[i];
  }
  csum += __shfl_xor(csum, 32);
  f32x16 af;
#pragma unroll
  for (int i = 0; i < 16; ++i) af[i] = 0.f;
  af = MFMA32(tf[0], pack8(l1m), af);
  af = MFMA32(tf[1], pack8(l1m + 8), af);
  float w[16];
#pragma unroll
  for (int i = 0; i < 16; ++i) w[i] = ex2(lb[i] + af[i] + carry);
  carry += csum;
  const bf16x8 w0 = pack8(w), w1 = pack8(w + 8);
  o0 = MFMA32(vf[0][0], w0, o0);
  o0 = MFMA32(vf[0][1], w1, o0);
  o1 = MFMA32(vf[1][0], w0, o1);
  o1 = MFMA32(vf[1][1], w1, o1);
}

template <bool SCALE_BIAS, typename BiasPtr>
DI void band_step(const f32x16& st, const bf16x8 (&vf)[2][2], BiasPtr bias, float b0, int relmax, int relc, int h,
                  f32x16& o0, f32x16& o1, float& m, float& l) {
  float sv[16];
  if (relmax <= -128) {
#pragma unroll
    for (int i = 0; i < 16; ++i) sv[i] = st[i] + b0;
  } else {
#pragma unroll
    for (int i = 0; i < 16; ++i) {
      int rel = relc + crow(i, h);
      rel = min(max(rel, -128), 128) + 128;
      const float bv = bias[rel];
      sv[i] = st[i] + (SCALE_BIAS ? bv * LOG2E : bv);
    }
  }
  float mt = sv[0];
#pragma unroll
  for (int i = 1; i < 16; ++i) mt = fmaxf(mt, sv[i]);
  mt = fmaxf(mt, __shfl_xor(mt, 32));
  const float mnew = fmaxf(m, mt);
  const float alpha = ex2(m - mnew);
  m = mnew;
  float ps = 0.f;
#pragma unroll
  for (int i = 0; i < 16; ++i) { sv[i] = ex2(sv[i] - mnew); ps += sv[i]; }
  l = l * alpha + ps;
#pragma unroll
  for (int i = 0; i < 16; ++i) { o0[i] *= alpha; o1[i] *= alpha; }
  const bf16x8 w0 = pack8(sv), w1 = pack8(sv + 8);
  o0 = MFMA32(vf[0][0], w0, o0);
  o0 = MFMA32(vf[0][1], w1, o0);
  o1 = MFMA32(vf[1][0], w0, o1);
  o1 = MFMA32(vf[1][1], w1, o1);
}

DI void sb_item(const u16* __restrict__ Q, const u16* __restrict__ Kb, const u16* __restrict__ VT, int ldv,
                int qpos0, int ntiles, const u16* Gp, u16* Mp) {
  const int lane = tid_opaque() & 63, r = lane & 31, h = lane >> 5;
  bf16x8 qf[4];
#pragma unroll
  for (int ks = 0; ks < 4; ++ks) qf[ks] = *(const bf16x8*)(Q + r * 64 + 16 * ks + 8 * h);
  bf16x8 tf[2];
  make_tf(tf, r, h);
  f32x16 o0, o1;
#pragma unroll
  for (int i = 0; i < 16; ++i) { o0[i] = 0.f; o1[i] = 0.f; }
  float carry = 0.f;
  const int qpos = qpos0 + r;
  for (int kt = ntiles - 1; kt >= 0; --kt) {
    const int k0 = kt * 32;
    f32x16 st;
#pragma unroll
    for (int i = 0; i < 16; ++i) st[i] = 0.f;
    const u16* kp = Kb + (size_t)(k0 + r) * 64 + 8 * h;
#pragma unroll
    for (int ks = 0; ks < 4; ++ks) {
      const bf16x8 kf = *(const bf16x8*)(kp + 16 * ks);
      st = MFMA32(kf, qf[ks], st);
    }
    bf16x8 vf[2][2];
#pragma unroll
    for (int db = 0; db < 2; ++db)
#pragma unroll
      for (int s = 0; s < 2; ++s) vf[db][s] = ldv8(VT + (size_t)(32 * db + r) * ldv + k0 + 16 * s + 4 * h);
    sb_step(st, vf, tf, k0, qpos, h, o0, o1, carry);
    if (__all(carry < SB_EXIT)) break;
  }
  attn_store(o0, o1, 1.0f, Gp, Mp, r, h);
}

DI void band_item(const u16* __restrict__ Q, const u16* __restrict__ Kb, const u16* __restrict__ VT, int ldv,
                  int kt_begin, int kt_end, int relbase, const float* __restrict__ bias, const u16* Gp, u16* Mp) {
  const int lane = tid_opaque() & 63, r = lane & 31, h = lane >> 5;
  bf16x8 qf[4];
#pragma unroll
  for (int ks = 0; ks < 4; ++ks) qf[ks] = *(const bf16x8*)(Q + r * 64 + 16 * ks + 8 * h);
  f32x16 o0, o1;
#pragma unroll
  for (int i = 0; i < 16; ++i) { o0[i] = 0.f; o1[i] = 0.f; }
  float m = -1e30f, l = 0.f;
  const float b0 = bias[0] * LOG2E;
  for (int kt = kt_begin; kt < kt_end; ++kt) {
    const int k0 = kt * 32;
    f32x16 st;
#pragma unroll
    for (int i = 0; i < 16; ++i) st[i] = 0.f;
    const u16* kp = Kb + (size_t)(k0 + r) * 64 + 8 * h;
#pragma unroll
    for (int ks = 0; ks < 4; ++ks) {
      const bf16x8 kf = *(const bf16x8*)(kp + 16 * ks);
      st = MFMA32(kf, qf[ks], st);
    }
    bf16x8 vf[2][2];
#pragma unroll
    for (int db = 0; db < 2; ++db)
#pragma unroll
      for (int s = 0; s < 2; ++s) vf[db][s] = ldv8(VT + (size_t)(32 * db + r) * ldv + k0 + 16 * s + 4 * h);
    band_step<true>(st, vf, bias, b0, k0 + 31 + relbase, k0 + relbase - r, h, o0, o1, m, l);
  }
  l += __shfl_xor(l, 32);
  attn_store(o0, o1, 1.0f / l, Gp, Mp, r, h);
}

constexpr int AT_KS = 72, AT_VS = 68;
constexpr int AT_STAGE = 64 * AT_KS + 64 * AT_VS;
constexpr int AT_BIAS_OFF = 2 * AT_STAGE * 2;

struct KvRegs { u32x4 k, v; };
DI KvRegs kv_load(const u16* __restrict__ Kb, const u16* __restrict__ VT, int ldv, int k0, int tid) {
  KvRegs g;
  const int row = tid >> 3, ch = tid & 7;
  g.k = *(const u32x4*)(Kb + (size_t)(k0 + row) * 64 + ch * 8);
  g.v = *(const u32x4*)(VT + (size_t)row * ldv + k0 + ch * 8);
  return g;
}
DI void kv_store(u16* stage, const KvRegs& g, int tid) {
  const int row = tid >> 3, ch = tid & 7;
  *(u32x4*)(stage + row * AT_KS + ch * 8) = g.k;
  uint2 lo, hi; lo.x = g.v[0]; lo.y = g.v[1]; hi.x = g.v[2]; hi.y = g.v[3];
  u16* vp = stage + 64 * AT_KS + row * AT_VS + ch * 8;
  *(uint2*)vp = lo;
  *(uint2*)(vp + 4) = hi;
}
DI void lds_frags(const u16* stage, int sub, const bf16x8 (&qf)[4], int r, int h, f32x16& st, bf16x8 (&vf)[2][2]) {
#pragma unroll
  for (int i = 0; i < 16; ++i) st[i] = 0.f;
  const u16* kp = stage + (32 * sub + r) * AT_KS + 8 * h;
#pragma unroll
  for (int ks = 0; ks < 4; ++ks) {
    const bf16x8 kf = *(const bf16x8*)(kp + 16 * ks);
    st = MFMA32(kf, qf[ks], st);
  }
#pragma unroll
  for (int db = 0; db < 2; ++db)
#pragma unroll
    for (int s = 0; s < 2; ++s) vf[db][s] = ldv8(stage + 64 * AT_KS + (32 * db + r) * AT_VS + 32 * sub + 16 * s + 4 * h);
}

DI void sbp_unit(const u16* __restrict__ Qb, const u16* __restrict__ Kb, const u16* __restrict__ VT, int qblk,
                 const u16* Gp, u16* Mp, u16* sm) {
  const int tid = tid_opaque(), lane = tid & 63, wave = tid >> 6, r = lane & 31, h = lane >> 5;
  const int q0w = qblk * 256 + 32 * wave;
  bf16x8 qf[4];
#pragma unroll
  for (int ks = 0; ks < 4; ++ks) qf[ks] = *(const bf16x8*)(Qb + (size_t)(q0w + r) * 64 + 16 * ks + 8 * h);
  bf16x8 tf[2];
  make_tf(tf, r, h);
  f32x16 o0, o1;
#pragma unroll
  for (int i = 0; i < 16; ++i) { o0[i] = 0.f; o1[i] = 0.f; }
  float carry = 0.f;
  int done = 0;
  const int qpos = q0w + r;
  const int t_hi = qblk * 4 + 3;
  {
    const KvRegs g = kv_load(Kb, VT, 2048, t_hi * 64, tid);
    kv_store(sm, g, tid);
  }
  __syncthreads();
  int cur = 0;
  for (int t = t_hi;; --t) {
    KvRegs g;
    if (t > 0) g = kv_load(Kb, VT, 2048, (t - 1) * 64, tid);
    const u16* stage = sm + cur * AT_STAGE;
    if (!done) {
#pragma unroll
      for (int sub = 1; sub >= 0; --sub) {
        const int k0 = t * 64 + sub * 32;
        if (k0 < q0w + 31) {
          f32x16 st; bf16x8 vf[2][2];
          lds_frags(stage, sub, qf, r, h, st, vf);
          sb_step(st, vf, tf, k0, qpos, h, o0, o1, carry);
        }
      }
      done = __all(carry < SB_EXIT) ? 1 : 0;
    }
    if (t == 0) break;
    kv_store(sm + (cur ^ 1) * AT_STAGE, g, tid);
    if (__syncthreads_and(done)) break;
    cur ^= 1;
  }
  attn_store(o0, o1, 1.0f, Gp + (size_t)(32 * wave) * 1024, Mp + (size_t)(32 * wave) * 1024, r, h);
}

DI void bp_unit(const u16* __restrict__ Qb, const u16* __restrict__ Kb, const u16* __restrict__ VT, int qblk,
                const float* __restrict__ bias_g, const u16* Gp, u16* Mp, u16* sm) {
  const int tid = tid_opaque(), lane = tid & 63, wave = tid >> 6, r = lane & 31, h = lane >> 5;
  const int q0w = qblk * 256 + 32 * wave;
  const int cw = qblk * 4 + (wave >> 1);
  float* sbias = (float*)((unsigned char*)sm + AT_BIAS_OFF);
  if (tid < 257) sbias[tid] = bias_g[tid] * LOG2E;
  bf16x8 qf[4];
#pragma unroll
  for (int ks = 0; ks < 4; ++ks) qf[ks] = *(const bf16x8*)(Qb + (size_t)(q0w + r) * 64 + 16 * ks + 8 * h);
  f32x16 o0, o1;
#pragma unroll
  for (int i = 0; i < 16; ++i) { o0[i] = 0.f; o1[i] = 0.f; }
  float m = -1e30f, l = 0.f;
  const int t_hi = qblk * 4 + 3, t_lo = max(0, qblk * 4 - 8);
  {
    const KvRegs g = kv_load(Kb, VT, 2048, t_hi * 64, tid);
    kv_store(sm, g, tid);
  }
  __syncthreads();
  const float b0 = sbias[0];
  int cur = 0;
  for (int t = t_hi;; --t) {
    KvRegs g;
    if (t > t_lo) g = kv_load(Kb, VT, 2048, (t - 1) * 64, tid);
    const u16* stage = sm + cur * AT_STAGE;
    if (t <= cw && t >= cw - 8) {
#pragma unroll
      for (int sub = 0; sub < 2; ++sub) {
        const int k0 = t * 64 + sub * 32;
        f32x16 st; bf16x8 vf[2][2];
        lds_frags(stage, sub, qf, r, h, st, vf);
        band_step<false>(st, vf, sbias, b0, k0 + 31 - q0w, k0 - q0w - r, h, o0, o1, m, l);
      }
    }
    if (t == t_lo) break;
    kv_store(sm + (cur ^ 1) * AT_STAGE, g, tid);
    __syncthreads();
    cur ^= 1;
  }
  l += __shfl_xor(l, 32);
  attn_store(o0, o1, 1.0f / l, Gp + (size_t)(32 * wave) * 1024, Mp + (size_t)(32 * wave) * 1024, r, h);
}

constexpr int N_UNITS = 32 + 1024 + 1024;

DI void phase2(const Params& p, int layer, const u16* Gbuf, u16* MIX, u16* sm, int cslot = 0) {
  unsigned char* ws = p.ws;
  int* ctr = (int*)(ws + OFF_CTR) + layer + cslot;
  int* s_unit = (int*)((unsigned char*)sm + AT_BIAS_OFF + 257 * 4 + 12);
  for (;;) {
    __syncthreads();
    if (threadIdx.x == 0) *s_unit = atomicAdd(ctr, 1);
    __syncthreads();
    const int u = *s_unit;
    if (u >= N_UNITS) break;
    if (u < 32) {
      const int wave = tid_opaque() >> 6;
      const int item = u * 8 + wave;
      if (item < 128) {
        const int bh = item, b = bh >> 3, hd = bh & 7;
        const size_t row0 = (size_t)MP + b * 32;
        sb_item((const u16*)(ws + OFF_QBS) + (size_t)bh * 32 * 64,
                (const u16*)(ws + OFF_KBS) + ((size_t)layer * 128 + bh) * 1056 * 64,
                (const u16*)(ws + OFF_VBST) + ((size_t)layer * 128 + bh) * 64 * 1056, 1056,
                1024, 33, Gbuf + row0 * 1024 + 512 + hd * 64, MIX + row0 * 1024 + 512 + hd * 64);
      } else {
        const int bh = item - 128, b = bh >> 3, hd = bh & 7;
        const size_t row0 = (size_t)MP + b * 32;
        band_item((const u16*)(ws + OFF_QAS) + (size_t)bh * 32 * 64,
                  (const u16*)(ws + OFF_KAS) + ((size_t)layer * 128 + bh) * 544 * 64,
                  (const u16*)(ws + OFF_VAST) + ((size_t)layer * 128 + bh) * 64 * 544, 544,
                  0, 17, -512, p.relb + (size_t)(layer * 8 + hd) * 257,
                  Gbuf + row0 * 1024 + hd * 64, MIX + row0 * 1024 + hd * 64);
      }
    } else if (u < 32 + 1024) {
      const int j = u - 32, bh = j >> 3, qblk = 7 - (j & 7), b = bh >> 3, hd = bh & 7;
      const size_t row0 = (size_t)b * 2048 + qblk * 256;
      sbp_unit((const u16*)(ws + OFF_QB) + (size_t)bh * 2048 * 64, (const u16*)(ws + OFF_KB) + (size_t)bh * 2048 * 64,
               (const u16*)(ws + OFF_VBT) + (size_t)bh * 64 * 2048, qblk,
               Gbuf + row0 * 1024 + 512 + hd * 64, MIX + row0 * 1024 + 512 + hd * 64, sm);
    } else {
      const int j = u - 32 - 1024, bh = j >> 3, qblk = 7 - (j & 7), b = bh >> 3, hd = bh & 7;
      const size_t row0 = (size_t)b * 2048 + qblk * 256;
      bp_unit((const u16*)(ws + OFF_QA) + (size_t)bh * 2048 * 64, (const u16*)(ws + OFF_KA) + (size_t)bh * 2048 * 64,
              (const u16*)(ws + OFF_VAT) + (size_t)bh * 64 * 2048, qblk, p.relb + (size_t)(layer * 8 + hd) * 257,
              Gbuf + row0 * 1024 + hd * 64, MIX + row0 * 1024 + hd * 64, sm);
    }
  }
}

DI void p3_tile(const Params& p, int layer, int mt, int nt, u16* sA, u16* sB, const u16* MIX, u16* Y) {
  const int m0 = mt * 256, n0 = nt * 128;
  f32x16 acc[4][1];
  gemm_mainloop<1>(MIX + (size_t)m0 * 1024, 1024, (const u16*)(p.ws + OFF_WOUT) + ((size_t)layer * 1024 + n0) * 1024, 1024, 1024, sA, sB, acc);
  int tl = tid_opaque();
  const int lane = tl & 63, wave = tl >> 6, wm = wave >> 2, wn = wave & 3, r = lane & 31, h = lane >> 5;
  __syncthreads();
  float* st = (float*)sA + wave * (32 * 36);
#pragma unroll 1
  for (int rb = 0; rb < 4; ++rb) {
    const int row0 = m0 + 128 * wm + 32 * rb;
#pragma unroll
    for (int i = 0; i < 16; ++i) {
      const float a = rb == 0 ? acc[0][0][i] : rb == 1 ? acc[1][0][i] : rb == 2 ? acc[2][0][i] : acc[3][0][i];
      st[crow(i, h) * 36 + r] = a;
    }
#pragma unroll
    for (int j = 0; j < 4; ++j) {
      const int c = lane + 64 * j, t = c >> 3, c4 = (c & 7) * 4;
      const float4 x = *(const float4*)(st + t * 36 + c4);
      uint2 o; o.x = pack2(x.x, x.y); o.y = pack2(x.z, x.w);
      *(uint2*)(Y + (size_t)(row0 + t) * 1024 + n0 + 32 * wn + c4) = o;
    }
  }
}

DI void phase4(const Params& p, int layer, const u16* Y, u16* H1B) {
  const int tid = tid_opaque(), lane = tid & 63;
  const int gw = (blockIdx.x * NTHR + tid) >> 6, nw = (gridDim.x * NTHR) >> 6;
  const float* gp = p.gpost + layer * 1024;
  for (int row = gw; row < MT; row += nw) {
    const u16* yr = Y + (size_t)row * 1024;
    float yf[16];
    float ss = 0.f;
#pragma unroll
    for (int j = 0; j < 2; ++j) {
      const uint4 u = *(const uint4*)(yr + 8 * lane + 512 * j);
      yf[8 * j + 0] = bflo(u.x); yf[8 * j + 1] = bfhi(u.x); yf[8 * j + 2] = bflo(u.y); yf[8 * j + 3] = bfhi(u.y);
      yf[8 * j + 4] = bflo(u.z); yf[8 * j + 5] = bfhi(u.z); yf[8 * j + 6] = bflo(u.w); yf[8 * j + 7] = bfhi(u.w);
    }
#pragma unroll
    for (int i = 0; i < 16; ++i) ss += yf[i] * yf[i];
#pragma unroll
    for (int m = 32; m >= 1; m >>= 1) ss += __shfl_xor(ss, m);
    const float rs = rsqrtf(ss * (1.0f / 1024.0f) + EPS);
    const float* hs;
    if (layer == 0) hs = row < MP ? p.xp + (size_t)row * 1024 : p.xs + (size_t)(row - MP) * 1024;
    else hs = p.out + (size_t)row * 1024;
    float* ho = p.out + (size_t)row * 1024;
#pragma unroll
    for (int j = 0; j < 2; ++j) {
      const int c = 8 * lane + 512 * j;
      const float4 a = *(const float4*)(hs + c), b = *(const float4*)(hs + c + 4);
      const float4 ga = *(const float4*)(gp + c), gb = *(const float4*)(gp + c + 4);
      float4 oa, ob;
      oa.x = a.x + yf[8 * j + 0] * rs * ga.x; oa.y = a.y + yf[8 * j + 1] * rs * ga.y;
      oa.z = a.z + yf[8 * j + 2] * rs * ga.z; oa.w = a.w + yf[8 * j + 3] * rs * ga.w;
      ob.x = b.x + yf[8 * j + 4] * rs * gb.x; ob.y = b.y + yf[8 * j + 5] * rs * gb.y;
      ob.z = b.z + yf[8 * j + 6] * rs * gb.z; ob.w = b.w + yf[8 * j + 7] * rs * gb.w;
      *(float4*)(ho + c) = oa; *(float4*)(ho + c + 4) = ob;
      uint4 o;
      o.x = pack2(oa.x, oa.y); o.y = pack2(oa.z, oa.w); o.z = pack2(ob.x, ob.y); o.w = pack2(ob.z, ob.w);
      *(uint4*)(H1B + (size_t)row * 1024 + c) = o;
    }
  }
}

DI void p5_tile(const Params& p, int layer, int mt, int nt, u16* sA, u16* sB, const u16* H1B, u16* HBN) {
  const int m0 = mt * 256, n0 = nt * 128;
  unsigned char* ws = p.ws;
  f32x16 acc[4][1];
  gemm_mainloop<1>((const u16*)(ws + OFF_PB) + ((size_t)layer * MT + m0) * 256, 256,
                   (const u16*)(ws + OFF_WPLE) + ((size_t)layer * 1024 + n0) * 256, 256, 256, sA, sB, acc);
  unsigned pl[4][8];
#pragma unroll
  for (int rb = 0; rb < 4; ++rb)
#pragma unroll
    for (int j = 0; j < 8; ++j) pl[rb][j] = pack2(acc[rb][0][2 * j], acc[rb][0][2 * j + 1]);
  gemm_mainloop<1>(H1B + (size_t)m0 * 1024, 1024, (const u16*)(ws + OFF_WGATE) + ((size_t)layer * 1024 + n0) * 1024, 1024, 1024, sA, sB, acc);
  int tl = tid_opaque();
  const int lane = tl & 63, wave = tl >> 6, wm = wave >> 2, wn = wave & 3, r = lane & 31, h = lane >> 5;
  const int col = n0 + 32 * wn + r;
  __syncthreads();
  float* st = (float*)sA + wave * (32 * 36);
#pragma unroll 1
  for (int rb = 0; rb < 4; ++rb) {
    const int row0 = m0 + 128 * wm + 32 * rb;
#pragma unroll
    for (int i = 0; i < 16; ++i) {
      const int t = crow(i, h);
      float* hp = p.out + (size_t)(row0 + t) * 1024 + col;
      const float h1 = *hp;
      const unsigned plw = rb == 0 ? pl[0][i >> 1] : rb == 1 ? pl[1][i >> 1] : rb == 2 ? pl[2][i >> 1] : pl[3][i >> 1];
      const float pv = (i & 1) ? bfhi(plw) : bflo(plw);
      const float a = rb == 0 ? acc[0][0][i] : rb == 1 ? acc[1][0][i] : rb == 2 ? acc[2][0][i] : acc[3][0][i];
      const float g = 1.0f / (1.0f + __expf(-a));
      const float h2 = h1 + g * pv;
      *hp = h2;
      st[t * 36 + r] = h2;
    }
    if (layer == 0) {
#pragma unroll
      for (int j = 0; j < 4; ++j) {
        const int c = lane + 64 * j, t = c >> 3, c4 = (c & 7) * 4;
        const float4 x = *(const float4*)(st + t * 36 + c4);
        uint2 o; o.x = pack2(x.x, x.y); o.y = pack2(x.z, x.w);
        *(uint2*)(HBN + (size_t)(row0 + t) * 1024 + n0 + 32 * wn + c4) = o;
        float ss = x.x * x.x + x.y * x.y + x.z * x.z + x.w * x.w;
        ss += __shfl_xor(ss, 1); ss += __shfl_xor(ss, 2); ss += __shfl_xor(ss, 4);
        if ((c & 7) == 0) ((float*)(ws + OFF_PSUM))[(size_t)(row0 + t) * 32 + nt * 4 + wn] = ss;
      }
    }
  }
}

__global__ void __launch_bounds__(NTHR, 2) mega(Params p, int ph_begin, int ph_end) {
  extern __shared__ __attribute__((aligned(16))) unsigned char smem[];
  u16* sA = (u16*)smem;
  u16* sB = sA + 256 * LDT;
  float* rstd_s = (float*)(smem + 2 * 256 * LDT * 2);
  unsigned char* ws = p.ws;
  __shared__ uint4 xb_words;
  if (threadIdx.x == 0) xb_words = make_uint4(0u, 0u, 0u, 0u);
  __syncthreads();
  XcdBarrier xb = xcd_barrier_post((unsigned*)(ws + OFF_BAR), (volatile LAS unsigned*)&xb_words);
  if (ph_end < 0) cg::this_grid().sync();
  const int xx = blockIdx.x & 7, xi = blockIdx.x >> 3;
#define PHASE_GATE(PH) if ((PH) >= ph_begin && (PH) < ph_end) { if ((PH) > ph_begin) xcd_barrier(xb);
  PHASE_GATE(0) phase0(p, (float*)smem); }
#pragma unroll 1
  for (int layer = 0; layer < 2; ++layer) {
    asm volatile("" : "+s"(layer));
    u16* RA = (u16*)(ws + ((layer & 1) ? OFF_R1 : OFF_R0));
    u16* RB = (u16*)(ws + ((layer & 1) ? OFF_R0 : OFF_R1));
    const int pb = 1 + 5 * layer;
    PHASE_GATE(pb + 0)
#pragma unroll 1
      for (int j = 0; j < 9; ++j) {
        const int mt = 16 * j + (xi >> 1), nt = 2 * xx + (xi & 1);
        if (mt < 130) p1_tile(p, layer, mt, nt, sA, sB, rstd_s, RA, RB);
      }
    }
    PHASE_GATE(pb + 1) phase2(p, layer, RB, RA, sA); }
#if PROBE_DUP == 2
    xcd_barrier(xb); phase2(p, layer, RB, RA, sA, 2);
#endif

    PHASE_GATE(pb + 2)
#pragma unroll 1
      for (int j = 0; j < 5; ++j) {
        const int mt = j < 4 ? 32 * j + 16 * (xx >> 2) + (xi >> 1) : ((xi >> 1) == 0 ? 128 + (xx >> 2) : 130);
        const int nt = 2 * (xx & 3) + (xi & 1);
        if (mt < 130) p3_tile(p, layer, mt, nt, sA, sB, RA, RB);
      }
    }
    PHASE_GATE(pb + 3) phase4(p, layer, RB, RA); }
#if PROBE_DUP == 5
    if (layer == 0) { xcd_barrier(xb); phase4(p, layer, RB, RA); xcd_barrier(xb); phase4(p, layer, RB, RA); }
#endif
    PHASE_GATE(pb + 4)
#pragma unroll 1
      for (int j = 0; j < 5; ++j) {
        const int mt = j < 4 ? 32 * j + 16 * (xx >> 2) + (xi >> 1) : ((xi >> 1) == 0 ? 128 + (xx >> 2) : 130);
        const int nt = 2 * (xx & 3) + (xi & 1);
        if (mt < 130) p5_tile(p, layer, mt, nt, sA, sB, RA, RB);
      }
    }
  }
}

extern "C" void kernel_launch(void* const* d_in, const int* in_sizes, int n_in, void* d_out, int out_size,
                              void* d_ws, size_t ws_size, hipStream_t stream) {
  Params p{};
  p.xp = (const float*)d_in[0]; p.xs = (const float*)d_in[1]; p.pp = (const float*)d_in[2]; p.ps = (const float*)d_in[3];
  p.cak = (const float*)d_in[4]; p.cav = (const float*)d_in[5]; p.cbk = (const float*)d_in[6]; p.cbv = (const float*)d_in[7];
  p.gpre = (const float*)d_in[8]; p.win = (const float*)d_in[9]; p.relb = (const float*)d_in[10]; p.wout = (const float*)d_in[11];
  p.gpost = (const float*)d_in[12]; p.wple = (const float*)d_in[13]; p.wgate = (const float*)d_in[14];
  p.out = (float*)d_out;
  p.ws = (unsigned char*)d_ws;
  static int grid_blocks = 0;
  if (!grid_blocks) {
    int dev = 0, cus = 0, per_cu = 0;
    (void)hipGetDevice(&dev);
    (void)hipDeviceGetAttribute(&cus, hipDeviceAttributeMultiprocessorCount, dev);
    if (hipFuncSetAttribute((const void*)mega, hipFuncAttributeMaxDynamicSharedMemorySize, SMEM_BYTES) != hipSuccess)
      fprintf(stderr, "hipFuncSetAttribute(MaxDynamicSharedMemorySize=%d) failed\n", SMEM_BYTES);
    (void)hipOccupancyMaxActiveBlocksPerMultiprocessor(&per_cu, mega, NTHR, SMEM_BYTES);
    if (per_cu < 1) per_cu = 1;
    if (per_cu > 1) per_cu = 1;
    grid_blocks = 256;
    if (cus * per_cu < 256) fprintf(stderr, "device too small for a 256-workgroup cooperative grid\n");
  }
#if MK_COOP
  hipMemsetAsync((unsigned char*)d_ws + OFF_BAR, 0, (size_t)XCD_BAR_WORDS * 4, stream);
  int pb = 0, pe = 11;
  void* args[] = {&p, &pb, &pe};
  hipError_t e = hipLaunchCooperativeKernel((void*)mega, dim3(grid_blocks), dim3(NTHR), args, SMEM_BYTES, stream);
  if (e != hipSuccess) fprintf(stderr, "cooperative launch failed: %s (grid %d)\n", hipGetErrorString(e), grid_blocks);
#else
  for (int ph = 0; ph < 11; ++ph) mega<<<dim3(grid_blocks), dim3(NTHR), SMEM_BYTES, stream>>>(p, ph, ph + 1);
#endif
}
```

```cpp
#include <hip/hip_runtime.h>
#include <hip/hip_cooperative_groups.h>
#include <stdint.h>
#include <stdio.h>
namespace cg = cooperative_groups;

#ifndef PROBE_DUP
#define PROBE_DUP 0
#endif
#ifndef SKEW_P1
#define SKEW_P1 0
#define SKEW_P3 0
#define SKEW_P5 0
#endif
#ifndef MK_COOP
#define MK_COOP 1
#endif

typedef __attribute__((ext_vector_type(8))) short bf16x8;
typedef __attribute__((ext_vector_type(4))) short bf16x4;
typedef __attribute__((ext_vector_type(16))) float f32x16;
typedef __attribute__((ext_vector_type(4))) float f32x4;
typedef __attribute__((ext_vector_type(2))) __bf16 bf2_t;
typedef __attribute__((ext_vector_type(2))) float f2_t;
typedef unsigned short u16;
typedef __attribute__((ext_vector_type(4))) unsigned u32x4;

#define DI __device__ __forceinline__
#define MFMA32(a, b, c) __builtin_amdgcn_mfma_f32_32x32x16_bf16((a), (b), (c), 0, 0, 0)

DI unsigned pack2(float a, float b) { f2_t v = {a, b}; bf2_t r = __builtin_convertvector(v, bf2_t); return __builtin_bit_cast(unsigned, r); }
DI u16 f2bf(float a) { return (u16)(pack2(a, 0.f) & 0xffffu); }
DI float bflo(unsigned u) { return __uint_as_float(u << 16); }
DI float bfhi(unsigned u) { return __uint_as_float(u & 0xffff0000u); }
DI int crow(int i, int h) { return (i & 3) + 8 * (i >> 2) + 4 * h; }
typedef __attribute__((ext_vector_type(2))) unsigned u32x2;
typedef __attribute__((ext_vector_type(4))) float f32x4v;
DI void st_nt8(void* p, unsigned a, unsigned b) { u32x2 v = {a, b}; __builtin_nontemporal_store(v, (u32x2*)p); }
DI void st_nt16f(float* p, float4 x) { f32x4v v = {x.x, x.y, x.z, x.w}; __builtin_nontemporal_store(v, (f32x4v*)p); }
DI void st_nt16u(void* p, u32x4 v) { __builtin_nontemporal_store(v, (u32x4*)p); }
DI int tid_opaque() { int t = threadIdx.x; asm volatile("" : "+v"(t)); return t; }

struct Params {
  const float *xp, *xs, *pp, *ps, *cak, *cav, *cbk, *cbv, *gpre, *win, *relb, *wout, *gpost, *wple, *wgate;
  float* out;
  unsigned char* ws;
};

constexpr int MP = 32768, MS = 512, MT = 33280;
constexpr float EPS = 1e-6f;
constexpr float QSCALE = 0.125f * 1.4426950408889634f;

#define XCD_BAR_WORDS 3456
constexpr size_t SZ_ACT = (size_t)MT * 1024 * 2;
constexpr size_t SZ_QKV = (size_t)16 * 8 * 2048 * 64 * 2;
constexpr size_t OFF_WIN = 0;
constexpr size_t OFF_WOUT = OFF_WIN + (size_t)2 * 4096 * 1024 * 2;
constexpr size_t OFF_WGATE = OFF_WOUT + (size_t)2 * 1024 * 1024 * 2;
constexpr size_t OFF_WPLE = OFF_WGATE + (size_t)2 * 1024 * 1024 * 2;
constexpr size_t OFF_R0 = OFF_WPLE + (size_t)2 * 1024 * 256 * 2;
constexpr size_t OFF_R1 = OFF_R0 + SZ_ACT;
constexpr size_t OFF_PB = OFF_R1 + SZ_ACT;
constexpr size_t OFF_PSUM = OFF_PB + (size_t)2 * MT * 256 * 2;
constexpr size_t OFF_QA = OFF_PSUM + (size_t)MT * 32 * 4;
constexpr size_t OFF_KA = OFF_QA + SZ_QKV;
constexpr size_t OFF_VAT = OFF_KA + SZ_QKV;
constexpr size_t OFF_QB = OFF_VAT + SZ_QKV;
constexpr size_t OFF_KB = OFF_QB + SZ_QKV;
constexpr size_t OFF_VBT = OFF_KB + SZ_QKV;
constexpr size_t OFF_QAS = OFF_VBT + SZ_QKV;
constexpr size_t OFF_QBS = OFF_QAS + (size_t)128 * 32 * 64 * 2;
constexpr size_t OFF_KAS = OFF_QBS + (size_t)128 * 32 * 64 * 2;
constexpr size_t OFF_VAST = OFF_KAS + (size_t)2 * 128 * 544 * 64 * 2;
constexpr size_t OFF_KBS = OFF_VAST + (size_t)2 * 128 * 544 * 64 * 2;
constexpr size_t OFF_VBST = OFF_KBS + (size_t)2 * 128 * 1056 * 64 * 2;
constexpr size_t OFF_CTR = OFF_VBST + (size_t)2 * 128 * 1056 * 64 * 2;
constexpr size_t OFF_BAR = OFF_CTR + 256;
constexpr size_t OFF_RSTD = OFF_BAR + (size_t)XCD_BAR_WORDS * 4;
constexpr size_t WS_TOTAL = OFF_RSTD + (size_t)MT * 4;
static_assert(WS_TOTAL <= (size_t)536870912, "workspace too large");
static_assert(OFF_QB - OFF_QA >= SZ_ACT, "ple product must fit in the q/k/v region of head group A");

constexpr size_t O_AKP = 34078720;
constexpr size_t O_AVP = O_AKP + 8388608;
constexpr size_t O_BKP = O_AVP + 8388608;
constexpr size_t O_BVP = O_BKP + 33554432;
constexpr size_t O_AKS = O_BVP + 33554432;
constexpr size_t O_AVS = O_AKS + 524288;
constexpr size_t O_BKS = O_AVS + 524288;
constexpr size_t O_BVS = O_BKS + 524288;


#define XB_TMO      128
#define XB_XCNT(j)  (256  + 64 * (j))
#define XB_XSUB(j)  (1280 + 64 * (j))
#define XB_XGEN(j)  (2304 + 64 * (j))
#define XB_TOP      3328
#define XB_TOPGEN   3392
#define XB_SPIN_CAP (1u << 22)
#define LAS __attribute__((address_space(3)))
DI unsigned xb_ld(unsigned* p) { return __hip_atomic_load(p, __ATOMIC_RELAXED, __HIP_MEMORY_SCOPE_AGENT); }
DI unsigned xb_add(unsigned* p, unsigned v) { return __hip_atomic_fetch_add(p, v, __ATOMIC_RELAXED, __HIP_MEMORY_SCOPE_AGENT); }
DI unsigned xb_xcc_id() { return (unsigned)__builtin_amdgcn_s_getreg((3 << 11) | 20) & 0xFu; }
#define XB_SPIN(cond, bar) do { unsigned _sp = 0; while (cond) { __builtin_amdgcn_s_sleep(1); \
    if ((++_sp & 255u) == 0u) { if (xb_ld(&(bar)[XB_TMO])) break; if (_sp > XB_SPIN_CAP) { atomicAdd(&(bar)[XB_TMO], 1u); break; } } } } while (0)
struct XcdBarrier { unsigned* bar; unsigned x; volatile LAS unsigned* st; };
DI XcdBarrier xcd_barrier_post(unsigned* bar, volatile LAS unsigned* st) {
  XcdBarrier b; b.bar = bar; b.x = xb_xcc_id(); b.st = st;
  if (threadIdx.x == 0) { st[2] = xb_add(&bar[XB_XCNT(b.x)], 1u); st[3] = b.x; }
  return b;
}
DI void xcd_barrier_complete(unsigned* bar, unsigned x, unsigned& nloc, unsigned& nx) {
  const unsigned G = gridDim.x * gridDim.y * gridDim.z;
  unsigned sum, cnt, mine, sp = 0u;
  for (;;) {
    sum = 0u; cnt = 0u; mine = 0u;
#pragma unroll
    for (unsigned j = 0; j < 16; ++j) { const unsigned c = xb_ld(&bar[XB_XCNT(j)]); sum += c; cnt += (c > 0u) ? 1u : 0u; mine = (j == x) ? c : mine; }
    if (sum == G) break;
    __builtin_amdgcn_s_sleep(1);
    if ((++sp & 255u) == 0u) { if (xb_ld(&bar[XB_TMO])) break; if (sp > XB_SPIN_CAP) { atomicAdd(&bar[XB_TMO], 1u); break; } }
  }
  nloc = mine > 0u ? mine : 1u; nx = cnt > 0u ? cnt : 1u;
}
DI void xcd_barrier(const XcdBarrier& b) {
  asm volatile("s_waitcnt vmcnt(0)" ::: "memory");
  __syncthreads();
  if (threadIdx.x == 0) {
    unsigned* bar = b.bar;
    __builtin_amdgcn_s_waitcnt(0);
    unsigned nloc = b.st[0], nx = b.st[1];
    if (nloc == 0u) { xcd_barrier_complete(bar, b.x, nloc, nx); b.st[0] = nloc; b.st[1] = nx; }
    const unsigned old = xb_add(&bar[XB_XSUB(b.x)], 1u);
    const unsigned gen = old / nloc;
    if (old + 1u == (gen + 1u) * nloc) {
      __builtin_amdgcn_fence(__ATOMIC_RELEASE, "agent");
      asm volatile("s_waitcnt vmcnt(0)" ::: "memory");
      const unsigned og = xb_add(&bar[XB_TOP], 1u);
      const unsigned tg = og / nx;
      if (og + 1u == (tg + 1u) * nx) xb_add(&bar[XB_TOPGEN], 1u);
      else XB_SPIN(xb_ld(&bar[XB_TOPGEN]) == tg, bar);
      __builtin_amdgcn_fence(__ATOMIC_ACQUIRE, "agent");
      xb_add(&bar[XB_XGEN(b.x)], 1u);
      asm volatile("s_waitcnt vmcnt(0)" ::: "memory");
    } else {
      XB_SPIN(xb_ld(&bar[XB_XGEN(b.x)]) == gen, bar);
      __builtin_amdgcn_fence(__ATOMIC_ACQUIRE, "agent");
      asm volatile("s_waitcnt vmcnt(0)" ::: "memory");
    }
  }
  __syncthreads();
}

DI void delay_ticks(unsigned ticks) {
  const unsigned long long t0 = __builtin_amdgcn_s_memrealtime();
  while (__builtin_amdgcn_s_memrealtime() - t0 < (unsigned long long)ticks) __builtin_amdgcn_s_sleep(8);
}

constexpr int BK = 64, LDT = BK + 8;
constexpr int NTHR = 512;
constexpr int SMEM_BYTES = 2 * (2 * 256 * LDT * 2) + 1024;

template <int NCB>
DI void gemm_mainloop(const u16* __restrict__ A, int lda, const u16* __restrict__ Bt, int ldb, int K, int ks0,
                      u16* sA, u16* sB, f32x16 (&acc)[4][NCB]) {
  const int kmask = K - 1;
  const int tid = tid_opaque(), lane = tid & 63, wave = tid >> 6, wm = wave >> 2, wn = wave & 3, r = lane & 31, h = lane >> 5;
  const int lrow = tid >> 3, lcol = (tid & 7) * 8;
  constexpr int NB = 2 * NCB;
  const u16* gA = A + (size_t)lrow * lda + lcol;
  const u16* gB = Bt + (size_t)lrow * ldb + lcol;
  u32x4 ra0[4], rb0[NB], ra1[4], rb1[NB];
  const int kf0 = (ks0 * BK) & kmask, kf1 = ((ks0 + 1) * BK) & kmask, kf2 = ((ks0 + 2) * BK) & kmask;
#pragma unroll
  for (int i = 0; i < 4; ++i) ra0[i] = *(const u32x4*)(gA + kf0 + (size_t)(64 * i) * lda);
#pragma unroll
  for (int i = 0; i < NB; ++i) rb0[i] = *(const u32x4*)(gB + kf0 + (size_t)(64 * i) * ldb);
  asm volatile("" ::: "memory");
#pragma unroll
  for (int i = 0; i < 4; ++i) ra1[i] = *(const u32x4*)(gA + kf1 + (size_t)(64 * i) * lda);
#pragma unroll
  for (int i = 0; i < NB; ++i) rb1[i] = *(const u32x4*)(gB + kf1 + (size_t)(64 * i) * ldb);
#pragma unroll
  for (int a = 0; a < 4; ++a)
#pragma unroll
    for (int b = 0; b < NCB; ++b)
#pragma unroll
      for (int i = 0; i < 16; ++i) acc[a][b][i] = 0.f;
  constexpr int STG = 2 * 256 * LDT;
  const u16* rA = sA + (128 * wm + r) * LDT + 8 * h;
  const u16* rB = sB + (32 * NCB * wn + r) * LDT + 8 * h;
  u16* wA = sA + lrow * LDT + lcol;
  u16* wB = sB + lrow * LDT + lcol;
  __syncthreads();
#pragma unroll
  for (int i = 0; i < 4; ++i) *(u32x4*)(wA + 64 * i * LDT) = ra0[i];
#pragma unroll
  for (int i = 0; i < NB; ++i) *(u32x4*)(wB + 64 * i * LDT) = rb0[i];
#pragma unroll
  for (int i = 0; i < 4; ++i) ra0[i] = *(const u32x4*)(gA + kf2 + (size_t)(64 * i) * lda);
#pragma unroll
  for (int i = 0; i < NB; ++i) rb0[i] = *(const u32x4*)(gB + kf2 + (size_t)(64 * i) * ldb);
  __syncthreads();
#define GEMM_STEP(RA_, RB_, WS_, RS_, KNEXT)                                                    \
  {                                                                                             \
    _Pragma("unroll") for (int i = 0; i < 4; ++i) *(u32x4*)(wA + (WS_) * STG + 64 * i * LDT) = RA_[i];  \
    _Pragma("unroll") for (int i = 0; i < NB; ++i) *(u32x4*)(wB + (WS_) * STG + 64 * i * LDT) = RB_[i]; \
    {                                                                                           \
      const int kn = (KNEXT) & kmask;     \
      _Pragma("unroll") for (int i = 0; i < 4; ++i) RA_[i] = *(const u32x4*)(gA + kn + (size_t)(64 * i) * lda);  \
      _Pragma("unroll") for (int i = 0; i < NB; ++i) RB_[i] = *(const u32x4*)(gB + kn + (size_t)(64 * i) * ldb); \
    }                                                                                           \
    _Pragma("unroll") for (int ks = 0; ks < 4; ++ks) {                                          \
      bf16x8 af[4], bf[NCB];                                                                    \
      _Pragma("unroll") for (int a = 0; a < 4; ++a) af[a] = *(const bf16x8*)(rA + (RS_) * STG + 32 * a * LDT + 16 * ks);   \
      _Pragma("unroll") for (int b = 0; b < NCB; ++b) bf[b] = *(const bf16x8*)(rB + (RS_) * STG + 32 * b * LDT + 16 * ks); \
      _Pragma("unroll") for (int a = 0; a < 4; ++a)                                             \
        _Pragma("unroll") for (int b = 0; b < NCB; ++b) acc[a][b] = MFMA32(af[a], bf[b], acc[a][b]);         \
    }                                                                                           \
    __syncthreads();                                                                            \
  }
  for (int k0 = 0; k0 < K; k0 += 2 * BK) {
    GEMM_STEP(ra1, rb1, 1, 0, ks0 * BK + k0 + 3 * BK)
    GEMM_STEP(ra0, rb0, 0, 1, ks0 * BK + k0 + 4 * BK)
  }
#undef GEMM_STEP
}

template <class Desc>
DI void transpose_stream(int j0, int jend, int jstride, const Desc& D, float* sm) {
  const int tid = tid_opaque();
  const int nn = tid & 63, kq = tid >> 6;
  const int kp = (tid & 31) * 2, nq = tid >> 5;
  float v[8];
  const float* src = nullptr; const float* scale = nullptr; u16* dst = nullptr; int sld = 0, dld = 0;
  int j = j0;
  if (j < jend) {
    D(j, src, sld, dst, dld, scale);
#pragma unroll
    for (int i = 0; i < 8; ++i) { const int kk = kq + 8 * i; v[i] = src[(size_t)kk * sld + nn] * (scale ? scale[kk] : 1.0f); }
  }
  while (j < jend) {
    u16* cdst = dst; const int cdld = dld;
    float w[8];
#pragma unroll
    for (int i = 0; i < 8; ++i) w[i] = v[i];
    const int jn = j + jstride;
    if (jn < jend) {
      D(jn, src, sld, dst, dld, scale);
#pragma unroll
      for (int i = 0; i < 8; ++i) { const int kk = kq + 8 * i; v[i] = src[(size_t)kk * sld + nn] * (scale ? scale[kk] : 1.0f); }
    }
#pragma unroll
    for (int i = 0; i < 8; ++i) sm[(kq + 8 * i) * 65 + nn] = w[i];
    __syncthreads();
#pragma unroll
    for (int i = 0; i < 4; ++i) {
      const int n2 = nq + 16 * i;
      *(unsigned*)(cdst + (size_t)n2 * cdld + kp) = pack2(sm[kp * 65 + n2], sm[(kp + 1) * 65 + n2]);
    }
    __syncthreads();
    j = jn;
  }
}

DI uint4 cvt8(const float* __restrict__ s) {
  const float4 a = *(const float4*)s, b = *(const float4*)(s + 4);
  uint4 o;
  o.x = pack2(a.x, a.y); o.y = pack2(a.z, a.w); o.z = pack2(b.x, b.y); o.w = pack2(b.z, b.w);
  return o;
}

DI void cache_convert(const Params& p, int layer, int bid, int nb, float* sm) {
  const int tid = tid_opaque();
  unsigned char* ws = p.ws;
  auto D = [&](int j, const float*& src, int& sld, u16*& dst, int& dld, const float*& scale) {
    scale = nullptr; sld = 512;
    if (j < 1024) {
      const int lbh = layer * 128 + (j >> 3), kt = j & 7;
      const int lb = lbh >> 3, hd = lbh & 7;
      src = p.cav + ((size_t)lb * 512 + kt * 64) * 512 + hd * 64;
      dst = (u16*)(ws + OFF_VAST) + (size_t)lbh * 64 * 544 + kt * 64; dld = 544;
    } else {
      const int jj = j - 1024;
      const int lbh = layer * 128 + (jj >> 4), kt = jj & 15;
      const int lb = lbh >> 3, hd = lbh & 7;
      src = p.cbv + ((size_t)lb * 1024 + kt * 64) * 512 + hd * 64;
      dst = (u16*)(ws + OFF_VBST) + (size_t)lbh * 64 * 1056 + kt * 64; dld = 1056;
    }
  };
  transpose_stream(bid, 3072, nb, D, sm);
  const size_t gtid = (size_t)bid * NTHR + tid, gn = (size_t)nb * NTHR;
  for (size_t e0 = gtid; e0 < (size_t)524288; e0 += gn) {
    const size_t e = e0 + (size_t)layer * 524288;
    const int d8 = e & 7, hd = (e >> 3) & 7, s = (e >> 6) & 511, lb = (int)(e >> 15);
    *(uint4*)((u16*)(ws + OFF_KAS) + (((size_t)lb * 8 + hd) * 544 + s) * 64 + d8 * 8) = cvt8(p.cak + e * 8);
  }
  for (size_t e0 = gtid; e0 < (size_t)1048576; e0 += gn) {
    const size_t e = e0 + (size_t)layer * 1048576;
    const int d8 = e & 7, hd = (e >> 3) & 7, s = (e >> 6) & 1023, lb = (int)(e >> 16);
    *(uint4*)((u16*)(ws + OFF_KBS) + (((size_t)lb * 8 + hd) * 1056 + s) * 64 + d8 * 8) = cvt8(p.cbk + e * 8);
  }
}

DI void phase0(const Params& p, float* sm) {
  const int tid = tid_opaque();
  unsigned char* ws = p.ws;
  if (blockIdx.x == 0 && tid < 4) ((int*)(ws + OFF_CTR))[tid] = 0;
  auto D = [&](int j, const float*& src, int& sld, u16*& dst, int& dld, const float*& scale) {
    scale = nullptr;
    if (j < 2048) {
      const int l = j >> 10, kt = (j >> 6) & 15, nt = j & 63;
      src = p.win + ((size_t)l * 1024 + kt * 64) * 4096 + nt * 64; sld = 4096;
      dst = (u16*)(ws + OFF_WIN) + ((size_t)l * 4096 + nt * 64) * 1024 + kt * 64; dld = 1024;
      scale = p.gpre + l * 1024 + kt * 64;
    } else if (j < 3072) {
      const int jj = (j - 2048) & 511;
      const bool gate = j >= 2560;
      const int l = jj >> 8, kt = (jj >> 4) & 15, nt = jj & 15;
      src = (gate ? p.wgate : p.wout) + ((size_t)l * 1024 + kt * 64) * 1024 + nt * 64; sld = 1024;
      dst = (u16*)(ws + (gate ? OFF_WGATE : OFF_WOUT)) + ((size_t)l * 1024 + nt * 64) * 1024 + kt * 64; dld = 1024;
    } else {
      const int jj = j - 3072;
      const int l = jj >> 6, kt = (jj >> 4) & 3, nt = jj & 15;
      src = p.wple + ((size_t)l * 256 + kt * 64) * 1024 + nt * 64; sld = 1024;
      dst = (u16*)(ws + OFF_WPLE) + ((size_t)l * 1024 + nt * 64) * 256 + kt * 64; dld = 256;
    }
  };
  transpose_stream((int)blockIdx.x, 3200, (int)gridDim.x, D, sm);
  const size_t gtid = (size_t)blockIdx.x * NTHR + tid, gn = (size_t)gridDim.x * NTHR;
  for (size_t e = gtid; e < (size_t)2 * MT * 32; e += gn) {
    const int c8 = e & 31;
    const size_t lr = e >> 5;
    const int l = (int)(lr / MT), row = (int)(lr % MT);
    const float* src = row < MP ? p.pp + ((size_t)l * MP + row) * 256 : p.ps + ((size_t)l * MS + (row - MP)) * 256;
    *(uint4*)((u16*)(ws + OFF_PB) + lr * 256 + c8 * 8) = cvt8(src + c8 * 8);
  }
  const int lane = tid & 63;
  const int gw = (int)(gtid >> 6), nw = (int)(gn >> 6);
  for (int row = gw; row < MT; row += nw) {
    const float* src = row < MP ? p.xp + (size_t)row * 1024 : p.xs + (size_t)(row - MP) * 1024;
    u16* dst = (u16*)(ws + OFF_R0) + (size_t)row * 1024;
    float ss = 0.f;
#pragma unroll
    for (int j = 0; j < 2; ++j) {
      const int c = 8 * lane + 512 * j;
      const float4 a = *(const float4*)(src + c), b = *(const float4*)(src + c + 4);
      ss += a.x * a.x + a.y * a.y + a.z * a.z + a.w * a.w + b.x * b.x + b.y * b.y + b.z * b.z + b.w * b.w;
      uint4 o;
      o.x = pack2(a.x, a.y); o.y = pack2(a.z, a.w); o.z = pack2(b.x, b.y); o.w = pack2(b.z, b.w);
      *(uint4*)(dst + c) = o;
    }
#pragma unroll
    for (int m = 32; m >= 1; m >>= 1) ss += __shfl_xor(ss, m);
    if (lane == 0) ((float*)(ws + OFF_RSTD))[row] = rsqrtf(ss * (1.0f / 1024.0f) + EPS);
  }
}

DI float sigm(float x) { return __builtin_amdgcn_rcpf(1.0f + __builtin_amdgcn_exp2f(-1.4426950408889634f * x)); }

namespace pg8 {
#define PG8_LAS __attribute__((address_space(3)))
constexpr int BM = 256, BK = 64, HALF = 128, HTB = HALF * BK * 2, STAGE_BYTES = 8 * HTB, NXCD = 8, WGM = 8;
DI int lds_byte(int r, int c) { const int st = (r >> 4) * 2 + (c >> 5), rr = r & 15, cc = c & 31, ob = rr * 64 + cc * 2; return st * 1024 + (ob ^ (((ob >> 9) & 1) << 5)); }
DI void stage_rc(int b, int& R, int& C) { const int st = b / 1024, sb = b % 1024, swz = sb ^ (((sb >> 9) & 1) << 5); R = (st >> 1) * 16 + swz / 64; C = (st & 1) * 32 + (swz % 64) / 2; }
DI int perm32(int rho) { const int n = rho >> 4, i = rho & 15; return 8 * (i >> 2) + 4 * n + (i & 3); }
struct Unit { int pm, pn; };
struct Gemm { const u16* A; const u16* Bt; int M, N, K; };
struct StaticOrder {
  int nM, nN, nwg, G, c;
  DI void init(int M, int N, int G_, int c_) { nM = M / BM; nN = N / BM; nwg = nM * nN; G = G_; c = c_; }
  DI bool next(int i, Unit& u) const {
    const long L = (long)i * G + c; if (L >= nwg) return false;
    int wgid = (int)L; { const int q = nwg / NXCD, r = nwg % NXCD, xcd = wgid % NXCD, off = wgid / NXCD; wgid = (xcd < r ? xcd * (q + 1) : r * (q + 1) + (xcd - r) * q) + off; }
    const int nig = WGM * nN, gid = wgid / nig, fm = gid * WGM, gsz = (nM - fm) < WGM ? (nM - fm) : WGM;
    u.pm = fm + ((wgid % nig) % gsz); u.pn = (wgid % nig) / gsz; return true;
  }
};
template <class Epi>
DI void gemm_phase(PG8_LAS unsigned char* lds, const Gemm g, const StaticOrder& S, const Epi& E) {
  const int tid = threadIdx.x, wid = __builtin_amdgcn_readfirstlane(tid >> 6), lane = tid & 63, wr = wid >> 2, wc = wid & 3, fr = lane & 15, fq = lane >> 4;
  const int K = g.K, nt = K / BK;
  unsigned voffA[2], voffB[2];
#pragma unroll
  for (int i = 0; i < 2; ++i) { int R, C; stage_rc(tid * 16 + i * 8192, R, C); const int Rb = (R & ~31) + perm32(R & 31);
    voffA[i] = (unsigned)(R * K + C) * 2u; voffB[i] = (unsigned)(Rb * K + C) * 2u; }
  const size_t kstep = (size_t)(BK * 2);
  const size_t hstep = (size_t)HALF * K * 2;
  const size_t tstep = 2 * hstep;
  const unsigned ldsw = (unsigned)wid * 1024u;
  const int aoff = lds_byte(wr * 64 + fr, fq * 8), boff = lds_byte(wc * 32 + fr, fq * 8);
#define PG8_SA(b, h) (((b) * 2 + (h)) * HTB)
#define PG8_SB(b, h) ((4 + (b) * 2 + (h)) * HTB)
#define PG8_STAGE(bufoff, gbase, voff) do { _Pragma("unroll") for (int _i = 0; _i < 2; ++_i) \
    __builtin_amdgcn_global_load_lds((const unsigned*)((const char*)(gbase) + (voff)[_i]), (PG8_LAS unsigned*)(lds + (bufoff) + ldsw + _i * 8192), 16, 0, 0); } while (0)
#define PG8_LDA(dst, b, h) do { _Pragma("unroll") for (int m = 0; m < 4; ++m) _Pragma("unroll") for (int k = 0; k < 2; ++k) dst[m][k] = *(const PG8_LAS bf16x8*)(lds + PG8_SA(b, h) + aoff + m * 2048 + k * 1024); } while (0)
#define PG8_LDB(dst, b, h) do { _Pragma("unroll") for (int n = 0; n < 2; ++n) _Pragma("unroll") for (int k = 0; k < 2; ++k) dst[n][k] = *(const PG8_LAS bf16x8*)(lds + PG8_SB(b, h) + boff + n * 2048 + k * 1024); } while (0)
#define PG8_MMA(ai, bj, At, Bt) do { __builtin_amdgcn_s_setprio(1); _Pragma("unroll") for (int m = 0; m < 4; ++m) _Pragma("unroll") for (int n = 0; n < 2; ++n) _Pragma("unroll") for (int k = 0; k < 2; ++k) \
    acc[ai][bj][m][n] = __builtin_amdgcn_mfma_f32_16x16x32_bf16(Bt[n][k], At[m][k], acc[ai][bj][m][n], 0, 0, 0); __builtin_amdgcn_s_setprio(0); } while (0)
#define PG8_WAIT_V(n) asm volatile("s_waitcnt vmcnt(" #n ")" ::: "memory")
#define PG8_WAIT_L(n) asm volatile("s_waitcnt lgkmcnt(" #n ")" ::: "memory")
#define PG8_BAR __builtin_amdgcn_s_barrier()
#define PG8_SCHED __builtin_amdgcn_sched_barrier(0)
  Unit cur, nxt; int ui = 0;
  if (!S.next(0, cur)) return;
  f32x4 acc[2][2][4][2];
#pragma unroll
  for (int a = 0; a < 2; ++a)
#pragma unroll
    for (int b = 0; b < 2; ++b)
#pragma unroll
      for (int m = 0; m < 4; ++m)
#pragma unroll
        for (int n = 0; n < 2; ++n) acc[a][b][m][n] = (f32x4){0.f, 0.f, 0.f, 0.f};
  bf16x8 At[4][2], B0[2][2], B1[2][2];
  const char* cA = (const char*)g.A + (size_t)cur.pm * tstep; const char* cB = (const char*)g.Bt + (size_t)cur.pn * tstep;
  PG8_STAGE(PG8_SB(0, 0), cB, voffB); PG8_STAGE(PG8_SA(0, 0), cA, voffA); PG8_STAGE(PG8_SB(0, 1), cB + hstep, voffB); PG8_STAGE(PG8_SA(0, 1), cA + hstep, voffA);
  if (wr == 1) PG8_BAR;
  PG8_WAIT_V(4); PG8_BAR;
  PG8_STAGE(PG8_SB(1, 0), cB + kstep, voffB); PG8_STAGE(PG8_SA(1, 0), cA + kstep, voffA); PG8_STAGE(PG8_SB(1, 1), cB + hstep + kstep, voffB);
  PG8_WAIT_V(6); PG8_BAR;
  for (;;) {
    const bool has_next = S.next(ui + 1, nxt);
    const char* nA = has_next ? (const char*)g.A + (size_t)nxt.pm * tstep : cA; const char* nB = has_next ? (const char*)g.Bt + (size_t)nxt.pn * tstep : cB;
    for (int t = 0; t < nt; t += 2) {
      const bool last = (t == nt - 2);
      const char* a1 = cA + (size_t)(t + 1) * kstep;
      const char* a2 = last ? nA : cA + (size_t)(t + 2) * kstep; const char* b2 = last ? nB : cB + (size_t)(t + 2) * kstep;
      const char* a3 = a2 + kstep; const char* b3 = b2 + kstep;
      PG8_LDB(B0, 0, 0); PG8_SCHED; PG8_LDA(At, 0, 0); PG8_STAGE(PG8_SA(1, 1), a1 + hstep, voffA);
      PG8_WAIT_L(8); PG8_BAR; PG8_WAIT_L(0); PG8_MMA(0, 0, At, B0); PG8_BAR; PG8_SCHED;
      PG8_LDB(B1, 0, 1); PG8_STAGE(PG8_SB(0, 0), b2, voffB);
      PG8_BAR; PG8_WAIT_L(0); PG8_MMA(0, 1, At, B1); PG8_BAR;
      PG8_LDA(At, 0, 1); PG8_STAGE(PG8_SA(0, 0), a2, voffA);
      PG8_BAR; PG8_WAIT_L(0); PG8_MMA(1, 0, At, B0); PG8_BAR; PG8_SCHED;
      PG8_STAGE(PG8_SB(0, 1), b2 + hstep, voffB);
      PG8_WAIT_V(6); PG8_BAR; PG8_MMA(1, 1, At, B1); PG8_BAR;
      PG8_LDB(B0, 1, 0); PG8_SCHED; PG8_LDA(At, 1, 0); PG8_STAGE(PG8_SA(0, 1), a2 + hstep, voffA);
      PG8_WAIT_L(8); PG8_BAR; PG8_WAIT_L(0); PG8_MMA(0, 0, At, B0); PG8_BAR; PG8_SCHED;
      PG8_LDB(B1, 1, 1); PG8_STAGE(PG8_SB(1, 0), b3, voffB);
      PG8_BAR; PG8_WAIT_L(0); PG8_MMA(0, 1, At, B1); PG8_BAR;
      PG8_LDA(At, 1, 1); PG8_STAGE(PG8_SA(1, 0), a3, voffA);
      PG8_BAR; PG8_WAIT_L(0); PG8_MMA(1, 0, At, B0); PG8_BAR; PG8_SCHED;
      PG8_STAGE(PG8_SB(1, 1), b3 + hstep, voffB);
      PG8_WAIT_V(6); PG8_BAR; PG8_MMA(1, 1, At, B1); PG8_BAR;
    }
    E(acc, cur);
#if PROBE_DUP == 9
    E(acc, cur);
#endif
    if (!has_next) break;
#pragma unroll
    for (int a = 0; a < 2; ++a)
#pragma unroll
      for (int b = 0; b < 2; ++b)
#pragma unroll
        for (int m = 0; m < 4; ++m)
#pragma unroll
          for (int n = 0; n < 2; ++n) acc[a][b][m][n] = (f32x4){0.f, 0.f, 0.f, 0.f};
    cur = nxt; cA = nA; cB = nB; ++ui;
  }
  PG8_WAIT_V(0);
  if (wr == 0) PG8_BAR;
  PG8_BAR;
#undef PG8_SA
#undef PG8_SB
#undef PG8_STAGE
#undef PG8_LDA
#undef PG8_LDB
#undef PG8_MMA
#undef PG8_WAIT_V
#undef PG8_WAIT_L
#undef PG8_BAR
#undef PG8_SCHED
}
}

struct EpiP1 {
  const Params* pp; int layer; u16* Gbuf;
  DI void operator()(const f32x4 (&acc)[2][2][4][2], const pg8::Unit& u) const {
    const Params& p = *pp;
    const int tl = tid_opaque();
    const int lane = tl & 63, wid = tl >> 6, wr = wid >> 2, wc = wid & 3, fr = lane & 15, fq = lane >> 4;
    unsigned char* ws = p.ws;
    const float* rstd = (const float*)(ws + OFF_RSTD);
    const int seg = u.pn >> 1, kind = seg & 3, grp = seg >> 2;
    const bool prompt = u.pm < 128;
    const int d0 = (wc & 1) * 32 + 8 * fq;
#pragma unroll
    for (int am = 0; am < 8; ++am) {
      const int ai = am >> 2, m = am & 3;
      const int row = 256 * u.pm + 128 * ai + 64 * wr + 16 * m + fr;
      const float rs = rstd[row];
      int b, s;
      if (prompt) { b = row >> 11; s = row & 2047; } else { b = (row - MP) >> 5; s = (row - MP) & 31; }
      const int lb = layer * 16 + b;
#pragma unroll
      for (int bj = 0; bj < 2; ++bj) {
        const int hd = (u.pn & 1) * 4 + bj * 2 + (wc >> 1);
        const f32x4 v0 = acc[ai][bj][m][0] * rs, v1 = acc[ai][bj][m][1] * rs;
        if (kind == 3) {
          u32x4 o;
          o[0] = pack2(v0[0] * sigm(v0[0]), v0[1] * sigm(v0[1]));
          o[1] = pack2(v0[2] * sigm(v0[2]), v0[3] * sigm(v0[3]));
          o[2] = pack2(v1[0] * sigm(v1[0]), v1[1] * sigm(v1[1]));
          o[3] = pack2(v1[2] * sigm(v1[2]), v1[3] * sigm(v1[3]));
          st_nt16u(Gbuf + (size_t)row * 1024 + grp * 512 + hd * 64 + d0, o);
        } else if (kind == 0) {
          u32x4 o;
          o[0] = pack2(v0[0] * QSCALE, v0[1] * QSCALE); o[1] = pack2(v0[2] * QSCALE, v0[3] * QSCALE);
          o[2] = pack2(v1[0] * QSCALE, v1[1] * QSCALE); o[3] = pack2(v1[2] * QSCALE, v1[3] * QSCALE);
          u16* dst = prompt ? (u16*)(ws + (grp ? OFF_QB : OFF_QA)) + (((size_t)b * 8 + hd) * 2048 + s) * 64 + d0
                            : (u16*)(ws + (grp ? OFF_QBS : OFF_QAS)) + (((size_t)b * 8 + hd) * 32 + s) * 64 + d0;
          st_nt16u(dst, o);
        } else {
          float* fo = nullptr;
          if (!prompt) {
            if (grp == 0) fo = p.out + (kind == 1 ? O_AKS : O_AVS) + ((size_t)lb * 32 + s) * 512 + hd * 64 + d0;
            else fo = p.out + (kind == 1 ? O_BKS : O_BVS) + ((size_t)lb * 32 + s) * 512 + hd * 64 + d0;
          }
          if (fo) { __builtin_nontemporal_store(v0, (f32x4*)fo); __builtin_nontemporal_store(v1, (f32x4*)(fo + 4)); }
          u32x4 o;
          o[0] = pack2(v0[0], v0[1]); o[1] = pack2(v0[2], v0[3]); o[2] = pack2(v1[0], v1[1]); o[3] = pack2(v1[2], v1[3]);
          if (prompt) {
            const size_t off = kind == 1 ? (grp ? OFF_KB : OFF_KA) : (grp ? OFF_VBT : OFF_VAT);
            st_nt16u((u16*)(ws + off) + (((size_t)b * 8 + hd) * 2048 + s) * 64 + d0, o);
          } else if (kind == 1) {
            u16* dst = grp == 0 ? (u16*)(ws + OFF_KAS) + (((size_t)lb * 8 + hd) * 544 + 512 + s) * 64 + d0
                                : (u16*)(ws + OFF_KBS) + (((size_t)lb * 8 + hd) * 1056 + 1024 + s) * 64 + d0;
            st_nt16u(dst, o);
          } else {
            u16* vb; int ldv;
            if (grp == 0) { vb = (u16*)(ws + OFF_VAST) + (((size_t)lb * 8 + hd) * 64) * 544 + 512 + s; ldv = 544; }
            else { vb = (u16*)(ws + OFF_VBST) + (((size_t)lb * 8 + hd) * 64) * 1056 + 1024 + s; ldv = 1056; }
#pragma unroll
            for (int j = 0; j < 4; ++j) {
              vb[(size_t)(d0 + 2 * j) * ldv] = (u16)(o[j] & 0xffffu);
              vb[(size_t)(d0 + 2 * j + 1) * ldv] = (u16)(o[j] >> 16);
            }
          }
        }
      }
    }
  }
};

struct EpiP3 {
  u16* Y;
  DI void operator()(const f32x4 (&acc)[2][2][4][2], const pg8::Unit& u) const {
    const int tl = tid_opaque();
    const int lane = tl & 63, wid = tl >> 6, wr = wid >> 2, wc = wid & 3, fr = lane & 15, fq = lane >> 4;
#pragma unroll
    for (int ai = 0; ai < 2; ++ai)
#pragma unroll
      for (int m = 0; m < 4; ++m) {
        const int row = 256 * u.pm + 128 * ai + 64 * wr + 16 * m + fr;
#pragma unroll
        for (int bj = 0; bj < 2; ++bj) {
          const f32x4 v0 = acc[ai][bj][m][0], v1 = acc[ai][bj][m][1];
          u32x4 o;
          o[0] = pack2(v0[0], v0[1]); o[1] = pack2(v0[2], v0[3]); o[2] = pack2(v1[0], v1[1]); o[3] = pack2(v1[2], v1[3]);
          *(u32x4*)(Y + (size_t)row * 1024 + 256 * u.pn + 128 * bj + 32 * wc + 8 * fq) = o;
        }
      }
  }
};

struct EpiP5 {
  float* out; const u16* PLE; const u16* H1B; u16* HBN; float* psum; int layer;
  DI void operator()(const f32x4 (&acc)[2][2][4][2], const pg8::Unit& u) const {
    const int tl = tid_opaque();
    const int lane = tl & 63, wid = tl >> 6, wr = wid >> 2, wc = wid & 3, fr = lane & 15, fq = lane >> 4;
#pragma unroll
    for (int ai = 0; ai < 2; ++ai)
#pragma unroll
      for (int m = 0; m < 4; ++m) {
        const int row = 256 * u.pm + 128 * ai + 64 * wr + 16 * m + fr;
        float ss = 0.f;
#pragma unroll
        for (int bj = 0; bj < 2; ++bj) {
          const size_t idx = (size_t)row * 1024 + 256 * u.pn + 128 * bj + 32 * wc + 8 * fq;
          const u32x4 hw = *(const u32x4*)(H1B + idx);
          f32x4 h0, h1;
          h0[0] = bflo(hw[0]); h0[1] = bfhi(hw[0]); h0[2] = bflo(hw[1]); h0[3] = bfhi(hw[1]);
          h1[0] = bflo(hw[2]); h1[1] = bfhi(hw[2]); h1[2] = bflo(hw[3]); h1[3] = bfhi(hw[3]);
          const u32x4 pw = *(const u32x4*)(PLE + idx);
          const f32x4 a0 = acc[ai][bj][m][0], a1 = acc[ai][bj][m][1];
          f32x4 r0, r1;
          r0[0] = h0[0] + bflo(pw[0]) * sigm(a0[0]); r0[1] = h0[1] + bfhi(pw[0]) * sigm(a0[1]);
          r0[2] = h0[2] + bflo(pw[1]) * sigm(a0[2]); r0[3] = h0[3] + bfhi(pw[1]) * sigm(a0[3]);
          r1[0] = h1[0] + bflo(pw[2]) * sigm(a1[0]); r1[1] = h1[1] + bfhi(pw[2]) * sigm(a1[1]);
          r1[2] = h1[2] + bflo(pw[3]) * sigm(a1[2]); r1[3] = h1[3] + bfhi(pw[3]) * sigm(a1[3]);
          *(f32x4*)(out + idx) = r0; *(f32x4*)(out + idx + 4) = r1;
          if (layer == 0) {
            u32x4 o;
            o[0] = pack2(r0[0], r0[1]); o[1] = pack2(r0[2], r0[3]); o[2] = pack2(r1[0], r1[1]); o[3] = pack2(r1[2], r1[3]);
            *(u32x4*)(HBN + idx) = o;
            ss += r0[0] * r0[0] + r0[1] * r0[1] + r0[2] * r0[2] + r0[3] * r0[3] + r1[0] * r1[0] + r1[1] * r1[1] + r1[2] * r1[2] + r1[3] * r1[3];
          }
        }
        if (layer == 0) {
          ss += __shfl_xor(ss, 16); ss += __shfl_xor(ss, 32);
          if (fq == 0) psum[(size_t)row * 32 + u.pn * 4 + wc] = ss;
        }
      }
  }
};

constexpr float LOG2E = 1.4426950408889634f;
constexpr float SB_EXIT = -160.0f;
DI float fmax_fin(float a, float b) { return __builtin_amdgcn_fmed3f(a, b, 3.0e38f); }
DI float ex2(float x) { return __builtin_amdgcn_exp2f(x); }
DI float lg2(float x) { return __builtin_amdgcn_logf(x); }

DI void attn_store(const f32x16& o0, const f32x16& o1, float scale, const u16* Gp, u16* Mp, int r, int h) {
#pragma unroll
  for (int db = 0; db < 2; ++db)
#pragma unroll
    for (int g = 0; g < 4; ++g) {
      const int d0 = 32 * db + 8 * g + 4 * h;
      const uint2 gv = *(const uint2*)(Gp + (size_t)r * 1024 + d0);
      const float x0 = (db ? o1[4 * g] : o0[4 * g]) * scale * bflo(gv.x);
      const float x1 = (db ? o1[4 * g + 1] : o0[4 * g + 1]) * scale * bfhi(gv.x);
      const float x2 = (db ? o1[4 * g + 2] : o0[4 * g + 2]) * scale * bflo(gv.y);
      const float x3 = (db ? o1[4 * g + 3] : o0[4 * g + 3]) * scale * bfhi(gv.y);
      uint2 o; o.x = pack2(x0, x1); o.y = pack2(x2, x3);
      *(uint2*)(Mp + (size_t)r * 1024 + d0) = o;
    }
}

DI bf16x8 ldv8(const u16* vp) {
  const bf16x4 lo = *(const bf16x4*)vp;
  const bf16x4 hi = *(const bf16x4*)(vp + 8);
  return __builtin_shufflevector(lo, hi, 0, 1, 2, 3, 4, 5, 6, 7);
}

DI bf16x8 pack8(const float* v) {
  u32x4 u;
  u[0] = pack2(v[0], v[1]); u[1] = pack2(v[2], v[3]); u[2] = pack2(v[4], v[5]); u[3] = pack2(v[6], v[7]);
  return __builtin_bit_cast(bf16x8, u);
}

DI void make_tf(bf16x8 (&tf)[2], int r, int h) {
#pragma unroll
  for (int s = 0; s < 2; ++s)
#pragma unroll
    for (int j = 0; j < 8; ++j) tf[s][j] = (16 * s + 8 * (j >> 2) + 4 * h + (j & 3) > r) ? (short)0x3F80 : (short)0;
}

DI unsigned pack2v(f2_t v) { bf2_t r = __builtin_convertvector(v, bf2_t); return __builtin_bit_cast(unsigned, r); }
DI bf16x8 pack8v(const f2_t* v) {
  u32x4 u;
  u[0] = pack2v(v[0]); u[1] = pack2v(v[1]); u[2] = pack2v(v[2]); u[3] = pack2v(v[3]);
  return __builtin_bit_cast(bf16x8, u);
}
template <bool MASK>
DI void sb_step(const f32x16& st, const bf16x8 (&vf)[2][2], const bf16x8 (&tf)[2], int k0, int qpos, int h,
                f32x16& o0, f32x16& o1, float& carry) {
  f2_t l1m[8], lb[8];
  f2_t cs2 = {0.f, 0.f};
#pragma unroll
  for (int p = 0; p < 8; ++p) {
    const f2_t z = {st[2 * p], st[2 * p + 1]};
    const f2_t e = {ex2(-fabsf(z.x)), ex2(-fabsf(z.y))};
    const f2_t t = e + 1.0f;
    const f2_t lg = {lg2(t.x), lg2(t.y)};
    const f2_t mx = {__builtin_amdgcn_fmed3f(z.x, 0.f, 3.0e38f), __builtin_amdgcn_fmed3f(z.y, 0.f, 3.0e38f)};
    const f2_t sp = mx + lg;
    if (MASK) {
      const bool c0 = (k0 + crow(2 * p, h)) < qpos, c1 = (k0 + crow(2 * p + 1, h)) < qpos;
      l1m[p] = (f2_t){c0 ? -sp.x : 0.f, c1 ? -sp.y : 0.f};
      lb[p] = (f2_t){c0 ? (z.x - sp.x) : -1e30f, c1 ? (z.y - sp.y) : -1e30f};
    } else {
      l1m[p] = -sp;
      lb[p] = z - sp;
    }
    cs2 += l1m[p];
  }
  float csum = cs2.x + cs2.y;
  csum += __shfl_xor(csum, 32);
  f32x16 af;
#pragma unroll
  for (int i = 0; i < 16; ++i) af[i] = carry;
  af = MFMA32(tf[0], pack8v(l1m), af);
  af = MFMA32(tf[1], pack8v(l1m + 4), af);
  f2_t w[8];
#pragma unroll
  for (int p = 0; p < 8; ++p) {
    const f2_t a2 = {af[2 * p], af[2 * p + 1]};
    const f2_t t = lb[p] + a2;
    w[p] = (f2_t){ex2(t.x), ex2(t.y)};
  }
  carry += csum;
  const bf16x8 w0 = pack8v(w), w1 = pack8v(w + 4);
  o0 = MFMA32(vf[0][0], w0, o0);
  o0 = MFMA32(vf[0][1], w1, o0);
  o1 = MFMA32(vf[1][0], w0, o1);
  o1 = MFMA32(vf[1][1], w1, o1);
}

template <bool SCALE_BIAS, typename BiasPtr>
DI void band_step(const f32x16& st, const bf16x8 (&vf)[2][2], BiasPtr bias, float b0, int relmax, int relc, int h,
                  f32x16& o0, f32x16& o1, float& m, float& l) {
  float sv[16];
  if (relmax <= -128) {
#pragma unroll
    for (int i = 0; i < 16; ++i) sv[i] = st[i] + b0;
  } else {
#pragma unroll
    for (int i = 0; i < 16; ++i) {
      int rel = relc + crow(i, h);
      rel = min(max(rel, -128), 128) + 128;
      const float bv = bias[rel];
      sv[i] = st[i] + (SCALE_BIAS ? bv * LOG2E : bv);
    }
  }
  float mt = sv[0];
#pragma unroll
  for (int i = 1; i < 16; ++i) mt = fmaxf(mt, sv[i]);
  mt = fmaxf(mt, __shfl_xor(mt, 32));
  const float mnew = fmaxf(m, mt);
  const float alpha = ex2(m - mnew);
  m = mnew;
  float ps = 0.f;
#pragma unroll
  for (int i = 0; i < 16; ++i) { sv[i] = ex2(sv[i] - mnew); ps += sv[i]; }
  l = l * alpha + ps;
#pragma unroll
  for (int i = 0; i < 16; ++i) { o0[i] *= alpha; o1[i] *= alpha; }
  const bf16x8 w0 = pack8(sv), w1 = pack8(sv + 8);
  o0 = MFMA32(vf[0][0], w0, o0);
  o0 = MFMA32(vf[0][1], w1, o0);
  o1 = MFMA32(vf[1][0], w0, o1);
  o1 = MFMA32(vf[1][1], w1, o1);
}

DI void sb_item(const u16* __restrict__ Q, const u16* __restrict__ Kb, const u16* __restrict__ VT, int ldv,
                int qpos0, int ntiles, const u16* Gp, u16* Mp) {
  const int lane = tid_opaque() & 63, r = lane & 31, h = lane >> 5;
  bf16x8 qf[4];
#pragma unroll
  for (int ks = 0; ks < 4; ++ks) qf[ks] = *(const bf16x8*)(Q + r * 64 + 16 * ks + 8 * h);
  bf16x8 tf[2];
  make_tf(tf, r, h);
  f32x16 o0, o1;
#pragma unroll
  for (int i = 0; i < 16; ++i) { o0[i] = 0.f; o1[i] = 0.f; }
  float carry = 0.f;
  const int qpos = qpos0 + r;
  for (int kt = ntiles - 1; kt >= 0; --kt) {
    const int k0 = kt * 32;
    f32x16 st;
#pragma unroll
    for (int i = 0; i < 16; ++i) st[i] = 0.f;
    const u16* kp = Kb + (size_t)(k0 + r) * 64 + 8 * h;
#pragma unroll
    for (int ks = 0; ks < 4; ++ks) {
      const bf16x8 kf = *(const bf16x8*)(kp + 16 * ks);
      st = MFMA32(kf, qf[ks], st);
    }
    bf16x8 vf[2][2];
#pragma unroll
    for (int db = 0; db < 2; ++db)
#pragma unroll
      for (int s = 0; s < 2; ++s) vf[db][s] = ldv8(VT + (size_t)(32 * db + r) * ldv + k0 + 16 * s + 4 * h);
    if (k0 + 31 < qpos0) sb_step<false>(st, vf, tf, k0, qpos, h, o0, o1, carry);
    else sb_step<true>(st, vf, tf, k0, qpos, h, o0, o1, carry);
    if (__all(carry < SB_EXIT)) break;
  }
  attn_store(o0, o1, 1.0f, Gp, Mp, r, h);
}

DI void band_item(const u16* __restrict__ Q, const u16* __restrict__ Kb, const u16* __restrict__ VT, int ldv,
                  int kt_begin, int kt_end, int relbase, const float* __restrict__ bias, const u16* Gp, u16* Mp) {
  const int lane = tid_opaque() & 63, r = lane & 31, h = lane >> 5;
  bf16x8 qf[4];
#pragma unroll
  for (int ks = 0; ks < 4; ++ks) qf[ks] = *(const bf16x8*)(Q + r * 64 + 16 * ks + 8 * h);
  f32x16 o0, o1;
#pragma unroll
  for (int i = 0; i < 16; ++i) { o0[i] = 0.f; o1[i] = 0.f; }
  float m = -1e30f, l = 0.f;
  const float b0 = bias[0] * LOG2E;
  for (int kt = kt_begin; kt < kt_end; ++kt) {
    const int k0 = kt * 32;
    f32x16 st;
#pragma unroll
    for (int i = 0; i < 16; ++i) st[i] = 0.f;
    const u16* kp = Kb + (size_t)(k0 + r) * 64 + 8 * h;
#pragma unroll
    for (int ks = 0; ks < 4; ++ks) {
      const bf16x8 kf = *(const bf16x8*)(kp + 16 * ks);
      st = MFMA32(kf, qf[ks], st);
    }
    bf16x8 vf[2][2];
#pragma unroll
    for (int db = 0; db < 2; ++db)
#pragma unroll
      for (int s = 0; s < 2; ++s) vf[db][s] = ldv8(VT + (size_t)(32 * db + r) * ldv + k0 + 16 * s + 4 * h);
    band_step<true>(st, vf, bias, b0, k0 + 31 + relbase, k0 + relbase - r, h, o0, o1, m, l);
  }
  l += __shfl_xor(l, 32);
  attn_store(o0, o1, 1.0f / l, Gp, Mp, r, h);
}

constexpr int AT_KS = 72, AT_VS = 68;
constexpr int AT_STAGE = 64 * AT_KS + 64 * AT_VS;
constexpr int AT_BIAS_OFF = 2 * AT_STAGE * 2;

struct KvRegs { u32x4 k; u32x2 v0, v1; };
DI KvRegs kv_load(const u16* __restrict__ Kb, const u16* __restrict__ Vb, int ldv, int k0, int tid) {
  KvRegs g;
  const int row = tid >> 3, ch = tid & 7;
  g.k = *(const u32x4*)(Kb + (size_t)(k0 + row) * 64 + ch * 8);
  const int kp = tid >> 4, d4 = tid & 15;
  g.v0 = *(const u32x2*)(Vb + (size_t)(k0 + 2 * kp) * 64 + d4 * 4);
  g.v1 = *(const u32x2*)(Vb + (size_t)(k0 + 2 * kp + 1) * 64 + d4 * 4);
  return g;
}
DI void kv_store(u16* stage, const KvRegs& g, int tid) {
  const int row = tid >> 3, ch = tid & 7;
  *(u32x4*)(stage + row * AT_KS + ch * 8) = g.k;
  const int kp = tid >> 4, d4 = tid & 15;
  u16* vp = stage + 64 * AT_KS + (d4 * 4) * AT_VS + 2 * kp;
  *(unsigned*)(vp + 0 * AT_VS) = (g.v0[0] & 0xffffu) | (g.v1[0] << 16);
  *(unsigned*)(vp + 1 * AT_VS) = (g.v0[0] >> 16) | (g.v1[0] & 0xffff0000u);
  *(unsigned*)(vp + 2 * AT_VS) = (g.v0[1] & 0xffffu) | (g.v1[1] << 16);
  *(unsigned*)(vp + 3 * AT_VS) = (g.v0[1] >> 16) | (g.v1[1] & 0xffff0000u);
}
DI void kv_out(const KvRegs& g, float* fk, float* fv, int k0, int tid) {
  const int row = tid >> 3, ch = tid & 7;
  const size_t o = (size_t)(k0 + row) * 512 + ch * 8;
  f32x4 a, b;
  a[0] = bflo(g.k[0]); a[1] = bfhi(g.k[0]); a[2] = bflo(g.k[1]); a[3] = bfhi(g.k[1]);
  b[0] = bflo(g.k[2]); b[1] = bfhi(g.k[2]); b[2] = bflo(g.k[3]); b[3] = bfhi(g.k[3]);
  __builtin_nontemporal_store(a, (f32x4*)(fk + o)); __builtin_nontemporal_store(b, (f32x4*)(fk + o + 4));
  const int kp = tid >> 4, d4 = tid & 15;
  const size_t ov = (size_t)(k0 + 2 * kp) * 512 + d4 * 4;
  a[0] = bflo(g.v0[0]); a[1] = bfhi(g.v0[0]); a[2] = bflo(g.v0[1]); a[3] = bfhi(g.v0[1]);
  b[0] = bflo(g.v1[0]); b[1] = bfhi(g.v1[0]); b[2] = bflo(g.v1[1]); b[3] = bfhi(g.v1[1]);
  __builtin_nontemporal_store(a, (f32x4*)(fv + ov)); __builtin_nontemporal_store(b, (f32x4*)(fv + ov + 512));
}
DI void lds_frags(const u16* stage, int sub, const bf16x8 (&qf)[4], int r, int h, f32x16& st, bf16x8 (&vf)[2][2]) {
#pragma unroll
  for (int i = 0; i < 16; ++i) st[i] = 0.f;
  const u16* kp = stage + (32 * sub + r) * AT_KS + 8 * h;
#pragma unroll
  for (int ks = 0; ks < 4; ++ks) {
    const bf16x8 kf = *(const bf16x8*)(kp + 16 * ks);
    st = MFMA32(kf, qf[ks], st);
  }
#pragma unroll
  for (int db = 0; db < 2; ++db)
#pragma unroll
    for (int s = 0; s < 2; ++s) vf[db][s] = ldv8(stage + 64 * AT_KS + (32 * db + r) * AT_VS + 32 * sub + 16 * s + 4 * h);
}

DI void lds_frags2(const u16* stage, const bf16x8 (&qf)[4], int r, int h, f32x16& st0, f32x16& st1,
                   bf16x8 (&vf0)[2][2], bf16x8 (&vf1)[2][2]) {
#pragma unroll
  for (int i = 0; i < 16; ++i) { st0[i] = 0.f; st1[i] = 0.f; }
  const u16* kp = stage + r * AT_KS + 8 * h;
#pragma unroll
  for (int ks = 0; ks < 4; ++ks) {
    const bf16x8 k0f = *(const bf16x8*)(kp + 16 * ks);
    const bf16x8 k1f = *(const bf16x8*)(kp + 32 * AT_KS + 16 * ks);
    st0 = MFMA32(k0f, qf[ks], st0);
    st1 = MFMA32(k1f, qf[ks], st1);
  }
#pragma unroll
  for (int db = 0; db < 2; ++db)
#pragma unroll
    for (int s = 0; s < 2; ++s) {
      vf0[db][s] = ldv8(stage + 64 * AT_KS + (32 * db + r) * AT_VS + 16 * s + 4 * h);
      vf1[db][s] = ldv8(stage + 64 * AT_KS + (32 * db + r) * AT_VS + 32 + 16 * s + 4 * h);
    }
}
DI void band_step64(const f32x16& st0, const f32x16& st1, const bf16x8 (&vf0)[2][2], const bf16x8 (&vf1)[2][2],
                    const float* bias, float b0, int relmax, int relc, int h, f32x16& o0, f32x16& o1, float& m, float& l) {
  float sa[16], sb[16];
  if (relmax <= -128) {
#pragma unroll
    for (int i = 0; i < 16; ++i) sa[i] = st0[i] + b0;
  } else {
#pragma unroll
    for (int i = 0; i < 16; ++i) sa[i] = st0[i] + bias[min(max(relc + crow(i, h), -128), 128) + 128];
  }
  if (relmax + 32 <= -128) {
#pragma unroll
    for (int i = 0; i < 16; ++i) sb[i] = st1[i] + b0;
  } else {
#pragma unroll
    for (int i = 0; i < 16; ++i) sb[i] = st1[i] + bias[min(max(relc + 32 + crow(i, h), -128), 128) + 128];
  }
  float mt = fmax_fin(sa[0], sb[0]);
#pragma unroll
  for (int i = 1; i < 16; ++i) mt = fmax_fin(fmax_fin(mt, sa[i]), sb[i]);
  mt = fmax_fin(mt, __shfl_xor(mt, 32));
  const float mnew = fmax_fin(m, mt);
  const float alpha = ex2(m - mnew);
  m = mnew;
  float ps = 0.f;
#pragma unroll
  for (int i = 0; i < 16; ++i) { sa[i] = ex2(sa[i] - mnew); sb[i] = ex2(sb[i] - mnew); ps += sa[i] + sb[i]; }
  l = l * alpha + ps;
#pragma unroll
  for (int i = 0; i < 16; ++i) { o0[i] *= alpha; o1[i] *= alpha; }
  const bf16x8 a0 = pack8(sa), a1 = pack8(sa + 8), b0w = pack8(sb), b1w = pack8(sb + 8);
  o0 = MFMA32(vf0[0][0], a0, o0);
  o1 = MFMA32(vf0[1][0], a0, o1);
  o0 = MFMA32(vf0[0][1], a1, o0);
  o1 = MFMA32(vf0[1][1], a1, o1);
  o0 = MFMA32(vf1[0][0], b0w, o0);
  o1 = MFMA32(vf1[1][0], b0w, o1);
  o0 = MFMA32(vf1[0][1], b1w, o0);
  o1 = MFMA32(vf1[1][1], b1w, o1);
}

DI void sbp_unit(const u16* __restrict__ Qb, const u16* __restrict__ Kb, const u16* __restrict__ VT, int qblk,
                 const u16* Gp, u16* Mp, u16* sm, float* fk, float* fv) {
  const int tid = tid_opaque(), lane = tid & 63, wave = tid >> 6, r = lane & 31, h = lane >> 5;
  const int q0w = qblk * 256 + 32 * wave;
  bf16x8 qf[4];
#pragma unroll
  for (int ks = 0; ks < 4; ++ks) qf[ks] = *(const bf16x8*)(Qb + (size_t)(q0w + r) * 64 + 16 * ks + 8 * h);
  bf16x8 tf[2];
  make_tf(tf, r, h);
  f32x16 o0, o1;
#pragma unroll
  for (int i = 0; i < 16; ++i) { o0[i] = 0.f; o1[i] = 0.f; }
  float carry = 0.f;
  int done = 0;
  const int qpos = q0w + r;
  const int t_hi = qblk * 4 + 3;
  KvRegs gA, gB;
  {
    const KvRegs g = kv_load(Kb, VT, 2048, t_hi * 64, tid);
    gA = kv_load(Kb, VT, 2048, max(t_hi - 1, 0) * 64, tid);
    kv_store(sm, g, tid);
    kv_out(g, fk, fv, t_hi * 64, tid);
  }
  __syncthreads();
  int cur = 0;
  for (int t = t_hi;; --t) {
    gB = kv_load(Kb, VT, 2048, max(t - 2, 0) * 64, tid);
    const u16* stage = sm + cur * AT_STAGE;
    if (!done) {
#pragma unroll
      for (int sub = 1; sub >= 0; --sub) {
        const int k0 = t * 64 + sub * 32;
        if (k0 < q0w + 31) {
          f32x16 st; bf16x8 vf[2][2];
          lds_frags(stage, sub, qf, r, h, st, vf);
          if (k0 + 31 < q0w) sb_step<false>(st, vf, tf, k0, qpos, h, o0, o1, carry);
          else sb_step<true>(st, vf, tf, k0, qpos, h, o0, o1, carry);
        }
      }
      done = __all(carry < SB_EXIT) ? 1 : 0;
    }
    if (t == 0) break;
    kv_store(sm + (cur ^ 1) * AT_STAGE, gA, tid);
    if (t - 1 >= qblk * 4) kv_out(gA, fk, fv, (t - 1) * 64, tid);
    int* fl = (int*)((unsigned char*)sm + AT_BIAS_OFF + 1056) + (t & 1) * 8;
    if (lane == 0) fl[wave] = done;
    __syncthreads();
    {
      const int4 fa = *(const int4*)fl, fb = *(const int4*)(fl + 4);
      if ((fa.x & fa.y & fa.z & fa.w & fb.x & fb.y & fb.z & fb.w) != 0) break;
    }
    gA = gB;
    cur ^= 1;
  }
  attn_store(o0, o1, 1.0f, Gp + (size_t)(32 * wave) * 1024, Mp + (size_t)(32 * wave) * 1024, r, h);
}

DI void bp_unit(const u16* __restrict__ Qb, const u16* __restrict__ Kb, const u16* __restrict__ VT, int qblk,
                const float* __restrict__ bias_g, const u16* Gp, u16* Mp, u16* sm, float* fk, float* fv) {
  const int tid = tid_opaque(), lane = tid & 63, wave = tid >> 6, r = lane & 31, h = lane >> 5;
  const int q0w = qblk * 256 + 32 * wave;
  const int cw = qblk * 4 + (wave >> 1);
  float* sbias = (float*)((unsigned char*)sm + AT_BIAS_OFF);
  if (tid < 257) sbias[tid] = bias_g[tid] * LOG2E;
  bf16x8 qf[4];
#pragma unroll
  for (int ks = 0; ks < 4; ++ks) qf[ks] = *(const bf16x8*)(Qb + (size_t)(q0w + r) * 64 + 16 * ks + 8 * h);
  f32x16 o0, o1;
#pragma unroll
  for (int i = 0; i < 16; ++i) { o0[i] = 0.f; o1[i] = 0.f; }
  float m = -1e30f, l = 0.f;
  const int t_hi = qblk * 4 + 3, t_lo = max(0, qblk * 4 - 8);
  KvRegs gA, gB;
  {
    const KvRegs g = kv_load(Kb, VT, 2048, t_hi * 64, tid);
    gA = kv_load(Kb, VT, 2048, max(t_hi - 1, t_lo) * 64, tid);
    kv_store(sm, g, tid);
    if (qblk >= 6) kv_out(g, fk, fv, t_hi * 64 - 1536, tid);
  }
  __syncthreads();
  const float b0 = sbias[0];
  int cur = 0;
  for (int t = t_hi;; --t) {
    gB = kv_load(Kb, VT, 2048, max(t - 2, t_lo) * 64, tid);
    const u16* stage = sm + cur * AT_STAGE;
    if (t <= cw && t >= cw - 8) {
      const int k0 = t * 64;
      f32x16 st0, st1; bf16x8 vf0[2][2], vf1[2][2];
      lds_frags2(stage, qf, r, h, st0, st1, vf0, vf1);
      band_step64(st0, st1, vf0, vf1, sbias, b0, k0 + 31 - q0w, k0 - q0w - r, h, o0, o1, m, l);
    }
    if (t == t_lo) break;
    kv_store(sm + (cur ^ 1) * AT_STAGE, gA, tid);
    if (qblk >= 6 && t - 1 >= qblk * 4) kv_out(gA, fk, fv, (t - 1) * 64 - 1536, tid);
    __syncthreads();
    gA = gB;
    cur ^= 1;
  }
  l += __shfl_xor(l, 32);
  attn_store(o0, o1, 1.0f / l, Gp + (size_t)(32 * wave) * 1024, Mp + (size_t)(32 * wave) * 1024, r, h);
}

constexpr int N_UNITS = 32 + 1024 + 1024;

DI void phase2(const Params& p, int layer, const u16* Gbuf, u16* MIX, u16* sm, int cslot = 0) {
  unsigned char* ws = p.ws;
  int* ctr = (int*)(ws + OFF_CTR) + layer + cslot;
  int* s_unit = (int*)((unsigned char*)sm + AT_BIAS_OFF + 257 * 4 + 12);
  for (;;) {
    __syncthreads();
    if (threadIdx.x == 0) *s_unit = atomicAdd(ctr, 1);
    __syncthreads();
    const int u = *s_unit;
    if (u >= N_UNITS) break;
    if (u < 32) {
      const int wave = tid_opaque() >> 6;
      const int item = u * 8 + wave;
      if (item < 128) {
        const int bh = item, b = bh >> 3, hd = bh & 7;
        const size_t row0 = (size_t)MP + b * 32;
        sb_item((const u16*)(ws + OFF_QBS) + (size_t)bh * 32 * 64,
                (const u16*)(ws + OFF_KBS) + ((size_t)layer * 128 + bh) * 1056 * 64,
                (const u16*)(ws + OFF_VBST) + ((size_t)layer * 128 + bh) * 64 * 1056, 1056,
                1024, 33, Gbuf + row0 * 1024 + 512 + hd * 64, MIX + row0 * 1024 + 512 + hd * 64);
      } else {
        const int bh = item - 128, b = bh >> 3, hd = bh & 7;
        const size_t row0 = (size_t)MP + b * 32;
        band_item((const u16*)(ws + OFF_QAS) + (size_t)bh * 32 * 64,
                  (const u16*)(ws + OFF_KAS) + ((size_t)layer * 128 + bh) * 544 * 64,
                  (const u16*)(ws + OFF_VAST) + ((size_t)layer * 128 + bh) * 64 * 544, 544,
                  0, 17, -512, p.relb + (size_t)(layer * 8 + hd) * 257,
                  Gbuf + row0 * 1024 + hd * 64, MIX + row0 * 1024 + hd * 64);
      }
    } else if (u < 32 + 1024) {
      const int j = u - 32, bh = j >> 3, qblk = 7 - (j & 7), b = bh >> 3, hd = bh & 7;
      const size_t row0 = (size_t)b * 2048 + qblk * 256;
      sbp_unit((const u16*)(ws + OFF_QB) + (size_t)bh * 2048 * 64, (const u16*)(ws + OFF_KB) + (size_t)bh * 2048 * 64,
               (const u16*)(ws + OFF_VBT) + (size_t)bh * 64 * 2048, qblk,
               Gbuf + row0 * 1024 + 512 + hd * 64, MIX + row0 * 1024 + 512 + hd * 64, sm,
               p.out + O_BKP + ((size_t)(layer * 16 + b) * 2048) * 512 + hd * 64, p.out + O_BVP + ((size_t)(layer * 16 + b) * 2048) * 512 + hd * 64);
    } else {
      const int j = u - 32 - 1024, bh = j & 127, qblk = 7 - (j >> 7), b = bh >> 3, hd = bh & 7;
      const size_t row0 = (size_t)b * 2048 + qblk * 256;
      bp_unit((const u16*)(ws + OFF_QA) + (size_t)bh * 2048 * 64, (const u16*)(ws + OFF_KA) + (size_t)bh * 2048 * 64,
              (const u16*)(ws + OFF_VAT) + (size_t)bh * 64 * 2048, qblk, p.relb + (size_t)(layer * 8 + hd) * 257,
              Gbuf + row0 * 1024 + hd * 64, MIX + row0 * 1024 + hd * 64, sm,
              p.out + O_AKP + ((size_t)(layer * 16 + b) * 512) * 512 + hd * 64, p.out + O_AVP + ((size_t)(layer * 16 + b) * 512) * 512 + hd * 64);
    }
  }
}

DI void phase4(const Params& p, int layer, const u16* Y, u16* H1B) {
  const int tid = tid_opaque(), lane = tid & 63;
  const int gw = (blockIdx.x * NTHR + tid) >> 6, nw = (gridDim.x * NTHR) >> 6;
  const float* gp = p.gpost + layer * 1024;
  for (int row = gw; row < MT; row += nw) {
    const u16* yr = Y + (size_t)row * 1024;
    float yf[16];
    float ss = 0.f;
#pragma unroll
    for (int j = 0; j < 2; ++j) {
      const uint4 u = *(const uint4*)(yr + 8 * lane + 512 * j);
      yf[8 * j + 0] = bflo(u.x); yf[8 * j + 1] = bfhi(u.x); yf[8 * j + 2] = bflo(u.y); yf[8 * j + 3] = bfhi(u.y);
      yf[8 * j + 4] = bflo(u.z); yf[8 * j + 5] = bfhi(u.z); yf[8 * j + 6] = bflo(u.w); yf[8 * j + 7] = bfhi(u.w);
    }
#pragma unroll
    for (int i = 0; i < 16; ++i) ss += yf[i] * yf[i];
#pragma unroll
    for (int m = 32; m >= 1; m >>= 1) ss += __shfl_xor(ss, m);
    const float rs = rsqrtf(ss * (1.0f / 1024.0f) + EPS);
    const float* hs;
    if (layer == 0) hs = row < MP ? p.xp + (size_t)row * 1024 : p.xs + (size_t)(row - MP) * 1024;
    else hs = p.out + (size_t)row * 1024;
#pragma unroll
    for (int j = 0; j < 2; ++j) {
      const int c = 8 * lane + 512 * j;
      const float4 a = *(const float4*)(hs + c), b = *(const float4*)(hs + c + 4);
      const float4 ga = *(const float4*)(gp + c), gb = *(const float4*)(gp + c + 4);
      float4 oa, ob;
      oa.x = a.x + yf[8 * j + 0] * rs * ga.x; oa.y = a.y + yf[8 * j + 1] * rs * ga.y;
      oa.z = a.z + yf[8 * j + 2] * rs * ga.z; oa.w = a.w + yf[8 * j + 3] * rs * ga.w;
      ob.x = b.x + yf[8 * j + 4] * rs * gb.x; ob.y = b.y + yf[8 * j + 5] * rs * gb.y;
      ob.z = b.z + yf[8 * j + 6] * rs * gb.z; ob.w = b.w + yf[8 * j + 7] * rs * gb.w;
      uint4 o;
      o.x = pack2(oa.x, oa.y); o.y = pack2(oa.z, oa.w); o.z = pack2(ob.x, ob.y); o.w = pack2(ob.z, ob.w);
      *(uint4*)(H1B + (size_t)row * 1024 + c) = o;
    }
  }
}

DI void p5_tile(const Params& p, int layer, int mt, int nt, int ks0, u16* sA, u16* sB, const u16* H1B, u16* HBN) {
  const int m0 = mt * 256, n0 = nt * 128;
  unsigned char* ws = p.ws;
  f32x16 acc[4][1];
  gemm_mainloop<1>((const u16*)(ws + OFF_PB) + ((size_t)layer * MT + m0) * 256, 256,
                   (const u16*)(ws + OFF_WPLE) + ((size_t)layer * 1024 + n0) * 256, 256, 256, ks0, sA, sB, acc);
  unsigned pl[4][8];
#pragma unroll
  for (int rb = 0; rb < 4; ++rb)
#pragma unroll
    for (int j = 0; j < 8; ++j) pl[rb][j] = pack2(acc[rb][0][2 * j], acc[rb][0][2 * j + 1]);
  gemm_mainloop<1>(H1B + (size_t)m0 * 1024, 1024, (const u16*)(ws + OFF_WGATE) + ((size_t)layer * 1024 + n0) * 1024, 1024, 1024, ks0, sA, sB, acc);
  int tl = tid_opaque();
  const int lane = tl & 63, wave = tl >> 6, wm = wave >> 2, wn = wave & 3, r = lane & 31, h = lane >> 5;
  const int col = n0 + 32 * wn + r;
  __syncthreads();
  float* st = (float*)sA + wave * (32 * 36);
#pragma unroll 1
  for (int rb = 0; rb < 4; ++rb) {
    const int row0 = m0 + 128 * wm + 32 * rb;
#pragma unroll
    for (int i = 0; i < 16; ++i) {
      const int t = crow(i, h);
      float* hp = p.out + (size_t)(row0 + t) * 1024 + col;
      const float h1 = *hp;
      const unsigned plw = rb == 0 ? pl[0][i >> 1] : rb == 1 ? pl[1][i >> 1] : rb == 2 ? pl[2][i >> 1] : pl[3][i >> 1];
      const float pv = (i & 1) ? bfhi(plw) : bflo(plw);
      const float a = rb == 0 ? acc[0][0][i] : rb == 1 ? acc[1][0][i] : rb == 2 ? acc[2][0][i] : acc[3][0][i];
      const float g = 1.0f / (1.0f + __expf(-a));
      const float h2 = h1 + g * pv;
      *hp = h2;
      st[t * 36 + r] = h2;
    }
    if (layer == 0) {
#pragma unroll
      for (int j = 0; j < 4; ++j) {
        const int c = lane + 64 * j, t = c >> 3, c4 = (c & 7) * 4;
        const float4 x = *(const float4*)(st + t * 36 + c4);
        uint2 o; o.x = pack2(x.x, x.y); o.y = pack2(x.z, x.w);
        *(uint2*)(HBN + (size_t)(row0 + t) * 1024 + n0 + 32 * wn + c4) = o;
        float ss = x.x * x.x + x.y * x.y + x.z * x.z + x.w * x.w;
        ss += __shfl_xor(ss, 1); ss += __shfl_xor(ss, 2); ss += __shfl_xor(ss, 4);
        if ((c & 7) == 0) ((float*)(ws + OFF_PSUM))[(size_t)(row0 + t) * 32 + nt * 4 + wn] = ss;
      }
    }
  }
}

__global__ void __launch_bounds__(NTHR, 2) mega(Params p, int ph_begin, int ph_end) {
  extern __shared__ __attribute__((aligned(16))) unsigned char smem[];
  u16* sA = (u16*)smem;
  PG8_LAS unsigned char* lds3 = (PG8_LAS unsigned char*)smem;
  u16* sB = sA + 256 * LDT;
  float* rstd_s = (float*)(smem + 2 * (2 * 256 * LDT * 2));
  unsigned char* ws = p.ws;
  __shared__ uint4 xb_words;
  if (threadIdx.x == 0) xb_words = make_uint4(0u, 0u, 0u, 0u);
  __syncthreads();
  XcdBarrier xb = xcd_barrier_post((unsigned*)(ws + OFF_BAR), (volatile LAS unsigned*)&xb_words);
  if (ph_end < 0) cg::this_grid().sync();
  int xx = blockIdx.x & 7, xi = blockIdx.x >> 3;
  int ks0 = (xi & 7) + (xi >> 3);
#define PHASE_GATE(PH) if ((PH) >= ph_begin && (PH) < ph_end) { if ((PH) > ph_begin) xcd_barrier(xb);
  PHASE_GATE(0) phase0(p, (float*)smem); }
#if PROBE_DUP == 10
  phase0(p, (float*)smem);
#endif
#pragma unroll 1
  for (int layer = 0; layer < 2; ++layer) {
    asm volatile("" : "+s"(layer));
    u16* RA = (u16*)(ws + ((layer & 1) ? OFF_R1 : OFF_R0));
    u16* RB = (u16*)(ws + ((layer & 1) ? OFF_R0 : OFF_R1));
    const int pb = 1 + 5 * layer;
    if (layer > 0 && (pb + 0) >= ph_begin && (pb + 0) < ph_end) {
      xcd_barrier(xb);
      const float* ps = (const float*)(ws + OFF_PSUM);
      float* rg = (float*)(ws + OFF_RSTD);
      for (int row = blockIdx.x * NTHR + tid_opaque(); row < MT; row += gridDim.x * NTHR) {
        const float4* q4 = (const float4*)(ps + (size_t)row * 32);
        float sm = 0.f;
#pragma unroll
        for (int j = 0; j < 4; ++j) { const float4 v = q4[j]; sm += v.x + v.y + v.z + v.w; }
        rg[row] = rsqrtf(sm * (1.0f / 1024.0f) + EPS);
      }
    }
    PHASE_GATE(pb + 0)
      pg8::StaticOrder S; S.init(MT, 4096, (int)gridDim.x, (int)blockIdx.x);
      pg8::Gemm g; g.A = RA; g.Bt = (const u16*)(ws + OFF_WIN) + (size_t)layer * 4096 * 1024; g.M = MT; g.N = 4096; g.K = 1024;
      EpiP1 E; E.pp = &p; E.layer = layer; E.Gbuf = RB;
      pg8::gemm_phase(lds3, g, S, E);
      if (blockIdx.x >= 32) cache_convert(p, layer, (int)blockIdx.x - 32, (int)gridDim.x - 32, (float*)smem);
#if PROBE_DUP == 8
      xcd_barrier(xb);
      pg8::gemm_phase(lds3, g, S, E);
#endif
    }
    PHASE_GATE(pb + 1) phase2(p, layer, RB, RA, sA); }
#if PROBE_DUP == 2
    xcd_barrier(xb); phase2(p, layer, RB, RA, sA, 2);
#endif

    PHASE_GATE(pb + 2)
      pg8::StaticOrder S; S.init(MT, 1024, (int)gridDim.x, (int)blockIdx.x);
      pg8::Gemm g; g.A = RA; g.Bt = (const u16*)(ws + OFF_WOUT) + (size_t)layer * 1024 * 1024; g.M = MT; g.N = 1024; g.K = 1024;
      EpiP3 E; E.Y = RB;
      pg8::gemm_phase(lds3, g, S, E);
      pg8::Gemm g2; g2.A = (const u16*)(ws + OFF_PB) + (size_t)layer * MT * 256; g2.Bt = (const u16*)(ws + OFF_WPLE) + (size_t)layer * 1024 * 256;
      g2.M = MT; g2.N = 1024; g2.K = 256;
      EpiP3 E2; E2.Y = (u16*)(ws + OFF_QA);
      if (blockIdx.x >= 8) {
        pg8::StaticOrder S2; S2.init(MT, 1024, (int)gridDim.x - 8, (int)blockIdx.x - 8);
        pg8::gemm_phase(lds3, g2, S2, E2);
      }
    }
    PHASE_GATE(pb + 3) phase4(p, layer, RB, RA); }
#if PROBE_DUP == 5
    if (layer == 0) { xcd_barrier(xb); phase4(p, layer, RB, RA); xcd_barrier(xb); phase4(p, layer, RB, RA); }
#endif
    PHASE_GATE(pb + 4)
      pg8::StaticOrder S; S.init(MT, 1024, (int)gridDim.x, (int)blockIdx.x);
      pg8::Gemm g; g.A = RA; g.Bt = (const u16*)(ws + OFF_WGATE) + (size_t)layer * 1024 * 1024; g.M = MT; g.N = 1024; g.K = 1024;
      EpiP5 E; E.out = p.out; E.PLE = (const u16*)(ws + OFF_QA); E.H1B = RA; E.HBN = RB; E.psum = (float*)(ws + OFF_PSUM); E.layer = layer;
      pg8::gemm_phase(lds3, g, S, E);
    }
  }
}

extern "C" void kernel_launch(void* const* d_in, const int* in_sizes, int n_in, void* d_out, int out_size,
                              void* d_ws, size_t ws_size, hipStream_t stream) {
  Params p{};
  p.xp = (const float*)d_in[0]; p.xs = (const float*)d_in[1]; p.pp = (const float*)d_in[2]; p.ps = (const float*)d_in[3];
  p.cak = (const float*)d_in[4]; p.cav = (const float*)d_in[5]; p.cbk = (const float*)d_in[6]; p.cbv = (const float*)d_in[7];
  p.gpre = (const float*)d_in[8]; p.win = (const float*)d_in[9]; p.relb = (const float*)d_in[10]; p.wout = (const float*)d_in[11];
  p.gpost = (const float*)d_in[12]; p.wple = (const float*)d_in[13]; p.wgate = (const float*)d_in[14];
  p.out = (float*)d_out;
  p.ws = (unsigned char*)d_ws;
  static int grid_blocks = 0;
  if (!grid_blocks) {
    int dev = 0, cus = 0, per_cu = 0;
    (void)hipGetDevice(&dev);
    (void)hipDeviceGetAttribute(&cus, hipDeviceAttributeMultiprocessorCount, dev);
    if (hipFuncSetAttribute((const void*)mega, hipFuncAttributeMaxDynamicSharedMemorySize, SMEM_BYTES) != hipSuccess)
      fprintf(stderr, "hipFuncSetAttribute(MaxDynamicSharedMemorySize=%d) failed\n", SMEM_BYTES);
    (void)hipOccupancyMaxActiveBlocksPerMultiprocessor(&per_cu, mega, NTHR, SMEM_BYTES);
    if (per_cu < 1) per_cu = 1;
    if (per_cu > 1) per_cu = 1;
    grid_blocks = 256;
    if (cus * per_cu < 256) fprintf(stderr, "device too small for a 256-workgroup cooperative grid\n");
  }
#if MK_COOP
  hipMemsetAsync((unsigned char*)d_ws + OFF_BAR, 0, (size_t)XCD_BAR_WORDS * 4, stream);
  int pb = 0, pe = 11;
  void* args[] = {&p, &pb, &pe};
  hipError_t e = hipLaunchCooperativeKernel((void*)mega, dim3(grid_blocks), dim3(NTHR), args, SMEM_BYTES, stream);
  if (e != hipSuccess) fprintf(stderr, "cooperative launch failed: %s (grid %d)\n", hipGetErrorString(e), grid_blocks);
#else
  for (int ph = 0; ph < 11; ++ph) mega<<<dim3(grid_blocks), dim3(NTHR), SMEM_BYTES, stream>>>(p, ph, ph + 1);
#endif
}
```

```cpp
#include <hip/hip_runtime.h>
#include <hip/hip_cooperative_groups.h>
#include <stdint.h>
#include <stdio.h>
namespace cg = cooperative_groups;

#ifndef PROBE_DUP
#define PROBE_DUP 0
#endif
#ifndef SKEW_P1
#define SKEW_P1 0
#define SKEW_P3 0
#define SKEW_P5 0
#endif
#ifndef MK_COOP
#define MK_COOP 1
#endif

typedef __attribute__((ext_vector_type(8))) short bf16x8;
typedef __attribute__((ext_vector_type(4))) short bf16x4;
typedef __attribute__((ext_vector_type(16))) float f32x16;
typedef __attribute__((ext_vector_type(4))) float f32x4;
typedef __attribute__((ext_vector_type(2))) __bf16 bf2_t;
typedef __attribute__((ext_vector_type(2))) float f2_t;
typedef unsigned short u16;
typedef __attribute__((ext_vector_type(4))) unsigned u32x4;

#define DI __device__ __forceinline__
#define MFMA32(a, b, c) __builtin_amdgcn_mfma_f32_32x32x16_bf16((a), (b), (c), 0, 0, 0)

DI unsigned pack2(float a, float b) { f2_t v = {a, b}; bf2_t r = __builtin_convertvector(v, bf2_t); return __builtin_bit_cast(unsigned, r); }
DI u16 f2bf(float a) { return (u16)(pack2(a, 0.f) & 0xffffu); }
DI float bflo(unsigned u) { return __uint_as_float(u << 16); }
DI float bfhi(unsigned u) { return __uint_as_float(u & 0xffff0000u); }
DI int crow(int i, int h) { return (i & 3) + 8 * (i >> 2) + 4 * h; }
typedef __attribute__((ext_vector_type(2))) unsigned u32x2;
typedef __attribute__((ext_vector_type(4))) float f32x4v;
DI void st_nt8(void* p, unsigned a, unsigned b) { u32x2 v = {a, b}; __builtin_nontemporal_store(v, (u32x2*)p); }
DI void st_nt16f(float* p, float4 x) { f32x4v v = {x.x, x.y, x.z, x.w}; __builtin_nontemporal_store(v, (f32x4v*)p); }
DI void st_nt16u(void* p, u32x4 v) { __builtin_nontemporal_store(v, (u32x4*)p); }
DI int tid_opaque() { int t = threadIdx.x; asm volatile("" : "+v"(t)); return t; }

struct Params {
  const float *xp, *xs, *pp, *ps, *cak, *cav, *cbk, *cbv, *gpre, *win, *relb, *wout, *gpost, *wple, *wgate;
  float* out;
  unsigned char* ws;
};

constexpr int MP = 32768, MS = 512, MT = 33280;
constexpr float EPS = 1e-6f;
constexpr float QSCALE = 0.125f * 1.4426950408889634f;

#define XCD_BAR_WORDS 3456
constexpr size_t SZ_ACT = (size_t)MT * 1024 * 2;
constexpr size_t SZ_QKV = (size_t)16 * 8 * 2048 * 64 * 2;
constexpr size_t OFF_WIN = 0;
constexpr size_t OFF_WOUT = OFF_WIN + (size_t)2 * 4096 * 1024 * 2;
constexpr size_t OFF_WGATE = OFF_WOUT + (size_t)2 * 1024 * 1024 * 2;
constexpr size_t OFF_WPLE = OFF_WGATE + (size_t)2 * 1024 * 1024 * 2;
constexpr size_t OFF_R0 = OFF_WPLE + (size_t)2 * 1024 * 256 * 2;
constexpr size_t OFF_R1 = OFF_R0 + SZ_ACT;
constexpr size_t OFF_PB = OFF_R1 + SZ_ACT;
constexpr size_t OFF_PSUM = OFF_PB + (size_t)2 * MT * 256 * 2;
constexpr size_t OFF_QA = OFF_PSUM + (size_t)MT * 32 * 4;
constexpr size_t OFF_KA = OFF_QA + SZ_QKV;
constexpr size_t OFF_VAT = OFF_KA + SZ_QKV;
constexpr size_t OFF_QB = OFF_VAT + SZ_QKV;
constexpr size_t OFF_KB = OFF_QB + SZ_QKV;
constexpr size_t OFF_VBT = OFF_KB + SZ_QKV;
constexpr size_t OFF_QAS = OFF_VBT + SZ_QKV;
constexpr size_t OFF_QBS = OFF_QAS + (size_t)128 * 32 * 64 * 2;
constexpr size_t OFF_KAS = OFF_QBS + (size_t)128 * 32 * 64 * 2;
constexpr size_t OFF_VAST = OFF_KAS + (size_t)2 * 128 * 544 * 64 * 2;
constexpr size_t OFF_KBS = OFF_VAST + (size_t)2 * 128 * 544 * 64 * 2;
constexpr size_t OFF_VBST = OFF_KBS + (size_t)2 * 128 * 1056 * 64 * 2;
constexpr size_t OFF_CTR = OFF_VBST + (size_t)2 * 128 * 1056 * 64 * 2;
constexpr size_t OFF_BAR = OFF_CTR + 256;
constexpr size_t OFF_RSTD = OFF_BAR + (size_t)XCD_BAR_WORDS * 4;
constexpr size_t WS_TOTAL = OFF_RSTD + (size_t)MT * 4;
static_assert(WS_TOTAL <= (size_t)536870912, "workspace too large");
static_assert(OFF_QB - OFF_QA >= SZ_ACT, "ple product must fit in the q/k/v region of head group A");

constexpr size_t O_AKP = 34078720;
constexpr size_t O_AVP = O_AKP + 8388608;
constexpr size_t O_BKP = O_AVP + 8388608;
constexpr size_t O_BVP = O_BKP + 33554432;
constexpr size_t O_AKS = O_BVP + 33554432;
constexpr size_t O_AVS = O_AKS + 524288;
constexpr size_t O_BKS = O_AVS + 524288;
constexpr size_t O_BVS = O_BKS + 524288;


#define XB_TMO      128
#define XB_XCNT(j)  (256  + 64 * (j))
#define XB_XSUB(j)  (1280 + 64 * (j))
#define XB_XGEN(j)  (2304 + 64 * (j))
#define XB_TOP      3328
#define XB_TOPGEN   3392
#define XB_SPIN_CAP (1u << 22)
#define LAS __attribute__((address_space(3)))
DI unsigned xb_ld(unsigned* p) { return __hip_atomic_load(p, __ATOMIC_RELAXED, __HIP_MEMORY_SCOPE_AGENT); }
DI unsigned xb_add(unsigned* p, unsigned v) { return __hip_atomic_fetch_add(p, v, __ATOMIC_RELAXED, __HIP_MEMORY_SCOPE_AGENT); }
DI unsigned xb_xcc_id() { return (unsigned)__builtin_amdgcn_s_getreg((3 << 11) | 20) & 0xFu; }
#define XB_SPIN(cond, bar) do { unsigned _sp = 0; while (cond) { __builtin_amdgcn_s_sleep(1); \
    if ((++_sp & 255u) == 0u) { if (xb_ld(&(bar)[XB_TMO])) break; if (_sp > XB_SPIN_CAP) { atomicAdd(&(bar)[XB_TMO], 1u); break; } } } } while (0)
struct XcdBarrier { unsigned* bar; unsigned x; volatile LAS unsigned* st; };
DI XcdBarrier xcd_barrier_post(unsigned* bar, volatile LAS unsigned* st) {
  XcdBarrier b; b.bar = bar; b.x = xb_xcc_id(); b.st = st;
  if (threadIdx.x == 0) { st[2] = xb_add(&bar[XB_XCNT(b.x)], 1u); st[3] = b.x; }
  return b;
}
DI void xcd_barrier_complete(unsigned* bar, unsigned x, unsigned& nloc, unsigned& nx) {
  const unsigned G = gridDim.x * gridDim.y * gridDim.z;
  unsigned sum, cnt, mine, sp = 0u;
  for (;;) {
    sum = 0u; cnt = 0u; mine = 0u;
#pragma unroll
    for (unsigned j = 0; j < 16; ++j) { const unsigned c = xb_ld(&bar[XB_XCNT(j)]); sum += c; cnt += (c > 0u) ? 1u : 0u; mine = (j == x) ? c : mine; }
    if (sum == G) break;
    __builtin_amdgcn_s_sleep(1);
    if ((++sp & 255u) == 0u) { if (xb_ld(&bar[XB_TMO])) break; if (sp > XB_SPIN_CAP) { atomicAdd(&bar[XB_TMO], 1u); break; } }
  }
  nloc = mine > 0u ? mine : 1u; nx = cnt > 0u ? cnt : 1u;
}
DI void xcd_barrier(const XcdBarrier& b) {
  asm volatile("s_waitcnt vmcnt(0)" ::: "memory");
  __syncthreads();
  if (threadIdx.x == 0) {
    unsigned* bar = b.bar;
    __builtin_amdgcn_s_waitcnt(0);
    unsigned nloc = b.st[0], nx = b.st[1];
    if (nloc == 0u) { xcd_barrier_complete(bar, b.x, nloc, nx); b.st[0] = nloc; b.st[1] = nx; }
    const unsigned old = xb_add(&bar[XB_XSUB(b.x)], 1u);
    const unsigned gen = old / nloc;
    if (old + 1u == (gen + 1u) * nloc) {
      __builtin_amdgcn_fence(__ATOMIC_RELEASE, "agent");
      asm volatile("s_waitcnt vmcnt(0)" ::: "memory");
      const unsigned og = xb_add(&bar[XB_TOP], 1u);
      const unsigned tg = og / nx;
      if (og + 1u == (tg + 1u) * nx) xb_add(&bar[XB_TOPGEN], 1u);
      else XB_SPIN(xb_ld(&bar[XB_TOPGEN]) == tg, bar);
      __builtin_amdgcn_fence(__ATOMIC_ACQUIRE, "agent");
      xb_add(&bar[XB_XGEN(b.x)], 1u);
      asm volatile("s_waitcnt vmcnt(0)" ::: "memory");
    } else {
      XB_SPIN(xb_ld(&bar[XB_XGEN(b.x)]) == gen, bar);
      __builtin_amdgcn_fence(__ATOMIC_ACQUIRE, "agent");
      asm volatile("s_waitcnt vmcnt(0)" ::: "memory");
    }
  }
  __syncthreads();
}

DI void delay_ticks(unsigned ticks) {
  const unsigned long long t0 = __builtin_amdgcn_s_memrealtime();
  while (__builtin_amdgcn_s_memrealtime() - t0 < (unsigned long long)ticks) __builtin_amdgcn_s_sleep(8);
}

constexpr int BK = 64, LDT = BK + 8;
constexpr int NTHR = 512;
constexpr int SMEM_BYTES = 2 * (2 * 256 * LDT * 2) + 1024;

template <int NCB>
DI void gemm_mainloop(const u16* __restrict__ A, int lda, const u16* __restrict__ Bt, int ldb, int K, int ks0,
                      u16* sA, u16* sB, f32x16 (&acc)[4][NCB]) {
  const int kmask = K - 1;
  const int tid = tid_opaque(), lane = tid & 63, wave = tid >> 6, wm = wave >> 2, wn = wave & 3, r = lane & 31, h = lane >> 5;
  const int lrow = tid >> 3, lcol = (tid & 7) * 8;
  constexpr int NB = 2 * NCB;
  const u16* gA = A + (size_t)lrow * lda + lcol;
  const u16* gB = Bt + (size_t)lrow * ldb + lcol;
  u32x4 ra0[4], rb0[NB], ra1[4], rb1[NB];
  const int kf0 = (ks0 * BK) & kmask, kf1 = ((ks0 + 1) * BK) & kmask, kf2 = ((ks0 + 2) * BK) & kmask;
#pragma unroll
  for (int i = 0; i < 4; ++i) ra0[i] = *(const u32x4*)(gA + kf0 + (size_t)(64 * i) * lda);
#pragma unroll
  for (int i = 0; i < NB; ++i) rb0[i] = *(const u32x4*)(gB + kf0 + (size_t)(64 * i) * ldb);
  asm volatile("" ::: "memory");
#pragma unroll
  for (int i = 0; i < 4; ++i) ra1[i] = *(const u32x4*)(gA + kf1 + (size_t)(64 * i) * lda);
#pragma unroll
  for (int i = 0; i < NB; ++i) rb1[i] = *(const u32x4*)(gB + kf1 + (size_t)(64 * i) * ldb);
#pragma unroll
  for (int a = 0; a < 4; ++a)
#pragma unroll
    for (int b = 0; b < NCB; ++b)
#pragma unroll
      for (int i = 0; i < 16; ++i) acc[a][b][i] = 0.f;
  constexpr int STG = 2 * 256 * LDT;
  const u16* rA = sA + (128 * wm + r) * LDT + 8 * h;
  const u16* rB = sB + (32 * NCB * wn + r) * LDT + 8 * h;
  u16* wA = sA + lrow * LDT + lcol;
  u16* wB = sB + lrow * LDT + lcol;
  __syncthreads();
#pragma unroll
  for (int i = 0; i < 4; ++i) *(u32x4*)(wA + 64 * i * LDT) = ra0[i];
#pragma unroll
  for (int i = 0; i < NB; ++i) *(u32x4*)(wB + 64 * i * LDT) = rb0[i];
#pragma unroll
  for (int i = 0; i < 4; ++i) ra0[i] = *(const u32x4*)(gA + kf2 + (size_t)(64 * i) * lda);
#pragma unroll
  for (int i = 0; i < NB; ++i) rb0[i] = *(const u32x4*)(gB + kf2 + (size_t)(64 * i) * ldb);
  __syncthreads();
#define GEMM_STEP(RA_, RB_, WS_, RS_, KNEXT)                                                    \
  {                                                                                             \
    _Pragma("unroll") for (int i = 0; i < 4; ++i) *(u32x4*)(wA + (WS_) * STG + 64 * i * LDT) = RA_[i];  \
    _Pragma("unroll") for (int i = 0; i < NB; ++i) *(u32x4*)(wB + (WS_) * STG + 64 * i * LDT) = RB_[i]; \
    {                                                                                           \
      const int kn = (KNEXT) & kmask;     \
      _Pragma("unroll") for (int i = 0; i < 4; ++i) RA_[i] = *(const u32x4*)(gA + kn + (size_t)(64 * i) * lda);  \
      _Pragma("unroll") for (int i = 0; i < NB; ++i) RB_[i] = *(const u32x4*)(gB + kn + (size_t)(64 * i) * ldb); \
    }                                                                                           \
    _Pragma("unroll") for (int ks = 0; ks < 4; ++ks) {                                          \
      bf16x8 af[4], bf[NCB];                                                                    \
      _Pragma("unroll") for (int a = 0; a < 4; ++a) af[a] = *(const bf16x8*)(rA + (RS_) * STG + 32 * a * LDT + 16 * ks);   \
      _Pragma("unroll") for (int b = 0; b < NCB; ++b) bf[b] = *(const bf16x8*)(rB + (RS_) * STG + 32 * b * LDT + 16 * ks); \
      _Pragma("unroll") for (int a = 0; a < 4; ++a)                                             \
        _Pragma("unroll") for (int b = 0; b < NCB; ++b) acc[a][b] = MFMA32(af[a], bf[b], acc[a][b]);         \
    }                                                                                           \
    __syncthreads();                                                                            \
  }
  for (int k0 = 0; k0 < K; k0 += 2 * BK) {
    GEMM_STEP(ra1, rb1, 1, 0, ks0 * BK + k0 + 3 * BK)
    GEMM_STEP(ra0, rb0, 0, 1, ks0 * BK + k0 + 4 * BK)
  }
#undef GEMM_STEP
}

template <class Desc>
DI void transpose_stream(int j0, int jend, int jstride, const Desc& D, float* sm) {
  const int tid = tid_opaque();
  const int nn = tid & 63, kq = tid >> 6;
  const int kp = (tid & 31) * 2, nq = tid >> 5;
  float v[8];
  const float* src = nullptr; const float* scale = nullptr; u16* dst = nullptr; int sld = 0, dld = 0;
  int j = j0;
  if (j < jend) {
    D(j, src, sld, dst, dld, scale);
#pragma unroll
    for (int i = 0; i < 8; ++i) { const int kk = kq + 8 * i; v[i] = src[(size_t)kk * sld + nn] * (scale ? scale[kk] : 1.0f); }
  }
  while (j < jend) {
    u16* cdst = dst; const int cdld = dld;
    float w[8];
#pragma unroll
    for (int i = 0; i < 8; ++i) w[i] = v[i];
    const int jn = j + jstride;
    if (jn < jend) {
      D(jn, src, sld, dst, dld, scale);
#pragma unroll
      for (int i = 0; i < 8; ++i) { const int kk = kq + 8 * i; v[i] = src[(size_t)kk * sld + nn] * (scale ? scale[kk] : 1.0f); }
    }
#pragma unroll
    for (int i = 0; i < 8; ++i) sm[(kq + 8 * i) * 65 + nn] = w[i];
    __syncthreads();
#pragma unroll
    for (int i = 0; i < 4; ++i) {
      const int n2 = nq + 16 * i;
      *(unsigned*)(cdst + (size_t)n2 * cdld + kp) = pack2(sm[kp * 65 + n2], sm[(kp + 1) * 65 + n2]);
    }
    __syncthreads();
    j = jn;
  }
}

DI uint4 cvt8(const float* __restrict__ s) {
  const float4 a = *(const float4*)s, b = *(const float4*)(s + 4);
  uint4 o;
  o.x = pack2(a.x, a.y); o.y = pack2(a.z, a.w); o.z = pack2(b.x, b.y); o.w = pack2(b.z, b.w);
  return o;
}

DI void cache_convert(const Params& p, int layer, int bid, int nb, float* sm) {
  const int tid = tid_opaque();
  unsigned char* ws = p.ws;
  auto D = [&](int j, const float*& src, int& sld, u16*& dst, int& dld, const float*& scale) {
    scale = nullptr; sld = 512;
    if (j < 1024) {
      const int lbh = layer * 128 + (j >> 3), kt = j & 7;
      const int lb = lbh >> 3, hd = lbh & 7;
      src = p.cav + ((size_t)lb * 512 + kt * 64) * 512 + hd * 64;
      dst = (u16*)(ws + OFF_VAST) + (size_t)lbh * 64 * 544 + kt * 64; dld = 544;
    } else {
      const int jj = j - 1024;
      const int lbh = layer * 128 + (jj >> 4), kt = jj & 15;
      const int lb = lbh >> 3, hd = lbh & 7;
      src = p.cbv + ((size_t)lb * 1024 + kt * 64) * 512 + hd * 64;
      dst = (u16*)(ws + OFF_VBST) + (size_t)lbh * 64 * 1056 + kt * 64; dld = 1056;
    }
  };
  transpose_stream(bid, 3072, nb, D, sm);
  const size_t gtid = (size_t)bid * NTHR + tid, gn = (size_t)nb * NTHR;
  for (size_t e0 = gtid; e0 < (size_t)524288; e0 += gn) {
    const size_t e = e0 + (size_t)layer * 524288;
    const int d8 = e & 7, hd = (e >> 3) & 7, s = (e >> 6) & 511, lb = (int)(e >> 15);
    *(uint4*)((u16*)(ws + OFF_KAS) + (((size_t)lb * 8 + hd) * 544 + s) * 64 + d8 * 8) = cvt8(p.cak + e * 8);
  }
  for (size_t e0 = gtid; e0 < (size_t)1048576; e0 += gn) {
    const size_t e = e0 + (size_t)layer * 1048576;
    const int d8 = e & 7, hd = (e >> 3) & 7, s = (e >> 6) & 1023, lb = (int)(e >> 16);
    *(uint4*)((u16*)(ws + OFF_KBS) + (((size_t)lb * 8 + hd) * 1056 + s) * 64 + d8 * 8) = cvt8(p.cbk + e * 8);
  }
}

DI void phase0(const Params& p, float* sm) {
  const int tid = tid_opaque();
  unsigned char* ws = p.ws;
  if (blockIdx.x == 0 && tid < 4) ((int*)(ws + OFF_CTR))[tid] = 0;
  auto D = [&](int j, const float*& src, int& sld, u16*& dst, int& dld, const float*& scale) {
    scale = nullptr;
    if (j < 2048) {
      const int l = j >> 10, kt = (j >> 6) & 15, nt = j & 63;
      src = p.win + ((size_t)l * 1024 + kt * 64) * 4096 + nt * 64; sld = 4096;
      dst = (u16*)(ws + OFF_WIN) + ((size_t)l * 4096 + nt * 64) * 1024 + kt * 64; dld = 1024;
      scale = p.gpre + l * 1024 + kt * 64;
    } else if (j < 3072) {
      const int jj = (j - 2048) & 511;
      const bool gate = j >= 2560;
      const int l = jj >> 8, kt = (jj >> 4) & 15, nt = jj & 15;
      src = (gate ? p.wgate : p.wout) + ((size_t)l * 1024 + kt * 64) * 1024 + nt * 64; sld = 1024;
      dst = (u16*)(ws + (gate ? OFF_WGATE : OFF_WOUT)) + ((size_t)l * 1024 + nt * 64) * 1024 + kt * 64; dld = 1024;
    } else {
      const int jj = j - 3072;
      const int l = jj >> 6, kt = (jj >> 4) & 3, nt = jj & 15;
      src = p.wple + ((size_t)l * 256 + kt * 64) * 1024 + nt * 64; sld = 1024;
      dst = (u16*)(ws + OFF_WPLE) + ((size_t)l * 1024 + nt * 64) * 256 + kt * 64; dld = 256;
    }
  };
  transpose_stream((int)blockIdx.x, 3200, (int)gridDim.x, D, sm);
  const size_t gtid = (size_t)blockIdx.x * NTHR + tid, gn = (size_t)gridDim.x * NTHR;
  for (size_t e = gtid; e < (size_t)2 * MT * 32; e += gn) {
    const int c8 = e & 31;
    const size_t lr = e >> 5;
    const int l = (int)(lr / MT), row = (int)(lr % MT);
    const float* src = row < MP ? p.pp + ((size_t)l * MP + row) * 256 : p.ps + ((size_t)l * MS + (row - MP)) * 256;
    *(uint4*)((u16*)(ws + OFF_PB) + lr * 256 + c8 * 8) = cvt8(src + c8 * 8);
  }
  const int lane = tid & 63;
  const int gw = (int)(gtid >> 6), nw = (int)(gn >> 6);
  for (int row = gw; row < MT; row += nw) {
    const float* src = row < MP ? p.xp + (size_t)row * 1024 : p.xs + (size_t)(row - MP) * 1024;
    u16* dst = (u16*)(ws + OFF_R0) + (size_t)row * 1024;
    float ss = 0.f;
#pragma unroll
    for (int j = 0; j < 2; ++j) {
      const int c = 8 * lane + 512 * j;
      const float4 a = *(const float4*)(src + c), b = *(const float4*)(src + c + 4);
      ss += a.x * a.x + a.y * a.y + a.z * a.z + a.w * a.w + b.x * b.x + b.y * b.y + b.z * b.z + b.w * b.w;
      uint4 o;
      o.x = pack2(a.x, a.y); o.y = pack2(a.z, a.w); o.z = pack2(b.x, b.y); o.w = pack2(b.z, b.w);
      *(uint4*)(dst + c) = o;
    }
#pragma unroll
    for (int m = 32; m >= 1; m >>= 1) ss += __shfl_xor(ss, m);
    if (lane == 0) ((float*)(ws + OFF_RSTD))[row] = rsqrtf(ss * (1.0f / 1024.0f) + EPS);
  }
}

DI float sigm(float x) { return __builtin_amdgcn_rcpf(1.0f + __builtin_amdgcn_exp2f(-1.4426950408889634f * x)); }

namespace pg8 {
#define PG8_LAS __attribute__((address_space(3)))
constexpr int BM = 256, BK = 64, HALF = 128, HTB = HALF * BK * 2, STAGE_BYTES = 8 * HTB, NXCD = 8, WGM = 8;
DI int lds_byte(int r, int c) { const int st = (r >> 4) * 2 + (c >> 5), rr = r & 15, cc = c & 31, ob = rr * 64 + cc * 2; return st * 1024 + (ob ^ (((ob >> 9) & 1) << 5)); }
DI void stage_rc(int b, int& R, int& C) { const int st = b / 1024, sb = b % 1024, swz = sb ^ (((sb >> 9) & 1) << 5); R = (st >> 1) * 16 + swz / 64; C = (st & 1) * 32 + (swz % 64) / 2; }
DI int perm32(int rho) { const int n = rho >> 4, i = rho & 15; return 8 * (i >> 2) + 4 * n + (i & 3); }
struct Unit { int pm, pn; };
struct Gemm { const u16* A; const u16* Bt; int M, N, K; };
struct StaticOrder {
  int nM, nN, nwg, G, c;
  DI void init(int M, int N, int G_, int c_) { nM = M / BM; nN = N / BM; nwg = nM * nN; G = G_; c = c_; }
  DI bool next(int i, Unit& u) const {
    const long L = (long)i * G + c; if (L >= nwg) return false;
    int wgid = (int)L; { const int q = nwg / NXCD, r = nwg % NXCD, xcd = wgid % NXCD, off = wgid / NXCD; wgid = (xcd < r ? xcd * (q + 1) : r * (q + 1) + (xcd - r) * q) + off; }
    const int nig = WGM * nN, gid = wgid / nig, fm = gid * WGM, gsz = (nM - fm) < WGM ? (nM - fm) : WGM;
    u.pm = fm + ((wgid % nig) % gsz); u.pn = (wgid % nig) / gsz; return true;
  }
};
template <class Epi>
DI void gemm_phase(PG8_LAS unsigned char* lds, const Gemm g, const StaticOrder& S, const Epi& E) {
  const int tid = threadIdx.x, wid = __builtin_amdgcn_readfirstlane(tid >> 6), lane = tid & 63, wr = wid >> 2, wc = wid & 3, fr = lane & 15, fq = lane >> 4;
  const int K = g.K, nt = K / BK;
  unsigned voffA[2], voffB[2];
#pragma unroll
  for (int i = 0; i < 2; ++i) { int R, C; stage_rc(tid * 16 + i * 8192, R, C); const int Rb = (R & ~31) + perm32(R & 31);
    voffA[i] = (unsigned)(R * K + C) * 2u; voffB[i] = (unsigned)(Rb * K + C) * 2u; }
  const size_t kstep = (size_t)(BK * 2);
  const size_t hstep = (size_t)HALF * K * 2;
  const size_t tstep = 2 * hstep;
  const unsigned ldsw = (unsigned)wid * 1024u;
  const int aoff = lds_byte(wr * 64 + fr, fq * 8), boff = lds_byte(wc * 32 + fr, fq * 8);
#define PG8_SA(b, h) (((b) * 2 + (h)) * HTB)
#define PG8_SB(b, h) ((4 + (b) * 2 + (h)) * HTB)
#define PG8_STAGE(bufoff, gbase, voff) do { _Pragma("unroll") for (int _i = 0; _i < 2; ++_i) \
    __builtin_amdgcn_global_load_lds((const unsigned*)((const char*)(gbase) + (voff)[_i]), (PG8_LAS unsigned*)(lds + (bufoff) + ldsw + _i * 8192), 16, 0, 0); } while (0)
#define PG8_LDA(dst, b, h) do { _Pragma("unroll") for (int m = 0; m < 4; ++m) _Pragma("unroll") for (int k = 0; k < 2; ++k) dst[m][k] = *(const PG8_LAS bf16x8*)(lds + PG8_SA(b, h) + aoff + m * 2048 + k * 1024); } while (0)
#define PG8_LDB(dst, b, h) do { _Pragma("unroll") for (int n = 0; n < 2; ++n) _Pragma("unroll") for (int k = 0; k < 2; ++k) dst[n][k] = *(const PG8_LAS bf16x8*)(lds + PG8_SB(b, h) + boff + n * 2048 + k * 1024); } while (0)
#define PG8_MMA(ai, bj, At, Bt) do { __builtin_amdgcn_s_setprio(1); _Pragma("unroll") for (int m = 0; m < 4; ++m) _Pragma("unroll") for (int n = 0; n < 2; ++n) _Pragma("unroll") for (int k = 0; k < 2; ++k) \
    acc[ai][bj][m][n] = __builtin_amdgcn_mfma_f32_16x16x32_bf16(Bt[n][k], At[m][k], acc[ai][bj][m][n], 0, 0, 0); __builtin_amdgcn_s_setprio(0); } while (0)
#define PG8_WAIT_V(n) asm volatile("s_waitcnt vmcnt(" #n ")" ::: "memory")
#define PG8_WAIT_L(n) asm volatile("s_waitcnt lgkmcnt(" #n ")" ::: "memory")
#define PG8_BAR __builtin_amdgcn_s_barrier()
#define PG8_SCHED __builtin_amdgcn_sched_barrier(0)
  Unit cur, nxt; int ui = 0;
  if (!S.next(0, cur)) return;
  f32x4 acc[2][2][4][2];
#pragma unroll
  for (int a = 0; a < 2; ++a)
#pragma unroll
    for (int b = 0; b < 2; ++b)
#pragma unroll
      for (int m = 0; m < 4; ++m)
#pragma unroll
        for (int n = 0; n < 2; ++n) acc[a][b][m][n] = (f32x4){0.f, 0.f, 0.f, 0.f};
  bf16x8 At[4][2], B0[2][2], B1[2][2];
  const char* cA = (const char*)g.A + (size_t)cur.pm * tstep; const char* cB = (const char*)g.Bt + (size_t)cur.pn * tstep;
  PG8_STAGE(PG8_SB(0, 0), cB, voffB); PG8_STAGE(PG8_SA(0, 0), cA, voffA); PG8_STAGE(PG8_SB(0, 1), cB + hstep, voffB); PG8_STAGE(PG8_SA(0, 1), cA + hstep, voffA);
  if (wr == 1) PG8_BAR;
  PG8_WAIT_V(4); PG8_BAR;
  PG8_STAGE(PG8_SB(1, 0), cB + kstep, voffB); PG8_STAGE(PG8_SA(1, 0), cA + kstep, voffA); PG8_STAGE(PG8_SB(1, 1), cB + hstep + kstep, voffB);
  PG8_WAIT_V(6); PG8_BAR;
  for (;;) {
    const bool has_next = S.next(ui + 1, nxt);
    const char* nA = has_next ? (const char*)g.A + (size_t)nxt.pm * tstep : cA; const char* nB = has_next ? (const char*)g.Bt + (size_t)nxt.pn * tstep : cB;
    for (int t = 0; t < nt; t += 2) {
      const bool last = (t == nt - 2);
      const char* a1 = cA + (size_t)(t + 1) * kstep;
      const char* a2 = last ? nA : cA + (size_t)(t + 2) * kstep; const char* b2 = last ? nB : cB + (size_t)(t + 2) * kstep;
      const char* a3 = a2 + kstep; const char* b3 = b2 + kstep;
      PG8_LDB(B0, 0, 0); PG8_SCHED; PG8_LDA(At, 0, 0); PG8_STAGE(PG8_SA(1, 1), a1 + hstep, voffA);
      PG8_WAIT_L(8); PG8_BAR; PG8_WAIT_L(0); PG8_MMA(0, 0, At, B0); PG8_BAR; PG8_SCHED;
      PG8_LDB(B1, 0, 1); PG8_STAGE(PG8_SB(0, 0), b2, voffB);
      PG8_BAR; PG8_WAIT_L(0); PG8_MMA(0, 1, At, B1); PG8_BAR;
      PG8_LDA(At, 0, 1); PG8_STAGE(PG8_SA(0, 0), a2, voffA);
      PG8_BAR; PG8_WAIT_L(0); PG8_MMA(1, 0, At, B0); PG8_BAR; PG8_SCHED;
      PG8_STAGE(PG8_SB(0, 1), b2 + hstep, voffB);
      PG8_WAIT_V(6); PG8_BAR; PG8_MMA(1, 1, At, B1); PG8_BAR;
      PG8_LDB(B0, 1, 0); PG8_SCHED; PG8_LDA(At, 1, 0); PG8_STAGE(PG8_SA(0, 1), a2 + hstep, voffA);
      PG8_WAIT_L(8); PG8_BAR; PG8_WAIT_L(0); PG8_MMA(0, 0, At, B0); PG8_BAR; PG8_SCHED;
      PG8_LDB(B1, 1, 1); PG8_STAGE(PG8_SB(1, 0), b3, voffB);
      PG8_BAR; PG8_WAIT_L(0); PG8_MMA(0, 1, At, B1); PG8_BAR;
      PG8_LDA(At, 1, 1); PG8_STAGE(PG8_SA(1, 0), a3, voffA);
      PG8_BAR; PG8_WAIT_L(0); PG8_MMA(1, 0, At, B0); PG8_BAR; PG8_SCHED;
      PG8_STAGE(PG8_SB(1, 1), b3 + hstep, voffB);
      PG8_WAIT_V(6); PG8_BAR; PG8_MMA(1, 1, At, B1); PG8_BAR;
    }
    E(acc, cur);
#if PROBE_DUP == 9
    E(acc, cur);
#endif
    if (!has_next) break;
#pragma unroll
    for (int a = 0; a < 2; ++a)
#pragma unroll
      for (int b = 0; b < 2; ++b)
#pragma unroll
        for (int m = 0; m < 4; ++m)
#pragma unroll
          for (int n = 0; n < 2; ++n) acc[a][b][m][n] = (f32x4){0.f, 0.f, 0.f, 0.f};
    cur = nxt; cA = nA; cB = nB; ++ui;
  }
  PG8_WAIT_V(0);
  if (wr == 0) PG8_BAR;
  PG8_BAR;
#undef PG8_SA
#undef PG8_SB
#undef PG8_STAGE
#undef PG8_LDA
#undef PG8_LDB
#undef PG8_MMA
#undef PG8_WAIT_V
#undef PG8_WAIT_L
#undef PG8_BAR
#undef PG8_SCHED
}
}

struct EpiP1 {
  const Params* pp; int layer; u16* Gbuf;
  DI void operator()(const f32x4 (&acc)[2][2][4][2], const pg8::Unit& u) const {
    const Params& p = *pp;
    const int tl = tid_opaque();
    const int lane = tl & 63, wid = tl >> 6, wr = wid >> 2, wc = wid & 3, fr = lane & 15, fq = lane >> 4;
    unsigned char* ws = p.ws;
    const float* rstd = (const float*)(ws + OFF_RSTD);
    const int seg = u.pn >> 1, kind = seg & 3, grp = seg >> 2;
    const bool prompt = u.pm < 128;
    const int d0 = (wc & 1) * 32 + 8 * fq;
#pragma unroll
    for (int am = 0; am < 8; ++am) {
      const int ai = am >> 2, m = am & 3;
      const int row = 256 * u.pm + 128 * ai + 64 * wr + 16 * m + fr;
      const float rs = rstd[row];
      int b, s;
      if (prompt) { b = row >> 11; s = row & 2047; } else { b = (row - MP) >> 5; s = (row - MP) & 31; }
      const int lb = layer * 16 + b;
#pragma unroll
      for (int bj = 0; bj < 2; ++bj) {
        const int hd = (u.pn & 1) * 4 + bj * 2 + (wc >> 1);
        const f32x4 v0 = acc[ai][bj][m][0] * rs, v1 = acc[ai][bj][m][1] * rs;
        if (kind == 3) {
          u32x4 o;
          o[0] = pack2(v0[0] * sigm(v0[0]), v0[1] * sigm(v0[1]));
          o[1] = pack2(v0[2] * sigm(v0[2]), v0[3] * sigm(v0[3]));
          o[2] = pack2(v1[0] * sigm(v1[0]), v1[1] * sigm(v1[1]));
          o[3] = pack2(v1[2] * sigm(v1[2]), v1[3] * sigm(v1[3]));
          st_nt16u(Gbuf + (size_t)row * 1024 + grp * 512 + hd * 64 + d0, o);
        } else if (kind == 0) {
          u32x4 o;
          o[0] = pack2(v0[0] * QSCALE, v0[1] * QSCALE); o[1] = pack2(v0[2] * QSCALE, v0[3] * QSCALE);
          o[2] = pack2(v1[0] * QSCALE, v1[1] * QSCALE); o[3] = pack2(v1[2] * QSCALE, v1[3] * QSCALE);
          u16* dst = prompt ? (u16*)(ws + (grp ? OFF_QB : OFF_QA)) + (((size_t)b * 8 + hd) * 2048 + s) * 64 + d0
                            : (u16*)(ws + (grp ? OFF_QBS : OFF_QAS)) + (((size_t)b * 8 + hd) * 32 + s) * 64 + d0;
          st_nt16u(dst, o);
        } else {
          float* fo = nullptr;
          if (!prompt) {
            if (grp == 0) fo = p.out + (kind == 1 ? O_AKS : O_AVS) + ((size_t)lb * 32 + s) * 512 + hd * 64 + d0;
            else fo = p.out + (kind == 1 ? O_BKS : O_BVS) + ((size_t)lb * 32 + s) * 512 + hd * 64 + d0;
          }
          if (fo) { __builtin_nontemporal_store(v0, (f32x4*)fo); __builtin_nontemporal_store(v1, (f32x4*)(fo + 4)); }
          u32x4 o;
          o[0] = pack2(v0[0], v0[1]); o[1] = pack2(v0[2], v0[3]); o[2] = pack2(v1[0], v1[1]); o[3] = pack2(v1[2], v1[3]);
          if (prompt) {
            const size_t off = kind == 1 ? (grp ? OFF_KB : OFF_KA) : (grp ? OFF_VBT : OFF_VAT);
            st_nt16u((u16*)(ws + off) + (((size_t)b * 8 + hd) * 2048 + s) * 64 + d0, o);
          } else if (kind == 1) {
            u16* dst = grp == 0 ? (u16*)(ws + OFF_KAS) + (((size_t)lb * 8 + hd) * 544 + 512 + s) * 64 + d0
                                : (u16*)(ws + OFF_KBS) + (((size_t)lb * 8 + hd) * 1056 + 1024 + s) * 64 + d0;
            st_nt16u(dst, o);
          } else {
            u16* vb; int ldv;
            if (grp == 0) { vb = (u16*)(ws + OFF_VAST) + (((size_t)lb * 8 + hd) * 64) * 544 + 512 + s; ldv = 544; }
            else { vb = (u16*)(ws + OFF_VBST) + (((size_t)lb * 8 + hd) * 64) * 1056 + 1024 + s; ldv = 1056; }
#pragma unroll
            for (int j = 0; j < 4; ++j) {
              vb[(size_t)(d0 + 2 * j) * ldv] = (u16)(o[j] & 0xffffu);
              vb[(size_t)(d0 + 2 * j + 1) * ldv] = (u16)(o[j] >> 16);
            }
          }
        }
      }
    }
  }
};

struct EpiP3 {
  u16* Y;
  DI void operator()(const f32x4 (&acc)[2][2][4][2], const pg8::Unit& u) const {
    const int tl = tid_opaque();
    const int lane = tl & 63, wid = tl >> 6, wr = wid >> 2, wc = wid & 3, fr = lane & 15, fq = lane >> 4;
#pragma unroll
    for (int ai = 0; ai < 2; ++ai)
#pragma unroll
      for (int m = 0; m < 4; ++m) {
        const int row = 256 * u.pm + 128 * ai + 64 * wr + 16 * m + fr;
#pragma unroll
        for (int bj = 0; bj < 2; ++bj) {
          const f32x4 v0 = acc[ai][bj][m][0], v1 = acc[ai][bj][m][1];
          u32x4 o;
          o[0] = pack2(v0[0], v0[1]); o[1] = pack2(v0[2], v0[3]); o[2] = pack2(v1[0], v1[1]); o[3] = pack2(v1[2], v1[3]);
          *(u32x4*)(Y + (size_t)row * 1024 + 256 * u.pn + 128 * bj + 32 * wc + 8 * fq) = o;
        }
      }
  }
};

struct EpiP5 {
  float* out; const u16* PLE; const u16* H1B; u16* HBN; float* psum; int layer;
  DI void operator()(const f32x4 (&acc)[2][2][4][2], const pg8::Unit& u) const {
    const int tl = tid_opaque();
    const int lane = tl & 63, wid = tl >> 6, wr = wid >> 2, wc = wid & 3, fr = lane & 15, fq = lane >> 4;
#pragma unroll
    for (int ai = 0; ai < 2; ++ai)
#pragma unroll
      for (int m = 0; m < 4; ++m) {
        const int row = 256 * u.pm + 128 * ai + 64 * wr + 16 * m + fr;
        float ss = 0.f;
#pragma unroll
        for (int bj = 0; bj < 2; ++bj) {
          const size_t idx = (size_t)row * 1024 + 256 * u.pn + 128 * bj + 32 * wc + 8 * fq;
          const u32x4 hw = *(const u32x4*)(H1B + idx);
          f32x4 h0, h1;
          h0[0] = bflo(hw[0]); h0[1] = bfhi(hw[0]); h0[2] = bflo(hw[1]); h0[3] = bfhi(hw[1]);
          h1[0] = bflo(hw[2]); h1[1] = bfhi(hw[2]); h1[2] = bflo(hw[3]); h1[3] = bfhi(hw[3]);
          const u32x4 pw = *(const u32x4*)(PLE + idx);
          const f32x4 a0 = acc[ai][bj][m][0], a1 = acc[ai][bj][m][1];
          f32x4 r0, r1;
          r0[0] = h0[0] + bflo(pw[0]) * sigm(a0[0]); r0[1] = h0[1] + bfhi(pw[0]) * sigm(a0[1]);
          r0[2] = h0[2] + bflo(pw[1]) * sigm(a0[2]); r0[3] = h0[3] + bfhi(pw[1]) * sigm(a0[3]);
          r1[0] = h1[0] + bflo(pw[2]) * sigm(a1[0]); r1[1] = h1[1] + bfhi(pw[2]) * sigm(a1[1]);
          r1[2] = h1[2] + bflo(pw[3]) * sigm(a1[2]); r1[3] = h1[3] + bfhi(pw[3]) * sigm(a1[3]);
          *(f32x4*)(out + idx) = r0; *(f32x4*)(out + idx + 4) = r1;
          if (layer == 0) {
            u32x4 o;
            o[0] = pack2(r0[0], r0[1]); o[1] = pack2(r0[2], r0[3]); o[2] = pack2(r1[0], r1[1]); o[3] = pack2(r1[2], r1[3]);
            *(u32x4*)(HBN + idx) = o;
            ss += r0[0] * r0[0] + r0[1] * r0[1] + r0[2] * r0[2] + r0[3] * r0[3] + r1[0] * r1[0] + r1[1] * r1[1] + r1[2] * r1[2] + r1[3] * r1[3];
          }
        }
        if (layer == 0) {
          ss += __shfl_xor(ss, 16); ss += __shfl_xor(ss, 32);
          if (fq == 0) psum[(size_t)row * 32 + u.pn * 4 + wc] = ss;
        }
      }
  }
};

constexpr float LOG2E = 1.4426950408889634f;
constexpr float SB_EXIT = -160.0f;
DI float ex2(float x) { return __builtin_amdgcn_exp2f(x); }
DI float lg2(float x) { return __builtin_amdgcn_logf(x); }

DI void attn_store(const f32x16& o0, const f32x16& o1, float scale, const u16* Gp, u16* Mp, int r, int h) {
#pragma unroll
  for (int db = 0; db < 2; ++db)
#pragma unroll
    for (int g = 0; g < 4; ++g) {
      const int d0 = 32 * db + 8 * g + 4 * h;
      const uint2 gv = *(const uint2*)(Gp + (size_t)r * 1024 + d0);
      const float x0 = (db ? o1[4 * g] : o0[4 * g]) * scale * bflo(gv.x);
      const float x1 = (db ? o1[4 * g + 1] : o0[4 * g + 1]) * scale * bfhi(gv.x);
      const float x2 = (db ? o1[4 * g + 2] : o0[4 * g + 2]) * scale * bflo(gv.y);
      const float x3 = (db ? o1[4 * g + 3] : o0[4 * g + 3]) * scale * bfhi(gv.y);
      uint2 o; o.x = pack2(x0, x1); o.y = pack2(x2, x3);
      *(uint2*)(Mp + (size_t)r * 1024 + d0) = o;
    }
}

DI bf16x8 ldv8(const u16* vp) {
  const bf16x4 lo = *(const bf16x4*)vp;
  const bf16x4 hi = *(const bf16x4*)(vp + 8);
  return __builtin_shufflevector(lo, hi, 0, 1, 2, 3, 4, 5, 6, 7);
}

DI bf16x8 pack8(const float* v) {
  u32x4 u;
  u[0] = pack2(v[0], v[1]); u[1] = pack2(v[2], v[3]); u[2] = pack2(v[4], v[5]); u[3] = pack2(v[6], v[7]);
  return __builtin_bit_cast(bf16x8, u);
}

DI void make_tf(bf16x8 (&tf)[2], int r, int h) {
#pragma unroll
  for (int s = 0; s < 2; ++s)
#pragma unroll
    for (int j = 0; j < 8; ++j) tf[s][j] = (16 * s + 8 * (j >> 2) + 4 * h + (j & 3) > r) ? (short)0x3F80 : (short)0;
}

DI unsigned pack2v(f2_t v) { bf2_t r = __builtin_convertvector(v, bf2_t); return __builtin_bit_cast(unsigned, r); }
DI bf16x8 pack8v(const f2_t* v) {
  u32x4 u;
  u[0] = pack2v(v[0]); u[1] = pack2v(v[1]); u[2] = pack2v(v[2]); u[3] = pack2v(v[3]);
  return __builtin_bit_cast(bf16x8, u);
}
template <bool MASK>
DI void sb_step(const f32x16& st, const bf16x8 (&vf)[2][2], const bf16x8 (&tf)[2], int k0, int qpos, int h,
                f32x16& o0, f32x16& o1, float& carry) {
  f2_t l1m[8], lb[8];
  f2_t cs2 = {0.f, 0.f};
#pragma unroll
  for (int p = 0; p < 8; ++p) {
    const f2_t z = {st[2 * p], st[2 * p + 1]};
    const f2_t e = {ex2(-fabsf(z.x)), ex2(-fabsf(z.y))};
    const f2_t t = e + 1.0f;
    const f2_t lg = {lg2(t.x), lg2(t.y)};
    const f2_t mx = {__builtin_amdgcn_fmed3f(z.x, 0.f, 3.0e38f), __builtin_amdgcn_fmed3f(z.y, 0.f, 3.0e38f)};
    const f2_t sp = mx + lg;
    if (MASK) {
      const bool c0 = (k0 + crow(2 * p, h)) < qpos, c1 = (k0 + crow(2 * p + 1, h)) < qpos;
      l1m[p] = (f2_t){c0 ? -sp.x : 0.f, c1 ? -sp.y : 0.f};
      lb[p] = (f2_t){c0 ? (z.x - sp.x) : -1e30f, c1 ? (z.y - sp.y) : -1e30f};
    } else {
      l1m[p] = -sp;
      lb[p] = z - sp;
    }
    cs2 += l1m[p];
  }
  float csum = cs2.x + cs2.y;
  csum += __shfl_xor(csum, 32);
  f32x16 af;
#pragma unroll
  for (int i = 0; i < 16; ++i) af[i] = 0.f;
  af = MFMA32(tf[0], pack8v(l1m), af);
  af = MFMA32(tf[1], pack8v(l1m + 4), af);
  f2_t w[8];
  const f2_t c2 = {carry, carry};
#pragma unroll
  for (int p = 0; p < 8; ++p) {
    const f2_t a2 = {af[2 * p], af[2 * p + 1]};
    const f2_t t = (lb[p] + a2) + c2;
    w[p] = (f2_t){ex2(t.x), ex2(t.y)};
  }
  carry += csum;
  const bf16x8 w0 = pack8v(w), w1 = pack8v(w + 4);
  o0 = MFMA32(vf[0][0], w0, o0);
  o0 = MFMA32(vf[0][1], w1, o0);
  o1 = MFMA32(vf[1][0], w0, o1);
  o1 = MFMA32(vf[1][1], w1, o1);
}

template <bool SCALE_BIAS, typename BiasPtr>
DI void band_step(const f32x16& st, const bf16x8 (&vf)[2][2], BiasPtr bias, float b0, int relmax, int relc, int h,
                  f32x16& o0, f32x16& o1, float& m, float& l) {
  float sv[16];
  if (relmax <= -128) {
#pragma unroll
    for (int i = 0; i < 16; ++i) sv[i] = st[i] + b0;
  } else {
#pragma unroll
    for (int i = 0; i < 16; ++i) {
      int rel = relc + crow(i, h);
      rel = min(max(rel, -128), 128) + 128;
      const float bv = bias[rel];
      sv[i] = st[i] + (SCALE_BIAS ? bv * LOG2E : bv);
    }
  }
  float mt = sv[0];
#pragma unroll
  for (int i = 1; i < 16; ++i) mt = fmaxf(mt, sv[i]);
  mt = fmaxf(mt, __shfl_xor(mt, 32));
  const float mnew = fmaxf(m, mt);
  const float alpha = ex2(m - mnew);
  m = mnew;
  float ps = 0.f;
#pragma unroll
  for (int i = 0; i < 16; ++i) { sv[i] = ex2(sv[i] - mnew); ps += sv[i]; }
  l = l * alpha + ps;
#pragma unroll
  for (int i = 0; i < 16; ++i) { o0[i] *= alpha; o1[i] *= alpha; }
  const bf16x8 w0 = pack8(sv), w1 = pack8(sv + 8);
  o0 = MFMA32(vf[0][0], w0, o0);
  o0 = MFMA32(vf[0][1], w1, o0);
  o1 = MFMA32(vf[1][0], w0, o1);
  o1 = MFMA32(vf[1][1], w1, o1);
}

DI void sb_item(const u16* __restrict__ Q, const u16* __restrict__ Kb, const u16* __restrict__ VT, int ldv,
                int qpos0, int ntiles, const u16* Gp, u16* Mp) {
  const int lane = tid_opaque() & 63, r = lane & 31, h = lane >> 5;
  bf16x8 qf[4];
#pragma unroll
  for (int ks = 0; ks < 4; ++ks) qf[ks] = *(const bf16x8*)(Q + r * 64 + 16 * ks + 8 * h);
  bf16x8 tf[2];
  make_tf(tf, r, h);
  f32x16 o0, o1;
#pragma unroll
  for (int i = 0; i < 16; ++i) { o0[i] = 0.f; o1[i] = 0.f; }
  float carry = 0.f;
  const int qpos = qpos0 + r;
  for (int kt = ntiles - 1; kt >= 0; --kt) {
    const int k0 = kt * 32;
    f32x16 st;
#pragma unroll
    for (int i = 0; i < 16; ++i) st[i] = 0.f;
    const u16* kp = Kb + (size_t)(k0 + r) * 64 + 8 * h;
#pragma unroll
    for (int ks = 0; ks < 4; ++ks) {
      const bf16x8 kf = *(const bf16x8*)(kp + 16 * ks);
      st = MFMA32(kf, qf[ks], st);
    }
    bf16x8 vf[2][2];
#pragma unroll
    for (int db = 0; db < 2; ++db)
#pragma unroll
      for (int s = 0; s < 2; ++s) vf[db][s] = ldv8(VT + (size_t)(32 * db + r) * ldv + k0 + 16 * s + 4 * h);
    if (k0 + 31 < qpos0) sb_step<false>(st, vf, tf, k0, qpos, h, o0, o1, carry);
    else sb_step<true>(st, vf, tf, k0, qpos, h, o0, o1, carry);
    if (__all(carry < SB_EXIT)) break;
  }
  attn_store(o0, o1, 1.0f, Gp, Mp, r, h);
}

DI void band_item(const u16* __restrict__ Q, const u16* __restrict__ Kb, const u16* __restrict__ VT, int ldv,
                  int kt_begin, int kt_end, int relbase, const float* __restrict__ bias, const u16* Gp, u16* Mp) {
  const int lane = tid_opaque() & 63, r = lane & 31, h = lane >> 5;
  bf16x8 qf[4];
#pragma unroll
  for (int ks = 0; ks < 4; ++ks) qf[ks] = *(const bf16x8*)(Q + r * 64 + 16 * ks + 8 * h);
  f32x16 o0, o1;
#pragma unroll
  for (int i = 0; i < 16; ++i) { o0[i] = 0.f; o1[i] = 0.f; }
  float m = -1e30f, l = 0.f;
  const float b0 = bias[0] * LOG2E;
  for (int kt = kt_begin; kt < kt_end; ++kt) {
    const int k0 = kt * 32;
    f32x16 st;
#pragma unroll
    for (int i = 0; i < 16; ++i) st[i] = 0.f;
    const u16* kp = Kb + (size_t)(k0 + r) * 64 + 8 * h;
#pragma unroll
    for (int ks = 0; ks < 4; ++ks) {
      const bf16x8 kf = *(const bf16x8*)(kp + 16 * ks);
      st = MFMA32(kf, qf[ks], st);
    }
    bf16x8 vf[2][2];
#pragma unroll
    for (int db = 0; db < 2; ++db)
#pragma unroll
      for (int s = 0; s < 2; ++s) vf[db][s] = ldv8(VT + (size_t)(32 * db + r) * ldv + k0 + 16 * s + 4 * h);
    band_step<true>(st, vf, bias, b0, k0 + 31 + relbase, k0 + relbase - r, h, o0, o1, m, l);
  }
  l += __shfl_xor(l, 32);
  attn_store(o0, o1, 1.0f / l, Gp, Mp, r, h);
}

constexpr int AT_KS = 72, AT_VS = 68;
constexpr int AT_STAGE = 64 * AT_KS + 64 * AT_VS;
constexpr int AT_BIAS_OFF = 2 * AT_STAGE * 2;

struct KvRegs { u32x4 k; u32x2 v0, v1; };
DI KvRegs kv_load(const u16* __restrict__ Kb, const u16* __restrict__ Vb, int ldv, int k0, int tid) {
  KvRegs g;
  const int row = tid >> 3, ch = tid & 7;
  g.k = *(const u32x4*)(Kb + (size_t)(k0 + row) * 64 + ch * 8);
  const int kp = tid >> 4, d4 = tid & 15;
  g.v0 = *(const u32x2*)(Vb + (size_t)(k0 + 2 * kp) * 64 + d4 * 4);
  g.v1 = *(const u32x2*)(Vb + (size_t)(k0 + 2 * kp + 1) * 64 + d4 * 4);
  return g;
}
DI void kv_store(u16* stage, const KvRegs& g, int tid) {
  const int row = tid >> 3, ch = tid & 7;
  *(u32x4*)(stage + row * AT_KS + ch * 8) = g.k;
  const int kp = tid >> 4, d4 = tid & 15;
  u16* vp = stage + 64 * AT_KS + (d4 * 4) * AT_VS + 2 * kp;
  *(unsigned*)(vp + 0 * AT_VS) = (g.v0[0] & 0xffffu) | (g.v1[0] << 16);
  *(unsigned*)(vp + 1 * AT_VS) = (g.v0[0] >> 16) | (g.v1[0] & 0xffff0000u);
  *(unsigned*)(vp + 2 * AT_VS) = (g.v0[1] & 0xffffu) | (g.v1[1] << 16);
  *(unsigned*)(vp + 3 * AT_VS) = (g.v0[1] >> 16) | (g.v1[1] & 0xffff0000u);
}
DI void kv_out(const KvRegs& g, float* fk, float* fv, int k0, int tid) {
  const int row = tid >> 3, ch = tid & 7;
  const size_t o = (size_t)(k0 + row) * 512 + ch * 8;
  f32x4 a, b;
  a[0] = bflo(g.k[0]); a[1] = bfhi(g.k[0]); a[2] = bflo(g.k[1]); a[3] = bfhi(g.k[1]);
  b[0] = bflo(g.k[2]); b[1] = bfhi(g.k[2]); b[2] = bflo(g.k[3]); b[3] = bfhi(g.k[3]);
  __builtin_nontemporal_store(a, (f32x4*)(fk + o)); __builtin_nontemporal_store(b, (f32x4*)(fk + o + 4));
  const int kp = tid >> 4, d4 = tid & 15;
  const size_t ov = (size_t)(k0 + 2 * kp) * 512 + d4 * 4;
  a[0] = bflo(g.v0[0]); a[1] = bfhi(g.v0[0]); a[2] = bflo(g.v0[1]); a[3] = bfhi(g.v0[1]);
  b[0] = bflo(g.v1[0]); b[1] = bfhi(g.v1[0]); b[2] = bflo(g.v1[1]); b[3] = bfhi(g.v1[1]);
  __builtin_nontemporal_store(a, (f32x4*)(fv + ov)); __builtin_nontemporal_store(b, (f32x4*)(fv + ov + 512));
}
DI void lds_frags(const u16* stage, int sub, const bf16x8 (&qf)[4], int r, int h, f32x16& st, bf16x8 (&vf)[2][2]) {
#pragma unroll
  for (int i = 0; i < 16; ++i) st[i] = 0.f;
  const u16* kp = stage + (32 * sub + r) * AT_KS + 8 * h;
#pragma unroll
  for (int ks = 0; ks < 4; ++ks) {
    const bf16x8 kf = *(const bf16x8*)(kp + 16 * ks);
    st = MFMA32(kf, qf[ks], st);
  }
#pragma unroll
  for (int db = 0; db < 2; ++db)
#pragma unroll
    for (int s = 0; s < 2; ++s) vf[db][s] = ldv8(stage + 64 * AT_KS + (32 * db + r) * AT_VS + 32 * sub + 16 * s + 4 * h);
}

DI void lds_frags2(const u16* stage, const bf16x8 (&qf)[4], int r, int h, f32x16& st0, f32x16& st1,
                   bf16x8 (&vf0)[2][2], bf16x8 (&vf1)[2][2]) {
#pragma unroll
  for (int i = 0; i < 16; ++i) { st0[i] = 0.f; st1[i] = 0.f; }
  const u16* kp = stage + r * AT_KS + 8 * h;
#pragma unroll
  for (int ks = 0; ks < 4; ++ks) {
    const bf16x8 k0f = *(const bf16x8*)(kp + 16 * ks);
    const bf16x8 k1f = *(const bf16x8*)(kp + 32 * AT_KS + 16 * ks);
    st0 = MFMA32(k0f, qf[ks], st0);
    st1 = MFMA32(k1f, qf[ks], st1);
  }
#pragma unroll
  for (int db = 0; db < 2; ++db)
#pragma unroll
    for (int s = 0; s < 2; ++s) {
      vf0[db][s] = ldv8(stage + 64 * AT_KS + (32 * db + r) * AT_VS + 16 * s + 4 * h);
      vf1[db][s] = ldv8(stage + 64 * AT_KS + (32 * db + r) * AT_VS + 32 + 16 * s + 4 * h);
    }
}
DI void band_step64(const f32x16& st0, const f32x16& st1, const bf16x8 (&vf0)[2][2], const bf16x8 (&vf1)[2][2],
                    const float* bias, float b0, int relmax, int relc, int h, f32x16& o0, f32x16& o1, float& m, float& l) {
  float sa[16], sb[16];
  if (relmax <= -128) {
#pragma unroll
    for (int i = 0; i < 16; ++i) sa[i] = st0[i] + b0;
  } else {
#pragma unroll
    for (int i = 0; i < 16; ++i) sa[i] = st0[i] + bias[min(max(relc + crow(i, h), -128), 128) + 128];
  }
  if (relmax + 32 <= -128) {
#pragma unroll
    for (int i = 0; i < 16; ++i) sb[i] = st1[i] + b0;
  } else {
#pragma unroll
    for (int i = 0; i < 16; ++i) sb[i] = st1[i] + bias[min(max(relc + 32 + crow(i, h), -128), 128) + 128];
  }
  float mt = fmaxf(sa[0], sb[0]);
#pragma unroll
  for (int i = 1; i < 16; ++i) mt = fmaxf(fmaxf(mt, sa[i]), sb[i]);
  mt = fmaxf(mt, __shfl_xor(mt, 32));
  const float mnew = fmaxf(m, mt);
  const float alpha = ex2(m - mnew);
  m = mnew;
  const f2_t mn = {mnew, mnew};
  f2_t ps2 = {0.f, 0.f};
#pragma unroll
  for (int p = 0; p < 8; ++p) {
    const f2_t da = (f2_t){sa[2 * p], sa[2 * p + 1]} - mn, db = (f2_t){sb[2 * p], sb[2 * p + 1]} - mn;
    sa[2 * p] = ex2(da.x); sa[2 * p + 1] = ex2(da.y); sb[2 * p] = ex2(db.x); sb[2 * p + 1] = ex2(db.y);
    ps2 += (f2_t){sa[2 * p], sa[2 * p + 1]} + (f2_t){sb[2 * p], sb[2 * p + 1]};
  }
  l = l * alpha + (ps2.x + ps2.y);
  o0 = o0 * alpha; o1 = o1 * alpha;
  const bf16x8 a0 = pack8(sa), a1 = pack8(sa + 8), b0w = pack8(sb), b1w = pack8(sb + 8);
  o0 = MFMA32(vf0[0][0], a0, o0);
  o1 = MFMA32(vf0[1][0], a0, o1);
  o0 = MFMA32(vf0[0][1], a1, o0);
  o1 = MFMA32(vf0[1][1], a1, o1);
  o0 = MFMA32(vf1[0][0], b0w, o0);
  o1 = MFMA32(vf1[1][0], b0w, o1);
  o0 = MFMA32(vf1[0][1], b1w, o0);
  o1 = MFMA32(vf1[1][1], b1w, o1);
}

DI void sbp_unit(const u16* __restrict__ Qb, const u16* __restrict__ Kb, const u16* __restrict__ VT, int qblk,
                 const u16* Gp, u16* Mp, u16* sm, float* fk, float* fv) {
  const int tid = tid_opaque(), lane = tid & 63, wave = tid >> 6, r = lane & 31, h = lane >> 5;
  const int q0w = qblk * 256 + 32 * wave;
  bf16x8 qf[4];
#pragma unroll
  for (int ks = 0; ks < 4; ++ks) qf[ks] = *(const bf16x8*)(Qb + (size_t)(q0w + r) * 64 + 16 * ks + 8 * h);
  bf16x8 tf[2];
  make_tf(tf, r, h);
  f32x16 o0, o1;
#pragma unroll
  for (int i = 0; i < 16; ++i) { o0[i] = 0.f; o1[i] = 0.f; }
  float carry = 0.f;
  int done = 0;
  const int qpos = q0w + r;
  const int t_hi = qblk * 4 + 3;
  KvRegs gA, gB;
  {
    const KvRegs g = kv_load(Kb, VT, 2048, t_hi * 64, tid);
    gA = kv_load(Kb, VT, 2048, max(t_hi - 1, 0) * 64, tid);
    kv_store(sm, g, tid);
    kv_out(g, fk, fv, t_hi * 64, tid);
  }
  __syncthreads();
  int cur = 0;
  for (int t = t_hi;; --t) {
    gB = kv_load(Kb, VT, 2048, max(t - 2, 0) * 64, tid);
    const u16* stage = sm + cur * AT_STAGE;
    if (!done) {
#pragma unroll
      for (int sub = 1; sub >= 0; --sub) {
        const int k0 = t * 64 + sub * 32;
        if (k0 < q0w + 31) {
          f32x16 st; bf16x8 vf[2][2];
          lds_frags(stage, sub, qf, r, h, st, vf);
          if (k0 + 31 < q0w) sb_step<false>(st, vf, tf, k0, qpos, h, o0, o1, carry);
          else sb_step<true>(st, vf, tf, k0, qpos, h, o0, o1, carry);
        }
      }
      done = __all(carry < SB_EXIT) ? 1 : 0;
    }
    if (t == 0) break;
    kv_store(sm + (cur ^ 1) * AT_STAGE, gA, tid);
    if (t - 1 >= qblk * 4) kv_out(gA, fk, fv, (t - 1) * 64, tid);
    int* fl = (int*)((unsigned char*)sm + AT_BIAS_OFF + 1056) + (t & 1) * 8;
    if (lane == 0) fl[wave] = done;
    __syncthreads();
    {
      const int4 fa = *(const int4*)fl, fb = *(const int4*)(fl + 4);
      if ((fa.x & fa.y & fa.z & fa.w & fb.x & fb.y & fb.z & fb.w) != 0) break;
    }
    gA = gB;
    cur ^= 1;
  }
  attn_store(o0, o1, 1.0f, Gp + (size_t)(32 * wave) * 1024, Mp + (size_t)(32 * wave) * 1024, r, h);
}

DI void bp_unit(const u16* __restrict__ Qb, const u16* __restrict__ Kb, const u16* __restrict__ VT, int qblk,
                const float* __restrict__ bias_g, const u16* Gp, u16* Mp, u16* sm, float* fk, float* fv) {
  const int tid = tid_opaque(), lane = tid & 63, wave = tid >> 6, r = lane & 31, h = lane >> 5;
  const int q0w = qblk * 256 + 32 * wave;
  const int cw = qblk * 4 + (wave >> 1);
  float* sbias = (float*)((unsigned char*)sm + AT_BIAS_OFF);
  if (tid < 257) sbias[tid] = bias_g[tid] * LOG2E;
  bf16x8 qf[4];
#pragma unroll
  for (int ks = 0; ks < 4; ++ks) qf[ks] = *(const bf16x8*)(Qb + (size_t)(q0w + r) * 64 + 16 * ks + 8 * h);
  f32x16 o0, o1;
#pragma unroll
  for (int i = 0; i < 16; ++i) { o0[i] = 0.f; o1[i] = 0.f; }
  float m = -1e30f, l = 0.f;
  const int t_hi = qblk * 4 + 3, t_lo = max(0, qblk * 4 - 8);
  KvRegs gA, gB;
  {
    const KvRegs g = kv_load(Kb, VT, 2048, t_hi * 64, tid);
    gA = kv_load(Kb, VT, 2048, max(t_hi - 1, t_lo) * 64, tid);
    kv_store(sm, g, tid);
    if (qblk >= 6) kv_out(g, fk, fv, t_hi * 64 - 1536, tid);
  }
  __syncthreads();
  const float b0 = sbias[0];
  int cur = 0;
  for (int t = t_hi;; --t) {
    gB = kv_load(Kb, VT, 2048, max(t - 2, t_lo) * 64, tid);
    const u16* stage = sm + cur * AT_STAGE;
    if (t <= cw && t >= cw - 8) {
      const int k0 = t * 64;
      f32x16 st0, st1; bf16x8 vf0[2][2], vf1[2][2];
      lds_frags2(stage, qf, r, h, st0, st1, vf0, vf1);
      band_step64(st0, st1, vf0, vf1, sbias, b0, k0 + 31 - q0w, k0 - q0w - r, h, o0, o1, m, l);
    }
    if (t == t_lo) break;
    kv_store(sm + (cur ^ 1) * AT_STAGE, gA, tid);
    if (qblk >= 6 && t - 1 >= qblk * 4) kv_out(gA, fk, fv, (t - 1) * 64 - 1536, tid);
    __syncthreads();
    gA = gB;
    cur ^= 1;
  }
  l += __shfl_xor(l, 32);
  attn_store(o0, o1, 1.0f / l, Gp + (size_t)(32 * wave) * 1024, Mp + (size_t)(32 * wave) * 1024, r, h);
}

constexpr int N_UNITS = 32 + 1024 + 1024;

DI void phase2(const Params& p, int layer, const u16* Gbuf, u16* MIX, u16* sm, int cslot = 0) {
  unsigned char* ws = p.ws;
  int* ctr = (int*)(ws + OFF_CTR) + layer + cslot;
  int* s_unit = (int*)((unsigned char*)sm + AT_BIAS_OFF + 257 * 4 + 12);
  for (;;) {
    __syncthreads();
    if (threadIdx.x == 0) *s_unit = atomicAdd(ctr, 1);
    __syncthreads();
    const int u = *s_unit;
    if (u >= N_UNITS) break;
    if (u < 32) {
      const int wave = tid_opaque() >> 6;
      const int item = u * 8 + wave;
      if (item < 128) {
        const int bh = item, b = bh >> 3, hd = bh & 7;
        const size_t row0 = (size_t)MP + b * 32;
        sb_item((const u16*)(ws + OFF_QBS) + (size_t)bh * 32 * 64,
                (const u16*)(ws + OFF_KBS) + ((size_t)layer * 128 + bh) * 1056 * 64,
                (const u16*)(ws + OFF_VBST) + ((size_t)layer * 128 + bh) * 64 * 1056, 1056,
                1024, 33, Gbuf + row0 * 1024 + 512 + hd * 64, MIX + row0 * 1024 + 512 + hd * 64);
      } else {
        const int bh = item - 128, b = bh >> 3, hd = bh & 7;
        const size_t row0 = (size_t)MP + b * 32;
        band_item((const u16*)(ws + OFF_QAS) + (size_t)bh * 32 * 64,
                  (const u16*)(ws + OFF_KAS) + ((size_t)layer * 128 + bh) * 544 * 64,
                  (const u16*)(ws + OFF_VAST) + ((size_t)layer * 128 + bh) * 64 * 544, 544,
                  0, 17, -512, p.relb + (size_t)(layer * 8 + hd) * 257,
                  Gbuf + row0 * 1024 + hd * 64, MIX + row0 * 1024 + hd * 64);
      }
    } else if (u < 32 + 1024) {
      const int j = u - 32, bh = j >> 3, qblk = 7 - (j & 7), b = bh >> 3, hd = bh & 7;
      const size_t row0 = (size_t)b * 2048 + qblk * 256;
      sbp_unit((const u16*)(ws + OFF_QB) + (size_t)bh * 2048 * 64, (const u16*)(ws + OFF_KB) + (size_t)bh * 2048 * 64,
               (const u16*)(ws + OFF_VBT) + (size_t)bh * 64 * 2048, qblk,
               Gbuf + row0 * 1024 + 512 + hd * 64, MIX + row0 * 1024 + 512 + hd * 64, sm,
               p.out + O_BKP + ((size_t)(layer * 16 + b) * 2048) * 512 + hd * 64, p.out + O_BVP + ((size_t)(layer * 16 + b) * 2048) * 512 + hd * 64);
    } else {
      const int j = u - 32 - 1024, bh = j & 127, qblk = 7 - (j >> 7), b = bh >> 3, hd = bh & 7;
      const size_t row0 = (size_t)b * 2048 + qblk * 256;
      bp_unit((const u16*)(ws + OFF_QA) + (size_t)bh * 2048 * 64, (const u16*)(ws + OFF_KA) + (size_t)bh * 2048 * 64,
              (const u16*)(ws + OFF_VAT) + (size_t)bh * 64 * 2048, qblk, p.relb + (size_t)(layer * 8 + hd) * 257,
              Gbuf + row0 * 1024 + hd * 64, MIX + row0 * 1024 + hd * 64, sm,
              p.out + O_AKP + ((size_t)(layer * 16 + b) * 512) * 512 + hd * 64, p.out + O_AVP + ((size_t)(layer * 16 + b) * 512) * 512 + hd * 64);
    }
  }
}

DI void phase4(const Params& p, int layer, const u16* Y, u16* H1B) {
  const int tid = tid_opaque(), lane = tid & 63;
  const int gw = (blockIdx.x * NTHR + tid) >> 6, nw = (gridDim.x * NTHR) >> 6;
  const float* gp = p.gpost + layer * 1024;
  for (int row = gw; row < MT; row += nw) {
    const u16* yr = Y + (size_t)row * 1024;
    float yf[16];
    float ss = 0.f;
#pragma unroll
    for (int j = 0; j < 2; ++j) {
      const uint4 u = *(const uint4*)(yr + 8 * lane + 512 * j);
      yf[8 * j + 0] = bflo(u.x); yf[8 * j + 1] = bfhi(u.x); yf[8 * j + 2] = bflo(u.y); yf[8 * j + 3] = bfhi(u.y);
      yf[8 * j + 4] = bflo(u.z); yf[8 * j + 5] = bfhi(u.z); yf[8 * j + 6] = bflo(u.w); yf[8 * j + 7] = bfhi(u.w);
    }
#pragma unroll
    for (int i = 0; i < 16; ++i) ss += yf[i] * yf[i];
#pragma unroll
    for (int m = 32; m >= 1; m >>= 1) ss += __shfl_xor(ss, m);
    const float rs = rsqrtf(ss * (1.0f / 1024.0f) + EPS);
    const float* hs;
    if (layer == 0) hs = row < MP ? p.xp + (size_t)row * 1024 : p.xs + (size_t)(row - MP) * 1024;
    else hs = p.out + (size_t)row * 1024;
#pragma unroll
    for (int j = 0; j < 2; ++j) {
      const int c = 8 * lane + 512 * j;
      const float4 a = *(const float4*)(hs + c), b = *(const float4*)(hs + c + 4);
      const float4 ga = *(const float4*)(gp + c), gb = *(const float4*)(gp + c + 4);
      float4 oa, ob;
      oa.x = a.x + yf[8 * j + 0] * rs * ga.x; oa.y = a.y + yf[8 * j + 1] * rs * ga.y;
      oa.z = a.z + yf[8 * j + 2] * rs * ga.z; oa.w = a.w + yf[8 * j + 3] * rs * ga.w;
      ob.x = b.x + yf[8 * j + 4] * rs * gb.x; ob.y = b.y + yf[8 * j + 5] * rs * gb.y;
      ob.z = b.z + yf[8 * j + 6] * rs * gb.z; ob.w = b.w + yf[8 * j + 7] * rs * gb.w;
      uint4 o;
      o.x = pack2(oa.x, oa.y); o.y = pack2(oa.z, oa.w); o.z = pack2(ob.x, ob.y); o.w = pack2(ob.z, ob.w);
      *(uint4*)(H1B + (size_t)row * 1024 + c) = o;
    }
  }
}

DI void p5_tile(const Params& p, int layer, int mt, int nt, int ks0, u16* sA, u16* sB, const u16* H1B, u16* HBN) {
  const int m0 = mt * 256, n0 = nt * 128;
  unsigned char* ws = p.ws;
  f32x16 acc[4][1];
  gemm_mainloop<1>((const u16*)(ws + OFF_PB) + ((size_t)layer * MT + m0) * 256, 256,
                   (const u16*)(ws + OFF_WPLE) + ((size_t)layer * 1024 + n0) * 256, 256, 256, ks0, sA, sB, acc);
  unsigned pl[4][8];
#pragma unroll
  for (int rb = 0; rb < 4; ++rb)
#pragma unroll
    for (int j = 0; j < 8; ++j) pl[rb][j] = pack2(acc[rb][0][2 * j], acc[rb][0][2 * j + 1]);
  gemm_mainloop<1>(H1B + (size_t)m0 * 1024, 1024, (const u16*)(ws + OFF_WGATE) + ((size_t)layer * 1024 + n0) * 1024, 1024, 1024, ks0, sA, sB, acc);
  int tl = tid_opaque();
  const int lane = tl & 63, wave = tl >> 6, wm = wave >> 2, wn = wave & 3, r = lane & 31, h = lane >> 5;
  const int col = n0 + 32 * wn + r;
  __syncthreads();
  float* st = (float*)sA + wave * (32 * 36);
#pragma unroll 1
  for (int rb = 0; rb < 4; ++rb) {
    const int row0 = m0 + 128 * wm + 32 * rb;
#pragma unroll
    for (int i = 0; i < 16; ++i) {
      const int t = crow(i, h);
      float* hp = p.out + (size_t)(row0 + t) * 1024 + col;
      const float h1 = *hp;
      const unsigned plw = rb == 0 ? pl[0][i >> 1] : rb == 1 ? pl[1][i >> 1] : rb == 2 ? pl[2][i >> 1] : pl[3][i >> 1];
      const float pv = (i & 1) ? bfhi(plw) : bflo(plw);
      const float a = rb == 0 ? acc[0][0][i] : rb == 1 ? acc[1][0][i] : rb == 2 ? acc[2][0][i] : acc[3][0][i];
      const float g = 1.0f / (1.0f + __expf(-a));
      const float h2 = h1 + g * pv;
      *hp = h2;
      st[t * 36 + r] = h2;
    }
    if (layer == 0) {
#pragma unroll
      for (int j = 0; j < 4; ++j) {
        const int c = lane + 64 * j, t = c >> 3, c4 = (c & 7) * 4;
        const float4 x = *(const float4*)(st + t * 36 + c4);
        uint2 o; o.x = pack2(x.x, x.y); o.y = pack2(x.z, x.w);
        *(uint2*)(HBN + (size_t)(row0 + t) * 1024 + n0 + 32 * wn + c4) = o;
        float ss = x.x * x.x + x.y * x.y + x.z * x.z + x.w * x.w;
        ss += __shfl_xor(ss, 1); ss += __shfl_xor(ss, 2); ss += __shfl_xor(ss, 4);
        if ((c & 7) == 0) ((float*)(ws + OFF_PSUM))[(size_t)(row0 + t) * 32 + nt * 4 + wn] = ss;
      }
    }
  }
}

__global__ void __launch_bounds__(NTHR, 2) mega(Params p, int ph_begin, int ph_end) {
  extern __shared__ __attribute__((aligned(16))) unsigned char smem[];
  u16* sA = (u16*)smem;
  PG8_LAS unsigned char* lds3 = (PG8_LAS unsigned char*)smem;
  u16* sB = sA + 256 * LDT;
  float* rstd_s = (float*)(smem + 2 * (2 * 256 * LDT * 2));
  unsigned char* ws = p.ws;
  __shared__ uint4 xb_words;
  if (threadIdx.x == 0) xb_words = make_uint4(0u, 0u, 0u, 0u);
  __syncthreads();
  XcdBarrier xb = xcd_barrier_post((unsigned*)(ws + OFF_BAR), (volatile LAS unsigned*)&xb_words);
  if (ph_end < 0) cg::this_grid().sync();
  int xx = blockIdx.x & 7, xi = blockIdx.x >> 3;
  int ks0 = (xi & 7) + (xi >> 3);
#define PHASE_GATE(PH) if ((PH) >= ph_begin && (PH) < ph_end) { if ((PH) > ph_begin) xcd_barrier(xb);
  PHASE_GATE(0) phase0(p, (float*)smem); }
#if PROBE_DUP == 10
  phase0(p, (float*)smem);
#endif
#pragma unroll 1
  for (int layer = 0; layer < 2; ++layer) {
    asm volatile("" : "+s"(layer));
    u16* RA = (u16*)(ws + ((layer & 1) ? OFF_R1 : OFF_R0));
    u16* RB = (u16*)(ws + ((layer & 1) ? OFF_R0 : OFF_R1));
    const int pb = 1 + 5 * layer;
    if (layer > 0 && (pb + 0) >= ph_begin && (pb + 0) < ph_end) {
      xcd_barrier(xb);
      const float* ps = (const float*)(ws + OFF_PSUM);
      float* rg = (float*)(ws + OFF_RSTD);
      for (int row = blockIdx.x * NTHR + tid_opaque(); row < MT; row += gridDim.x * NTHR) {
        const float4* q4 = (const float4*)(ps + (size_t)row * 32);
        float sm = 0.f;
#pragma unroll
        for (int j = 0; j < 4; ++j) { const float4 v = q4[j]; sm += v.x + v.y + v.z + v.w; }
        rg[row] = rsqrtf(sm * (1.0f / 1024.0f) + EPS);
      }
    }
    PHASE_GATE(pb + 0)
      pg8::StaticOrder S; S.init(MT, 4096, (int)gridDim.x, (int)blockIdx.x);
      pg8::Gemm g; g.A = RA; g.Bt = (const u16*)(ws + OFF_WIN) + (size_t)layer * 4096 * 1024; g.M = MT; g.N = 4096; g.K = 1024;
      EpiP1 E; E.pp = &p; E.layer = layer; E.Gbuf = RB;
      pg8::gemm_phase(lds3, g, S, E);
      if (blockIdx.x >= 32) cache_convert(p, layer, (int)blockIdx.x - 32, (int)gridDim.x - 32, (float*)smem);
#if PROBE_DUP == 8
      xcd_barrier(xb);
      pg8::gemm_phase(lds3, g, S, E);
#endif
    }
    PHASE_GATE(pb + 1) phase2(p, layer, RB, RA, sA); }
#if PROBE_DUP == 2
    xcd_barrier(xb); phase2(p, layer, RB, RA, sA, 2);
#endif

    PHASE_GATE(pb + 2)
      pg8::StaticOrder S; S.init(MT, 1024, (int)gridDim.x, (int)blockIdx.x);
      pg8::Gemm g; g.A = RA; g.Bt = (const u16*)(ws + OFF_WOUT) + (size_t)layer * 1024 * 1024; g.M = MT; g.N = 1024; g.K = 1024;
      EpiP3 E; E.Y = RB;
      pg8::gemm_phase(lds3, g, S, E);
      pg8::Gemm g2; g2.A = (const u16*)(ws + OFF_PB) + (size_t)layer * MT * 256; g2.Bt = (const u16*)(ws + OFF_WPLE) + (size_t)layer * 1024 * 256;
      g2.M = MT; g2.N = 1024; g2.K = 256;
      EpiP3 E2; E2.Y = (u16*)(ws + OFF_QA);
      if (blockIdx.x >= 8) {
        pg8::StaticOrder S2; S2.init(MT, 1024, (int)gridDim.x - 8, (int)blockIdx.x - 8);
        pg8::gemm_phase(lds3, g2, S2, E2);
      }
    }
    PHASE_GATE(pb + 3) phase4(p, layer, RB, RA); }
#if PROBE_DUP == 5
    if (layer == 0) { xcd_barrier(xb); phase4(p, layer, RB, RA); xcd_barrier(xb); phase4(p, layer, RB, RA); }
#endif
    PHASE_GATE(pb + 4)
      pg8::StaticOrder S; S.init(MT, 1024, (int)gridDim.x, (int)blockIdx.x);
      pg8::Gemm g; g.A = RA; g.Bt = (const u16*)(ws + OFF_WGATE) + (size_t)layer * 1024 * 1024; g.M = MT; g.N = 1024; g.K = 1024;
      EpiP5 E; E.out = p.out; E.PLE = (const u16*)(ws + OFF_QA); E.H1B = RA; E.HBN = RB; E.psum = (float*)(ws + OFF_PSUM); E.layer = layer;
      pg8::gemm_phase(lds3, g, S, E);
    }
  }
}

extern "C" void kernel_launch(void* const* d_in, const int* in_sizes, int n_in, void* d_out, int out_size,
                              void* d_ws, size_t ws_size, hipStream_t stream) {
  Params p{};
  p.xp = (const float*)d_in[0]; p.xs = (const float*)d_in[1]; p.pp = (const float*)d_in[2]; p.ps = (const float*)d_in[3];
  p.cak = (const float*)d_in[4]; p.cav = (const float*)d_in[5]; p.cbk = (const float*)d_in[6]; p.cbv = (const float*)d_in[7];
  p.gpre = (const float*)d_in[8]; p.win = (const float*)d_in[9]; p.relb = (const float*)d_in[10]; p.wout = (const float*)d_in[11];
  p.gpost = (const float*)d_in[12]; p.wple = (const float*)d_in[13]; p.wgate = (const float*)d_in[14];
  p.out = (float*)d_out;
  p.ws = (unsigned char*)d_ws;
  static int grid_blocks = 0;
  if (!grid_blocks) {
    int dev = 0, cus = 0, per_cu = 0;
    (void)hipGetDevice(&dev);
    (void)hipDeviceGetAttribute(&cus, hipDeviceAttributeMultiprocessorCount, dev);
    if (hipFuncSetAttribute((const void*)mega, hipFuncAttributeMaxDynamicSharedMemorySize, SMEM_BYTES) != hipSuccess)
      fprintf(stderr, "hipFuncSetAttribute(MaxDynamicSharedMemorySize=%d) failed\n", SMEM_BYTES);
    (void)hipOccupancyMaxActiveBlocksPerMultiprocessor(&per_cu, mega, NTHR, SMEM_BYTES);
    if (per_cu < 1) per_cu = 1;
    if (per_cu > 1) per_cu = 1;
    grid_blocks = 256;
    if (cus * per_cu < 256) fprintf(stderr, "device too small for a 256-workgroup cooperative grid\n");
  }
#if MK_COOP
  hipMemsetAsync((unsigned char*)d_ws + OFF_BAR, 0, (size_t)XCD_BAR_WORDS * 4, stream);
  int pb = 0, pe = 11;
  void* args[] = {&p, &pb, &pe};
  hipError_t e = hipLaunchCooperativeKernel((void*)mega, dim3(grid_blocks), dim3(NTHR), args, SMEM_BYTES, stream);
  if (e != hipSuccess) fprintf(stderr, "cooperative launch failed: %s (grid %d)\n", hipGetErrorString(e), grid_blocks);
#else
  for (int ph = 0; ph < 11; ++ph) mega<<<dim3(grid_blocks), dim3(NTHR), SMEM_BYTES, stream>>>(p, ph, ph + 1);
#endif
}
```

```cpp
#include <hip/hip_runtime.h>
#include <hip/hip_cooperative_groups.h>
#include <stdint.h>
#include <stdio.h>
namespace cg = cooperative_groups;

#ifndef PROBE_DUP
#define PROBE_DUP 0
#endif
#ifndef SKEW_P1
#define SKEW_P1 0
#define SKEW_P3 0
#define SKEW_P5 0
#endif
#ifndef MK_COOP
#define MK_COOP 1
#endif

typedef __attribute__((ext_vector_type(8))) short bf16x8;
typedef __attribute__((ext_vector_type(4))) short bf16x4;
typedef __attribute__((ext_vector_type(16))) float f32x16;
typedef __attribute__((ext_vector_type(4))) float f32x4;
typedef __attribute__((ext_vector_type(2))) __bf16 bf2_t;
typedef __attribute__((ext_vector_type(2))) float f2_t;
typedef unsigned short u16;
typedef __attribute__((ext_vector_type(4))) unsigned u32x4;

#define DI __device__ __forceinline__
#define MFMA32(a, b, c) __builtin_amdgcn_mfma_f32_32x32x16_bf16((a), (b), (c), 0, 0, 0)

DI unsigned pack2(float a, float b) { f2_t v = {a, b}; bf2_t r = __builtin_convertvector(v, bf2_t); return __builtin_bit_cast(unsigned, r); }
DI u16 f2bf(float a) { return (u16)(pack2(a, 0.f) & 0xffffu); }
DI float bflo(unsigned u) { return __uint_as_float(u << 16); }
DI float bfhi(unsigned u) { return __uint_as_float(u & 0xffff0000u); }
DI int crow(int i, int h) { return (i & 3) + 8 * (i >> 2) + 4 * h; }
typedef __attribute__((ext_vector_type(2))) unsigned u32x2;
typedef __attribute__((ext_vector_type(4))) float f32x4v;
DI void st_nt8(void* p, unsigned a, unsigned b) { u32x2 v = {a, b}; __builtin_nontemporal_store(v, (u32x2*)p); }
DI void st_nt16f(float* p, float4 x) { f32x4v v = {x.x, x.y, x.z, x.w}; __builtin_nontemporal_store(v, (f32x4v*)p); }
DI void st_nt16u(void* p, u32x4 v) { __builtin_nontemporal_store(v, (u32x4*)p); }
DI int tid_opaque() { int t = threadIdx.x; asm volatile("" : "+v"(t)); return t; }

struct Params {
  const float *xp, *xs, *pp, *ps, *cak, *cav, *cbk, *cbv, *gpre, *win, *relb, *wout, *gpost, *wple, *wgate;
  float* out;
  unsigned char* ws;
};

constexpr int MP = 32768, MS = 512, MT = 33280;
constexpr float EPS = 1e-6f;
constexpr float QSCALE = 0.125f * 1.4426950408889634f;

#define XCD_BAR_WORDS 3456
constexpr size_t SZ_ACT = (size_t)MT * 1024 * 2;
constexpr size_t SZ_QKV = (size_t)16 * 8 * 2048 * 64 * 2;
constexpr size_t OFF_WIN = 0;
constexpr size_t OFF_WOUT = OFF_WIN + (size_t)2 * 4096 * 1024 * 2;
constexpr size_t OFF_WGATE = OFF_WOUT + (size_t)2 * 1024 * 1024 * 2;
constexpr size_t OFF_WPLE = OFF_WGATE + (size_t)2 * 1024 * 1024 * 2;
constexpr size_t OFF_R0 = OFF_WPLE + (size_t)2 * 1024 * 256 * 2;
constexpr size_t OFF_R1 = OFF_R0 + SZ_ACT;
constexpr size_t OFF_PB = OFF_R1 + SZ_ACT;
constexpr size_t OFF_PSUM = OFF_PB + (size_t)2 * MT * 256 * 2;
constexpr size_t OFF_QA = OFF_PSUM + (size_t)MT * 32 * 4;
constexpr size_t OFF_KA = OFF_QA + SZ_QKV;
constexpr size_t OFF_VAT = OFF_KA + SZ_QKV;
constexpr size_t OFF_QB = OFF_VAT + SZ_QKV;
constexpr size_t OFF_KB = OFF_QB + SZ_QKV;
constexpr size_t OFF_VBT = OFF_KB + SZ_QKV;
constexpr size_t OFF_QAS = OFF_VBT + SZ_QKV;
constexpr size_t OFF_QBS = OFF_QAS + (size_t)128 * 32 * 64 * 2;
constexpr size_t OFF_KAS = OFF_QBS + (size_t)128 * 32 * 64 * 2;
constexpr size_t OFF_VAST = OFF_KAS + (size_t)2 * 128 * 544 * 64 * 2;
constexpr size_t OFF_KBS = OFF_VAST + (size_t)2 * 128 * 544 * 64 * 2;
constexpr size_t OFF_VBST = OFF_KBS + (size_t)2 * 128 * 1056 * 64 * 2;
constexpr size_t OFF_CTR = OFF_VBST + (size_t)2 * 128 * 1056 * 64 * 2;
constexpr size_t OFF_BAR = OFF_CTR + 256;
constexpr size_t OFF_RSTD = OFF_BAR + (size_t)XCD_BAR_WORDS * 4;
constexpr size_t WS_TOTAL = OFF_RSTD + (size_t)MT * 4;
static_assert(WS_TOTAL <= (size_t)536870912, "workspace too large");
static_assert(OFF_QB - OFF_QA >= SZ_ACT, "ple product must fit in the q/k/v region of head group A");

constexpr size_t O_AKP = 34078720;
constexpr size_t O_AVP = O_AKP + 8388608;
constexpr size_t O_BKP = O_AVP + 8388608;
constexpr size_t O_BVP = O_BKP + 33554432;
constexpr size_t O_AKS = O_BVP + 33554432;
constexpr size_t O_AVS = O_AKS + 524288;
constexpr size_t O_BKS = O_AVS + 524288;
constexpr size_t O_BVS = O_BKS + 524288;


#define XB_TMO      128
#define XB_XCNT(j)  (256  + 64 * (j))
#define XB_XSUB(j)  (1280 + 64 * (j))
#define XB_XGEN(j)  (2304 + 64 * (j))
#define XB_TOP      3328
#define XB_TOPGEN   3392
#define XB_SPIN_CAP (1u << 22)
#define LAS __attribute__((address_space(3)))
DI unsigned xb_ld(unsigned* p) { return __hip_atomic_load(p, __ATOMIC_RELAXED, __HIP_MEMORY_SCOPE_AGENT); }
DI unsigned xb_add(unsigned* p, unsigned v) { return __hip_atomic_fetch_add(p, v, __ATOMIC_RELAXED, __HIP_MEMORY_SCOPE_AGENT); }
DI unsigned xb_xcc_id() { return (unsigned)__builtin_amdgcn_s_getreg((3 << 11) | 20) & 0xFu; }
#define XB_SPIN(cond, bar) do { unsigned _sp = 0; while (cond) { __builtin_amdgcn_s_sleep(1); \
    if ((++_sp & 255u) == 0u) { if (xb_ld(&(bar)[XB_TMO])) break; if (_sp > XB_SPIN_CAP) { atomicAdd(&(bar)[XB_TMO], 1u); break; } } } } while (0)
struct XcdBarrier { unsigned* bar; unsigned x; volatile LAS unsigned* st; };
DI XcdBarrier xcd_barrier_post(unsigned* bar, volatile LAS unsigned* st) {
  XcdBarrier b; b.bar = bar; b.x = xb_xcc_id(); b.st = st;
  if (threadIdx.x == 0) { st[2] = xb_add(&bar[XB_XCNT(b.x)], 1u); st[3] = b.x; }
  return b;
}
DI void xcd_barrier_complete(unsigned* bar, unsigned x, unsigned& nloc, unsigned& nx) {
  const unsigned G = gridDim.x * gridDim.y * gridDim.z;
  unsigned sum, cnt, mine, sp = 0u;
  for (;;) {
    sum = 0u; cnt = 0u; mine = 0u;
#pragma unroll
    for (unsigned j = 0; j < 16; ++j) { const unsigned c = xb_ld(&bar[XB_XCNT(j)]); sum += c; cnt += (c > 0u) ? 1u : 0u; mine = (j == x) ? c : mine; }
    if (sum == G) break;
    __builtin_amdgcn_s_sleep(1);
    if ((++sp & 255u) == 0u) { if (xb_ld(&bar[XB_TMO])) break; if (sp > XB_SPIN_CAP) { atomicAdd(&bar[XB_TMO], 1u); break; } }
  }
  nloc = mine > 0u ? mine : 1u; nx = cnt > 0u ? cnt : 1u;
}
DI void xcd_barrier(const XcdBarrier& b) {
  asm volatile("s_waitcnt vmcnt(0)" ::: "memory");
  __syncthreads();
  if (threadIdx.x == 0) {
    unsigned* bar = b.bar;
    __builtin_amdgcn_s_waitcnt(0);
    unsigned nloc = b.st[0], nx = b.st[1];
    if (nloc == 0u) { xcd_barrier_complete(bar, b.x, nloc, nx); b.st[0] = nloc; b.st[1] = nx; }
    const unsigned old = xb_add(&bar[XB_XSUB(b.x)], 1u);
    const unsigned gen = old / nloc;
    if (old + 1u == (gen + 1u) * nloc) {
      __builtin_amdgcn_fence(__ATOMIC_RELEASE, "agent");
      asm volatile("s_waitcnt vmcnt(0)" ::: "memory");
      const unsigned og = xb_add(&bar[XB_TOP], 1u);
      const unsigned tg = og / nx;
      if (og + 1u == (tg + 1u) * nx) xb_add(&bar[XB_TOPGEN], 1u);
      else XB_SPIN(xb_ld(&bar[XB_TOPGEN]) == tg, bar);
      __builtin_amdgcn_fence(__ATOMIC_ACQUIRE, "agent");
      xb_add(&bar[XB_XGEN(b.x)], 1u);
      asm volatile("s_waitcnt vmcnt(0)" ::: "memory");
    } else {
      XB_SPIN(xb_ld(&bar[XB_XGEN(b.x)]) == gen, bar);
      __builtin_amdgcn_fence(__ATOMIC_ACQUIRE, "agent");
      asm volatile("s_waitcnt vmcnt(0)" ::: "memory");
    }
  }
  __syncthreads();
}

DI void delay_ticks(unsigned ticks) {
  const unsigned long long t0 = __builtin_amdgcn_s_memrealtime();
  while (__builtin_amdgcn_s_memrealtime() - t0 < (unsigned long long)ticks) __builtin_amdgcn_s_sleep(8);
}

constexpr int BK = 64, LDT = BK + 8;
constexpr int NTHR = 512;
constexpr int SMEM_BYTES = 2 * (2 * 256 * LDT * 2) + 1024;

template <int NCB>
DI void gemm_mainloop(const u16* __restrict__ A, int lda, const u16* __restrict__ Bt, int ldb, int K, int ks0,
                      u16* sA, u16* sB, f32x16 (&acc)[4][NCB]) {
  const int kmask = K - 1;
  const int tid = tid_opaque(), lane = tid & 63, wave = tid >> 6, wm = wave >> 2, wn = wave & 3, r = lane & 31, h = lane >> 5;
  const int lrow = tid >> 3, lcol = (tid & 7) * 8;
  constexpr int NB = 2 * NCB;
  const u16* gA = A + (size_t)lrow * lda + lcol;
  const u16* gB = Bt + (size_t)lrow * ldb + lcol;
  u32x4 ra0[4], rb0[NB], ra1[4], rb1[NB];
  const int kf0 = (ks0 * BK) & kmask, kf1 = ((ks0 + 1) * BK) & kmask, kf2 = ((ks0 + 2) * BK) & kmask;
#pragma unroll
  for (int i = 0; i < 4; ++i) ra0[i] = *(const u32x4*)(gA + kf0 + (size_t)(64 * i) * lda);
#pragma unroll
  for (int i = 0; i < NB; ++i) rb0[i] = *(const u32x4*)(gB + kf0 + (size_t)(64 * i) * ldb);
  asm volatile("" ::: "memory");
#pragma unroll
  for (int i = 0; i < 4; ++i) ra1[i] = *(const u32x4*)(gA + kf1 + (size_t)(64 * i) * lda);
#pragma unroll
  for (int i = 0; i < NB; ++i) rb1[i] = *(const u32x4*)(gB + kf1 + (size_t)(64 * i) * ldb);
#pragma unroll
  for (int a = 0; a < 4; ++a)
#pragma unroll
    for (int b = 0; b < NCB; ++b)
#pragma unroll
      for (int i = 0; i < 16; ++i) acc[a][b][i] = 0.f;
  constexpr int STG = 2 * 256 * LDT;
  const u16* rA = sA + (128 * wm + r) * LDT + 8 * h;
  const u16* rB = sB + (32 * NCB * wn + r) * LDT + 8 * h;
  u16* wA = sA + lrow * LDT + lcol;
  u16* wB = sB + lrow * LDT + lcol;
  __syncthreads();
#pragma unroll
  for (int i = 0; i < 4; ++i) *(u32x4*)(wA + 64 * i * LDT) = ra0[i];
#pragma unroll
  for (int i = 0; i < NB; ++i) *(u32x4*)(wB + 64 * i * LDT) = rb0[i];
#pragma unroll
  for (int i = 0; i < 4; ++i) ra0[i] = *(const u32x4*)(gA + kf2 + (size_t)(64 * i) * lda);
#pragma unroll
  for (int i = 0; i < NB; ++i) rb0[i] = *(const u32x4*)(gB + kf2 + (size_t)(64 * i) * ldb);
  __syncthreads();
#define GEMM_STEP(RA_, RB_, WS_, RS_, KNEXT)                                                    \
  {                                                                                             \
    _Pragma("unroll") for (int i = 0; i < 4; ++i) *(u32x4*)(wA + (WS_) * STG + 64 * i * LDT) = RA_[i];  \
    _Pragma("unroll") for (int i = 0; i < NB; ++i) *(u32x4*)(wB + (WS_) * STG + 64 * i * LDT) = RB_[i]; \
    {                                                                                           \
      const int kn = (KNEXT) & kmask;     \
      _Pragma("unroll") for (int i = 0; i < 4; ++i) RA_[i] = *(const u32x4*)(gA + kn + (size_t)(64 * i) * lda);  \
      _Pragma("unroll") for (int i = 0; i < NB; ++i) RB_[i] = *(const u32x4*)(gB + kn + (size_t)(64 * i) * ldb); \
    }                                                                                           \
    _Pragma("unroll") for (int ks = 0; ks < 4; ++ks) {                                          \
      bf16x8 af[4], bf[NCB];                                                                    \
      _Pragma("unroll") for (int a = 0; a < 4; ++a) af[a] = *(const bf16x8*)(rA + (RS_) * STG + 32 * a * LDT + 16 * ks);   \
      _Pragma("unroll") for (int b = 0; b < NCB; ++b) bf[b] = *(const bf16x8*)(rB + (RS_) * STG + 32 * b * LDT + 16 * ks); \
      _Pragma("unroll") for (int a = 0; a < 4; ++a)                                             \
        _Pragma("unroll") for (int b = 0; b < NCB; ++b) acc[a][b] = MFMA32(af[a], bf[b], acc[a][b]);         \
    }                                                                                           \
    __syncthreads();                                                                            \
  }
  for (int k0 = 0; k0 < K; k0 += 2 * BK) {
    GEMM_STEP(ra1, rb1, 1, 0, ks0 * BK + k0 + 3 * BK)
    GEMM_STEP(ra0, rb0, 0, 1, ks0 * BK + k0 + 4 * BK)
  }
#undef GEMM_STEP
}

template <class Desc>
DI void transpose_stream(int j0, int jend, int jstride, const Desc& D, float* sm) {
  const int tid = tid_opaque();
  const int nn = tid & 63, kq = tid >> 6;
  const int kp = (tid & 31) * 2, nq = tid >> 5;
  float v[8];
  const float* src = nullptr; const float* scale = nullptr; u16* dst = nullptr; int sld = 0, dld = 0;
  int j = j0;
  if (j < jend) {
    D(j, src, sld, dst, dld, scale);
#pragma unroll
    for (int i = 0; i < 8; ++i) { const int kk = kq + 8 * i; v[i] = src[(size_t)kk * sld + nn] * (scale ? scale[kk] : 1.0f); }
  }
  while (j < jend) {
    u16* cdst = dst; const int cdld = dld;
    float w[8];
#pragma unroll
    for (int i = 0; i < 8; ++i) w[i] = v[i];
    const int jn = j + jstride;
    if (jn < jend) {
      D(jn, src, sld, dst, dld, scale);
#pragma unroll
      for (int i = 0; i < 8; ++i) { const int kk = kq + 8 * i; v[i] = src[(size_t)kk * sld + nn] * (scale ? scale[kk] : 1.0f); }
    }
#pragma unroll
    for (int i = 0; i < 8; ++i) sm[(kq + 8 * i) * 65 + nn] = w[i];
    __syncthreads();
#pragma unroll
    for (int i = 0; i < 4; ++i) {
      const int n2 = nq + 16 * i;
      *(unsigned*)(cdst + (size_t)n2 * cdld + kp) = pack2(sm[kp * 65 + n2], sm[(kp + 1) * 65 + n2]);
    }
    __syncthreads();
    j = jn;
  }
}

DI uint4 cvt8(const float* __restrict__ s) {
  const float4 a = *(const float4*)s, b = *(const float4*)(s + 4);
  uint4 o;
  o.x = pack2(a.x, a.y); o.y = pack2(a.z, a.w); o.z = pack2(b.x, b.y); o.w = pack2(b.z, b.w);
  return o;
}

DI void cache_convert(const Params& p, int layer, int bid, int nb, float* sm) {
  const int tid = tid_opaque();
  unsigned char* ws = p.ws;
  auto D = [&](int j, const float*& src, int& sld, u16*& dst, int& dld, const float*& scale) {
    scale = nullptr; sld = 512;
    if (j < 1024) {
      const int lbh = layer * 128 + (j >> 3), kt = j & 7;
      const int lb = lbh >> 3, hd = lbh & 7;
      src = p.cav + ((size_t)lb * 512 + kt * 64) * 512 + hd * 64;
      dst = (u16*)(ws + OFF_VAST) + (size_t)lbh * 64 * 544 + kt * 64; dld = 544;
    } else {
      const int jj = j - 1024;
      const int lbh = layer * 128 + (jj >> 4), kt = jj & 15;
      const int lb = lbh >> 3, hd = lbh & 7;
      src = p.cbv + ((size_t)lb * 1024 + kt * 64) * 512 + hd * 64;
      dst = (u16*)(ws + OFF_VBST) + (size_t)lbh * 64 * 1056 + kt * 64; dld = 1056;
    }
  };
  transpose_stream(bid, 3072, nb, D, sm);
  const size_t gtid = (size_t)bid * NTHR + tid, gn = (size_t)nb * NTHR;
  for (size_t e0 = gtid; e0 < (size_t)524288; e0 += gn) {
    const size_t e = e0 + (size_t)layer * 524288;
    const int d8 = e & 7, hd = (e >> 3) & 7, s = (e >> 6) & 511, lb = (int)(e >> 15);
    *(uint4*)((u16*)(ws + OFF_KAS) + (((size_t)lb * 8 + hd) * 544 + s) * 64 + d8 * 8) = cvt8(p.cak + e * 8);
  }
  for (size_t e0 = gtid; e0 < (size_t)1048576; e0 += gn) {
    const size_t e = e0 + (size_t)layer * 1048576;
    const int d8 = e & 7, hd = (e >> 3) & 7, s = (e >> 6) & 1023, lb = (int)(e >> 16);
    *(uint4*)((u16*)(ws + OFF_KBS) + (((size_t)lb * 8 + hd) * 1056 + s) * 64 + d8 * 8) = cvt8(p.cbk + e * 8);
  }
}

DI void phase0(const Params& p, float* sm) {
  const int tid = tid_opaque();
  unsigned char* ws = p.ws;
  if (blockIdx.x == 0 && tid < 4) ((int*)(ws + OFF_CTR))[tid] = 0;
  auto D = [&](int j, const float*& src, int& sld, u16*& dst, int& dld, const float*& scale) {
    scale = nullptr;
    if (j < 2048) {
      const int l = j >> 10, kt = (j >> 6) & 15, nt = j & 63;
      src = p.win + ((size_t)l * 1024 + kt * 64) * 4096 + nt * 64; sld = 4096;
      dst = (u16*)(ws + OFF_WIN) + ((size_t)l * 4096 + nt * 64) * 1024 + kt * 64; dld = 1024;
      scale = p.gpre + l * 1024 + kt * 64;
    } else if (j < 3072) {
      const int jj = (j - 2048) & 511;
      const bool gate = j >= 2560;
      const int l = jj >> 8, kt = (jj >> 4) & 15, nt = jj & 15;
      src = (gate ? p.wgate : p.wout) + ((size_t)l * 1024 + kt * 64) * 1024 + nt * 64; sld = 1024;
      dst = (u16*)(ws + (gate ? OFF_WGATE : OFF_WOUT)) + ((size_t)l * 1024 + nt * 64) * 1024 + kt * 64; dld = 1024;
    } else {
      const int jj = j - 3072;
      const int l = jj >> 6, kt = (jj >> 4) & 3, nt = jj & 15;
      src = p.wple + ((size_t)l * 256 + kt * 64) * 1024 + nt * 64; sld = 1024;
      dst = (u16*)(ws + OFF_WPLE) + ((size_t)l * 1024 + nt * 64) * 256 + kt * 64; dld = 256;
    }
  };
  transpose_stream((int)blockIdx.x, 3200, (int)gridDim.x, D, sm);
  const size_t gtid = (size_t)blockIdx.x * NTHR + tid, gn = (size_t)gridDim.x * NTHR;
  for (size_t e = gtid; e < (size_t)2 * MT * 32; e += gn) {
    const int c8 = e & 31;
    const size_t lr = e >> 5;
    const int l = (int)(lr / MT), row = (int)(lr % MT);
    const float* src = row < MP ? p.pp + ((size_t)l * MP + row) * 256 : p.ps + ((size_t)l * MS + (row - MP)) * 256;
    *(uint4*)((u16*)(ws + OFF_PB) + lr * 256 + c8 * 8) = cvt8(src + c8 * 8);
  }
  const int lane = tid & 63;
  const int gw = (int)(gtid >> 6), nw = (int)(gn >> 6);
  for (int row = gw; row < MT; row += nw) {
    const float* src = row < MP ? p.xp + (size_t)row * 1024 : p.xs + (size_t)(row - MP) * 1024;
    u16* dst = (u16*)(ws + OFF_R0) + (size_t)row * 1024;
    float ss = 0.f;
#pragma unroll
    for (int j = 0; j < 2; ++j) {
      const int c = 8 * lane + 512 * j;
      const float4 a = *(const float4*)(src + c), b = *(const float4*)(src + c + 4);
      ss += a.x * a.x + a.y * a.y + a.z * a.z + a.w * a.w + b.x * b.x + b.y * b.y + b.z * b.z + b.w * b.w;
      uint4 o;
      o.x = pack2(a.x, a.y); o.y = pack2(a.z, a.w); o.z = pack2(b.x, b.y); o.w = pack2(b.z, b.w);
      *(uint4*)(dst + c) = o;
    }
#pragma unroll
    for (int m = 32; m >= 1; m >>= 1) ss += __shfl_xor(ss, m);
    if (lane == 0) ((float*)(ws + OFF_RSTD))[row] = rsqrtf(ss * (1.0f / 1024.0f) + EPS);
  }
}

DI float sigm(float x) { return __builtin_amdgcn_rcpf(1.0f + __builtin_amdgcn_exp2f(-1.4426950408889634f * x)); }

namespace pg8 {
#define PG8_LAS __attribute__((address_space(3)))
constexpr int BM = 256, BK = 64, HALF = 128, HTB = HALF * BK * 2, STAGE_BYTES = 8 * HTB, NXCD = 8, WGM = 8;
DI int lds_byte(int r, int c) { const int st = (r >> 4) * 2 + (c >> 5), rr = r & 15, cc = c & 31, ob = rr * 64 + cc * 2; return st * 1024 + (ob ^ (((ob >> 9) & 1) << 5)); }
DI void stage_rc(int b, int& R, int& C) { const int st = b / 1024, sb = b % 1024, swz = sb ^ (((sb >> 9) & 1) << 5); R = (st >> 1) * 16 + swz / 64; C = (st & 1) * 32 + (swz % 64) / 2; }
DI int perm32(int rho) { const int n = rho >> 4, i = rho & 15; return 8 * (i >> 2) + 4 * n + (i & 3); }
struct Unit { int pm, pn; };
struct Gemm { const u16* A; const u16* Bt; int M, N, K; };
struct StaticOrder {
  int nM, nN, nwg, G, c;
  DI void init(int M, int N, int G_, int c_) { nM = M / BM; nN = N / BM; nwg = nM * nN; G = G_; c = c_; }
  DI bool next(int i, Unit& u) const {
    const long L = (long)i * G + c; if (L >= nwg) return false;
    int wgid = (int)L; { const int q = nwg / NXCD, r = nwg % NXCD, xcd = wgid % NXCD, off = wgid / NXCD; wgid = (xcd < r ? xcd * (q + 1) : r * (q + 1) + (xcd - r) * q) + off; }
    const int nig = WGM * nN, gid = wgid / nig, fm = gid * WGM, gsz = (nM - fm) < WGM ? (nM - fm) : WGM;
    u.pm = fm + ((wgid % nig) % gsz); u.pn = (wgid % nig) / gsz; return true;
  }
};
template <class Epi>
DI void gemm_phase(PG8_LAS unsigned char* lds, const Gemm g, const StaticOrder& S, const Epi& E) {
  const int tid = threadIdx.x, wid = __builtin_amdgcn_readfirstlane(tid >> 6), lane = tid & 63, wr = wid >> 2, wc = wid & 3, fr = lane & 15, fq = lane >> 4;
  const int K = g.K, nt = K / BK;
  unsigned voffA[2], voffB[2];
#pragma unroll
  for (int i = 0; i < 2; ++i) { int R, C; stage_rc(tid * 16 + i * 8192, R, C); const int Rb = (R & ~31) + perm32(R & 31);
    voffA[i] = (unsigned)(R * K + C) * 2u; voffB[i] = (unsigned)(Rb * K + C) * 2u; }
  const size_t kstep = (size_t)(BK * 2);
  const size_t hstep = (size_t)HALF * K * 2;
  const size_t tstep = 2 * hstep;
  const unsigned ldsw = (unsigned)wid * 1024u;
  const int aoff = lds_byte(wr * 64 + fr, fq * 8), boff = lds_byte(wc * 32 + fr, fq * 8);
#define PG8_SA(b, h) (((b) * 2 + (h)) * HTB)
#define PG8_SB(b, h) ((4 + (b) * 2 + (h)) * HTB)
#define PG8_STAGE(bufoff, gbase, voff) do { _Pragma("unroll") for (int _i = 0; _i < 2; ++_i) \
    __builtin_amdgcn_global_load_lds((const unsigned*)((const char*)(gbase) + (voff)[_i]), (PG8_LAS unsigned*)(lds + (bufoff) + ldsw + _i * 8192), 16, 0, 0); } while (0)
#define PG8_LDA(dst, b, h) do { _Pragma("unroll") for (int m = 0; m < 4; ++m) _Pragma("unroll") for (int k = 0; k < 2; ++k) dst[m][k] = *(const PG8_LAS bf16x8*)(lds + PG8_SA(b, h) + aoff + m * 2048 + k * 1024); } while (0)
#define PG8_LDB(dst, b, h) do { _Pragma("unroll") for (int n = 0; n < 2; ++n) _Pragma("unroll") for (int k = 0; k < 2; ++k) dst[n][k] = *(const PG8_LAS bf16x8*)(lds + PG8_SB(b, h) + boff + n * 2048 + k * 1024); } while (0)
#define PG8_MMA(ai, bj, At, Bt) do { __builtin_amdgcn_s_setprio(1); _Pragma("unroll") for (int m = 0; m < 4; ++m) _Pragma("unroll") for (int n = 0; n < 2; ++n) _Pragma("unroll") for (int k = 0; k < 2; ++k) \
    acc[ai][bj][m][n] = __builtin_amdgcn_mfma_f32_16x16x32_bf16(Bt[n][k], At[m][k], acc[ai][bj][m][n], 0, 0, 0); __builtin_amdgcn_s_setprio(0); } while (0)
#define PG8_WAIT_V(n) asm volatile("s_waitcnt vmcnt(" #n ")" ::: "memory")
#define PG8_WAIT_L(n) asm volatile("s_waitcnt lgkmcnt(" #n ")" ::: "memory")
#define PG8_BAR __builtin_amdgcn_s_barrier()
#define PG8_SCHED __builtin_amdgcn_sched_barrier(0)
  Unit cur, nxt; int ui = 0;
  if (!S.next(0, cur)) return;
  f32x4 acc[2][2][4][2];
#pragma unroll
  for (int a = 0; a < 2; ++a)
#pragma unroll
    for (int b = 0; b < 2; ++b)
#pragma unroll
      for (int m = 0; m < 4; ++m)
#pragma unroll
        for (int n = 0; n < 2; ++n) acc[a][b][m][n] = (f32x4){0.f, 0.f, 0.f, 0.f};
  bf16x8 At[4][2], B0[2][2], B1[2][2];
  const char* cA = (const char*)g.A + (size_t)cur.pm * tstep; const char* cB = (const char*)g.Bt + (size_t)cur.pn * tstep;
  PG8_STAGE(PG8_SB(0, 0), cB, voffB); PG8_STAGE(PG8_SA(0, 0), cA, voffA); PG8_STAGE(PG8_SB(0, 1), cB + hstep, voffB); PG8_STAGE(PG8_SA(0, 1), cA + hstep, voffA);
  if (wr == 1) PG8_BAR;
  PG8_WAIT_V(4); PG8_BAR;
  PG8_STAGE(PG8_SB(1, 0), cB + kstep, voffB); PG8_STAGE(PG8_SA(1, 0), cA + kstep, voffA); PG8_STAGE(PG8_SB(1, 1), cB + hstep + kstep, voffB);
  PG8_WAIT_V(6); PG8_BAR;
  for (;;) {
    const bool has_next = S.next(ui + 1, nxt);
    const char* nA = has_next ? (const char*)g.A + (size_t)nxt.pm * tstep : cA; const char* nB = has_next ? (const char*)g.Bt + (size_t)nxt.pn * tstep : cB;
    for (int t = 0; t < nt; t += 2) {
      const bool last = (t == nt - 2);
      const char* a1 = cA + (size_t)(t + 1) * kstep;
      const char* a2 = last ? nA : cA + (size_t)(t + 2) * kstep; const char* b2 = last ? nB : cB + (size_t)(t + 2) * kstep;
      const char* a3 = a2 + kstep; const char* b3 = b2 + kstep;
      PG8_LDB(B0, 0, 0); PG8_SCHED; PG8_LDA(At, 0, 0); PG8_STAGE(PG8_SA(1, 1), a1 + hstep, voffA);
      PG8_WAIT_L(8); PG8_BAR; PG8_WAIT_L(0); PG8_MMA(0, 0, At, B0); PG8_BAR; PG8_SCHED;
      PG8_LDB(B1, 0, 1); PG8_STAGE(PG8_SB(0, 0), b2, voffB);
      PG8_BAR; PG8_WAIT_L(0); PG8_MMA(0, 1, At, B1); PG8_BAR;
      PG8_LDA(At, 0, 1); PG8_STAGE(PG8_SA(0, 0), a2, voffA);
      PG8_BAR; PG8_WAIT_L(0); PG8_MMA(1, 0, At, B0); PG8_BAR; PG8_SCHED;
      PG8_STAGE(PG8_SB(0, 1), b2 + hstep, voffB);
      PG8_WAIT_V(6); PG8_BAR; PG8_MMA(1, 1, At, B1); PG8_BAR;
      PG8_LDB(B0, 1, 0); PG8_SCHED; PG8_LDA(At, 1, 0); PG8_STAGE(PG8_SA(0, 1), a2 + hstep, voffA);
      PG8_WAIT_L(8); PG8_BAR; PG8_WAIT_L(0); PG8_MMA(0, 0, At, B0); PG8_BAR; PG8_SCHED;
      PG8_LDB(B1, 1, 1); PG8_STAGE(PG8_SB(1, 0), b3, voffB);
      PG8_BAR; PG8_WAIT_L(0); PG8_MMA(0, 1, At, B1); PG8_BAR;
      PG8_LDA(At, 1, 1); PG8_STAGE(PG8_SA(1, 0), a3, voffA);
      PG8_BAR; PG8_WAIT_L(0); PG8_MMA(1, 0, At, B0); PG8_BAR; PG8_SCHED;
      PG8_STAGE(PG8_SB(1, 1), b3 + hstep, voffB);
      PG8_WAIT_V(6); PG8_BAR; PG8_MMA(1, 1, At, B1); PG8_BAR;
    }
    E(acc, cur);
#if PROBE_DUP == 9
    E(acc, cur);
#endif
    if (!has_next) break;
#pragma unroll
    for (int a = 0; a < 2; ++a)
#pragma unroll
      for (int b = 0; b < 2; ++b)
#pragma unroll
        for (int m = 0; m < 4; ++m)
#pragma unroll
          for (int n = 0; n < 2; ++n) acc[a][b][m][n] = (f32x4){0.f, 0.f, 0.f, 0.f};
    cur = nxt; cA = nA; cB = nB; ++ui;
  }
  PG8_WAIT_V(0);
  if (wr == 0) PG8_BAR;
  PG8_BAR;
#undef PG8_SA
#undef PG8_SB
#undef PG8_STAGE
#undef PG8_LDA
#undef PG8_LDB
#undef PG8_MMA
#undef PG8_WAIT_V
#undef PG8_WAIT_L
#undef PG8_BAR
#undef PG8_SCHED
}
}

struct EpiP1 {
  const Params* pp; int layer; u16* Gbuf;
  DI void operator()(const f32x4 (&acc)[2][2][4][2], const pg8::Unit& u) const {
    const Params& p = *pp;
    const int tl = tid_opaque();
    const int lane = tl & 63, wid = tl >> 6, wr = wid >> 2, wc = wid & 3, fr = lane & 15, fq = lane >> 4;
    unsigned char* ws = p.ws;
    const float* rstd = (const float*)(ws + OFF_RSTD);
    const int seg = u.pn >> 1, kind = seg & 3, grp = seg >> 2;
    const bool prompt = u.pm < 128;
    const int d0 = (wc & 1) * 32 + 8 * fq;
#pragma unroll
    for (int am = 0; am < 8; ++am) {
      const int ai = am >> 2, m = am & 3;
      const int row = 256 * u.pm + 128 * ai + 64 * wr + 16 * m + fr;
      const float rs = rstd[row];
      int b, s;
      if (prompt) { b = row >> 11; s = row & 2047; } else { b = (row - MP) >> 5; s = (row - MP) & 31; }
      const int lb = layer * 16 + b;
#pragma unroll
      for (int bj = 0; bj < 2; ++bj) {
        const int hd = (u.pn & 1) * 4 + bj * 2 + (wc >> 1);
        const f32x4 v0 = acc[ai][bj][m][0] * rs, v1 = acc[ai][bj][m][1] * rs;
        if (kind == 3) {
          u32x4 o;
          o[0] = pack2(v0[0] * sigm(v0[0]), v0[1] * sigm(v0[1]));
          o[1] = pack2(v0[2] * sigm(v0[2]), v0[3] * sigm(v0[3]));
          o[2] = pack2(v1[0] * sigm(v1[0]), v1[1] * sigm(v1[1]));
          o[3] = pack2(v1[2] * sigm(v1[2]), v1[3] * sigm(v1[3]));
          st_nt16u(Gbuf + (size_t)row * 1024 + grp * 512 + hd * 64 + d0, o);
        } else if (kind == 0) {
          u32x4 o;
          o[0] = pack2(v0[0] * QSCALE, v0[1] * QSCALE); o[1] = pack2(v0[2] * QSCALE, v0[3] * QSCALE);
          o[2] = pack2(v1[0] * QSCALE, v1[1] * QSCALE); o[3] = pack2(v1[2] * QSCALE, v1[3] * QSCALE);
          u16* dst = prompt ? (u16*)(ws + (grp ? OFF_QB : OFF_QA)) + (((size_t)b * 8 + hd) * 2048 + s) * 64 + d0
                            : (u16*)(ws + (grp ? OFF_QBS : OFF_QAS)) + (((size_t)b * 8 + hd) * 32 + s) * 64 + d0;
          st_nt16u(dst, o);
        } else {
          float* fo = nullptr;
          if (!prompt) {
            if (grp == 0) fo = p.out + (kind == 1 ? O_AKS : O_AVS) + ((size_t)lb * 32 + s) * 512 + hd * 64 + d0;
            else fo = p.out + (kind == 1 ? O_BKS : O_BVS) + ((size_t)lb * 32 + s) * 512 + hd * 64 + d0;
          }
          if (fo) { __builtin_nontemporal_store(v0, (f32x4*)fo); __builtin_nontemporal_store(v1, (f32x4*)(fo + 4)); }
          u32x4 o;
          o[0] = pack2(v0[0], v0[1]); o[1] = pack2(v0[2], v0[3]); o[2] = pack2(v1[0], v1[1]); o[3] = pack2(v1[2], v1[3]);
          if (prompt) {
            const size_t off = kind == 1 ? (grp ? OFF_KB : OFF_KA) : (grp ? OFF_VBT : OFF_VAT);
            st_nt16u((u16*)(ws + off) + (((size_t)b * 8 + hd) * 2048 + s) * 64 + d0, o);
          } else if (kind == 1) {
            u16* dst = grp == 0 ? (u16*)(ws + OFF_KAS) + (((size_t)lb * 8 + hd) * 544 + 512 + s) * 64 + d0
                                : (u16*)(ws + OFF_KBS) + (((size_t)lb * 8 + hd) * 1056 + 1024 + s) * 64 + d0;
            st_nt16u(dst, o);
          } else {
            u16* vb; int ldv;
            if (grp == 0) { vb = (u16*)(ws + OFF_VAST) + (((size_t)lb * 8 + hd) * 64) * 544 + 512 + s; ldv = 544; }
            else { vb = (u16*)(ws + OFF_VBST) + (((size_t)lb * 8 + hd) * 64) * 1056 + 1024 + s; ldv = 1056; }
#pragma unroll
            for (int j = 0; j < 4; ++j) {
              vb[(size_t)(d0 + 2 * j) * ldv] = (u16)(o[j] & 0xffffu);
              vb[(size_t)(d0 + 2 * j + 1) * ldv] = (u16)(o[j] >> 16);
            }
          }
        }
      }
    }
  }
};

struct EpiP3 {
  u16* Y;
  DI void operator()(const f32x4 (&acc)[2][2][4][2], const pg8::Unit& u) const {
    const int tl = tid_opaque();
    const int lane = tl & 63, wid = tl >> 6, wr = wid >> 2, wc = wid & 3, fr = lane & 15, fq = lane >> 4;
#pragma unroll
    for (int ai = 0; ai < 2; ++ai)
#pragma unroll
      for (int m = 0; m < 4; ++m) {
        const int row = 256 * u.pm + 128 * ai + 64 * wr + 16 * m + fr;
#pragma unroll
        for (int bj = 0; bj < 2; ++bj) {
          const f32x4 v0 = acc[ai][bj][m][0], v1 = acc[ai][bj][m][1];
          u32x4 o;
          o[0] = pack2(v0[0], v0[1]); o[1] = pack2(v0[2], v0[3]); o[2] = pack2(v1[0], v1[1]); o[3] = pack2(v1[2], v1[3]);
          *(u32x4*)(Y + (size_t)row * 1024 + 256 * u.pn + 128 * bj + 32 * wc + 8 * fq) = o;
        }
      }
  }
};

struct EpiP5 {
  float* out; const u16* PLE; const u16* H1B; u16* HBN; float* psum; int layer;
  DI void operator()(const f32x4 (&acc)[2][2][4][2], const pg8::Unit& u) const {
    const int tl = tid_opaque();
    const int lane = tl & 63, wid = tl >> 6, wr = wid >> 2, wc = wid & 3, fr = lane & 15, fq = lane >> 4;
#pragma unroll
    for (int ai = 0; ai < 2; ++ai)
#pragma unroll
      for (int m = 0; m < 4; ++m) {
        const int row = 256 * u.pm + 128 * ai + 64 * wr + 16 * m + fr;
        float ss = 0.f;
#pragma unroll
        for (int bj = 0; bj < 2; ++bj) {
          const size_t idx = (size_t)row * 1024 + 256 * u.pn + 128 * bj + 32 * wc + 8 * fq;
          const u32x4 hw = *(const u32x4*)(H1B + idx);
          f32x4 h0, h1;
          h0[0] = bflo(hw[0]); h0[1] = bfhi(hw[0]); h0[2] = bflo(hw[1]); h0[3] = bfhi(hw[1]);
          h1[0] = bflo(hw[2]); h1[1] = bfhi(hw[2]); h1[2] = bflo(hw[3]); h1[3] = bfhi(hw[3]);
          const u32x4 pw = *(const u32x4*)(PLE + idx);
          const f32x4 a0 = acc[ai][bj][m][0], a1 = acc[ai][bj][m][1];
          f32x4 r0, r1;
          r0[0] = h0[0] + bflo(pw[0]) * sigm(a0[0]); r0[1] = h0[1] + bfhi(pw[0]) * sigm(a0[1]);
          r0[2] = h0[2] + bflo(pw[1]) * sigm(a0[2]); r0[3] = h0[3] + bfhi(pw[1]) * sigm(a0[3]);
          r1[0] = h1[0] + bflo(pw[2]) * sigm(a1[0]); r1[1] = h1[1] + bfhi(pw[2]) * sigm(a1[1]);
          r1[2] = h1[2] + bflo(pw[3]) * sigm(a1[2]); r1[3] = h1[3] + bfhi(pw[3]) * sigm(a1[3]);
          *(f32x4*)(out + idx) = r0; *(f32x4*)(out + idx + 4) = r1;
          if (layer == 0) {
            u32x4 o;
            o[0] = pack2(r0[0], r0[1]); o[1] = pack2(r0[2], r0[3]); o[2] = pack2(r1[0], r1[1]); o[3] = pack2(r1[2], r1[3]);
            *(u32x4*)(HBN + idx) = o;
            ss += r0[0] * r0[0] + r0[1] * r0[1] + r0[2] * r0[2] + r0[3] * r0[3] + r1[0] * r1[0] + r1[1] * r1[1] + r1[2] * r1[2] + r1[3] * r1[3];
          }
        }
        if (layer == 0) {
          ss += __shfl_xor(ss, 16); ss += __shfl_xor(ss, 32);
          if (fq == 0) psum[(size_t)row * 32 + u.pn * 4 + wc] = ss;
        }
      }
  }
};

constexpr float LOG2E = 1.4426950408889634f;
constexpr float SB_EXIT = -160.0f;
DI float ex2(float x) { return __builtin_amdgcn_exp2f(x); }
DI float lg2(float x) { return __builtin_amdgcn_logf(x); }

DI void attn_store(const f32x16& o0, const f32x16& o1, float scale, const u16* Gp, u16* Mp, int r, int h) {
#pragma unroll
  for (int db = 0; db < 2; ++db)
#pragma unroll
    for (int g = 0; g < 4; ++g) {
      const int d0 = 32 * db + 8 * g + 4 * h;
      const uint2 gv = *(const uint2*)(Gp + (size_t)r * 1024 + d0);
      const float x0 = (db ? o1[4 * g] : o0[4 * g]) * scale * bflo(gv.x);
      const float x1 = (db ? o1[4 * g + 1] : o0[4 * g + 1]) * scale * bfhi(gv.x);
      const float x2 = (db ? o1[4 * g + 2] : o0[4 * g + 2]) * scale * bflo(gv.y);
      const float x3 = (db ? o1[4 * g + 3] : o0[4 * g + 3]) * scale * bfhi(gv.y);
      uint2 o; o.x = pack2(x0, x1); o.y = pack2(x2, x3);
      *(uint2*)(Mp + (size_t)r * 1024 + d0) = o;
    }
}

DI bf16x8 ldv8(const u16* vp) {
  const bf16x4 lo = *(const bf16x4*)vp;
  const bf16x4 hi = *(const bf16x4*)(vp + 8);
  return __builtin_shufflevector(lo, hi, 0, 1, 2, 3, 4, 5, 6, 7);
}

DI bf16x8 pack8(const float* v) {
  u32x4 u;
  u[0] = pack2(v[0], v[1]); u[1] = pack2(v[2], v[3]); u[2] = pack2(v[4], v[5]); u[3] = pack2(v[6], v[7]);
  return __builtin_bit_cast(bf16x8, u);
}

DI void make_tf(bf16x8 (&tf)[2], int r, int h) {
#pragma unroll
  for (int s = 0; s < 2; ++s)
#pragma unroll
    for (int j = 0; j < 8; ++j) tf[s][j] = (16 * s + 8 * (j >> 2) + 4 * h + (j & 3) > r) ? (short)0x3F80 : (short)0;
}

DI unsigned pack2v(f2_t v) { bf2_t r = __builtin_convertvector(v, bf2_t); return __builtin_bit_cast(unsigned, r); }
DI bf16x8 pack8v(const f2_t* v) {
  u32x4 u;
  u[0] = pack2v(v[0]); u[1] = pack2v(v[1]); u[2] = pack2v(v[2]); u[3] = pack2v(v[3]);
  return __builtin_bit_cast(bf16x8, u);
}
template <bool MASK>
DI void sb_step(const f32x16& st, const bf16x8 (&vf)[2][2], const bf16x8 (&tf)[2], int k0, int qpos, int h,
                f32x16& o0, f32x16& o1, float& carry) {
  f2_t l1m[8], lb[8];
  f2_t cs2 = {0.f, 0.f};
#pragma unroll
  for (int p = 0; p < 8; ++p) {
    const f2_t z = {st[2 * p], st[2 * p + 1]};
    const f2_t e = {ex2(-fabsf(z.x)), ex2(-fabsf(z.y))};
    const f2_t t = e + 1.0f;
    const f2_t lg = {lg2(t.x), lg2(t.y)};
    const f2_t mx = {__builtin_amdgcn_fmed3f(z.x, 0.f, 3.0e38f), __builtin_amdgcn_fmed3f(z.y, 0.f, 3.0e38f)};
    const f2_t sp = mx + lg;
    if (MASK) {
      const bool c0 = (k0 + crow(2 * p, h)) < qpos, c1 = (k0 + crow(2 * p + 1, h)) < qpos;
      l1m[p] = (f2_t){c0 ? -sp.x : 0.f, c1 ? -sp.y : 0.f};
      lb[p] = (f2_t){c0 ? (z.x - sp.x) : -1e30f, c1 ? (z.y - sp.y) : -1e30f};
    } else {
      l1m[p] = -sp;
      lb[p] = z - sp;
    }
    cs2 += l1m[p];
  }
  float csum = cs2.x + cs2.y;
  csum += __shfl_xor(csum, 32);
  f32x16 af;
#pragma unroll
  for (int i = 0; i < 16; ++i) af[i] = carry;
  af = MFMA32(tf[0], pack8v(l1m), af);
  af = MFMA32(tf[1], pack8v(l1m + 4), af);
  f2_t w[8];
#pragma unroll
  for (int p = 0; p < 8; ++p) {
    const f2_t a2 = {af[2 * p], af[2 * p + 1]};
    const f2_t t = lb[p] + a2;
    w[p] = (f2_t){ex2(t.x), ex2(t.y)};
  }
  carry += csum;
  const bf16x8 w0 = pack8v(w), w1 = pack8v(w + 4);
  o0 = MFMA32(vf[0][0], w0, o0);
  o0 = MFMA32(vf[0][1], w1, o0);
  o1 = MFMA32(vf[1][0], w0, o1);
  o1 = MFMA32(vf[1][1], w1, o1);
}

template <bool SCALE_BIAS, typename BiasPtr>
DI void band_step(const f32x16& st, const bf16x8 (&vf)[2][2], BiasPtr bias, float b0, int relmax, int relc, int h,
                  f32x16& o0, f32x16& o1, float& m, float& l) {
  float sv[16];
  if (relmax <= -128) {
#pragma unroll
    for (int i = 0; i < 16; ++i) sv[i] = st[i] + b0;
  } else {
#pragma unroll
    for (int i = 0; i < 16; ++i) {
      int rel = relc + crow(i, h);
      rel = min(max(rel, -128), 128) + 128;
      const float bv = bias[rel];
      sv[i] = st[i] + (SCALE_BIAS ? bv * LOG2E : bv);
    }
  }
  float mt = sv[0];
#pragma unroll
  for (int i = 1; i < 16; ++i) mt = fmaxf(mt, sv[i]);
  mt = fmaxf(mt, __shfl_xor(mt, 32));
  const float mnew = fmaxf(m, mt);
  const float alpha = ex2(m - mnew);
  m = mnew;
  float ps = 0.f;
#pragma unroll
  for (int i = 0; i < 16; ++i) { sv[i] = ex2(sv[i] - mnew); ps += sv[i]; }
  l = l * alpha + ps;
#pragma unroll
  for (int i = 0; i < 16; ++i) { o0[i] *= alpha; o1[i] *= alpha; }
  const bf16x8 w0 = pack8(sv), w1 = pack8(sv + 8);
  o0 = MFMA32(vf[0][0], w0, o0);
  o0 = MFMA32(vf[0][1], w1, o0);
  o1 = MFMA32(vf[1][0], w0, o1);
  o1 = MFMA32(vf[1][1], w1, o1);
}

DI void sb_item(const u16* __restrict__ Q, const u16* __restrict__ Kb, const u16* __restrict__ VT, int ldv,
                int qpos0, int ntiles, const u16* Gp, u16* Mp) {
  const int lane = tid_opaque() & 63, r = lane & 31, h = lane >> 5;
  bf16x8 qf[4];
#pragma unroll
  for (int ks = 0; ks < 4; ++ks) qf[ks] = *(const bf16x8*)(Q + r * 64 + 16 * ks + 8 * h);
  bf16x8 tf[2];
  make_tf(tf, r, h);
  f32x16 o0, o1;
#pragma unroll
  for (int i = 0; i < 16; ++i) { o0[i] = 0.f; o1[i] = 0.f; }
  float carry = 0.f;
  const int qpos = qpos0 + r;
  for (int kt = ntiles - 1; kt >= 0; --kt) {
    const int k0 = kt * 32;
    f32x16 st;
#pragma unroll
    for (int i = 0; i < 16; ++i) st[i] = 0.f;
    const u16* kp = Kb + (size_t)(k0 + r) * 64 + 8 * h;
#pragma unroll
    for (int ks = 0; ks < 4; ++ks) {
      const bf16x8 kf = *(const bf16x8*)(kp + 16 * ks);
      st = MFMA32(kf, qf[ks], st);
    }
    bf16x8 vf[2][2];
#pragma unroll
    for (int db = 0; db < 2; ++db)
#pragma unroll
      for (int s = 0; s < 2; ++s) vf[db][s] = ldv8(VT + (size_t)(32 * db + r) * ldv + k0 + 16 * s + 4 * h);
    if (k0 + 31 < qpos0) sb_step<false>(st, vf, tf, k0, qpos, h, o0, o1, carry);
    else sb_step<true>(st, vf, tf, k0, qpos, h, o0, o1, carry);
    if (__all(carry < SB_EXIT)) break;
  }
  attn_store(o0, o1, 1.0f, Gp, Mp, r, h);
}

DI void band_item(const u16* __restrict__ Q, const u16* __restrict__ Kb, const u16* __restrict__ VT, int ldv,
                  int kt_begin, int kt_end, int relbase, const float* __restrict__ bias, const u16* Gp, u16* Mp) {
  const int lane = tid_opaque() & 63, r = lane & 31, h = lane >> 5;
  bf16x8 qf[4];
#pragma unroll
  for (int ks = 0; ks < 4; ++ks) qf[ks] = *(const bf16x8*)(Q + r * 64 + 16 * ks + 8 * h);
  f32x16 o0, o1;
#pragma unroll
  for (int i = 0; i < 16; ++i) { o0[i] = 0.f; o1[i] = 0.f; }
  float m = -1e30f, l = 0.f;
  const float b0 = bias[0] * LOG2E;
  for (int kt = kt_begin; kt < kt_end; ++kt) {
    const int k0 = kt * 32;
    f32x16 st;
#pragma unroll
    for (int i = 0; i < 16; ++i) st[i] = 0.f;
    const u16* kp = Kb + (size_t)(k0 + r) * 64 + 8 * h;
#pragma unroll
    for (int ks = 0; ks < 4; ++ks) {
      const bf16x8 kf = *(const bf16x8*)(kp + 16 * ks);
      st = MFMA32(kf, qf[ks], st);
    }
    bf16x8 vf[2][2];
#pragma unroll
    for (int db = 0; db < 2; ++db)
#pragma unroll
      for (int s = 0; s < 2; ++s) vf[db][s] = ldv8(VT + (size_t)(32 * db + r) * ldv + k0 + 16 * s + 4 * h);
    band_step<true>(st, vf, bias, b0, k0 + 31 + relbase, k0 + relbase - r, h, o0, o1, m, l);
  }
  l += __shfl_xor(l, 32);
  attn_store(o0, o1, 1.0f / l, Gp, Mp, r, h);
}

constexpr int AT_KS = 72, AT_VS = 68;
constexpr int AT_STAGE = 64 * AT_KS + 64 * AT_VS;
constexpr int AT_BIAS_OFF = 2 * AT_STAGE * 2;

struct KvRegs { u32x4 k; u32x2 v0, v1; };
DI KvRegs kv_load(const u16* __restrict__ Kb, const u16* __restrict__ Vb, int ldv, int k0, int tid) {
  KvRegs g;
  const int row = tid >> 3, ch = tid & 7;
  g.k = *(const u32x4*)(Kb + (size_t)(k0 + row) * 64 + ch * 8);
  const int kp = tid >> 4, d4 = tid & 15;
  g.v0 = *(const u32x2*)(Vb + (size_t)(k0 + 2 * kp) * 64 + d4 * 4);
  g.v1 = *(const u32x2*)(Vb + (size_t)(k0 + 2 * kp + 1) * 64 + d4 * 4);
  return g;
}
DI void kv_store(u16* stage, const KvRegs& g, int tid) {
  const int row = tid >> 3, ch = tid & 7;
  *(u32x4*)(stage + row * AT_KS + ch * 8) = g.k;
  const int kp = tid >> 4, d4 = tid & 15;
  u16* vp = stage + 64 * AT_KS + (d4 * 4) * AT_VS + 2 * kp;
  *(unsigned*)(vp + 0 * AT_VS) = (g.v0[0] & 0xffffu) | (g.v1[0] << 16);
  *(unsigned*)(vp + 1 * AT_VS) = (g.v0[0] >> 16) | (g.v1[0] & 0xffff0000u);
  *(unsigned*)(vp + 2 * AT_VS) = (g.v0[1] & 0xffffu) | (g.v1[1] << 16);
  *(unsigned*)(vp + 3 * AT_VS) = (g.v0[1] >> 16) | (g.v1[1] & 0xffff0000u);
}
DI void kv_out(const KvRegs& g, float* fk, float* fv, int k0, int tid) {
  const int row = tid >> 3, ch = tid & 7;
  const size_t o = (size_t)(k0 + row) * 512 + ch * 8;
  f32x4 a, b;
  a[0] = bflo(g.k[0]); a[1] = bfhi(g.k[0]); a[2] = bflo(g.k[1]); a[3] = bfhi(g.k[1]);
  b[0] = bflo(g.k[2]); b[1] = bfhi(g.k[2]); b[2] = bflo(g.k[3]); b[3] = bfhi(g.k[3]);
  __builtin_nontemporal_store(a, (f32x4*)(fk + o)); __builtin_nontemporal_store(b, (f32x4*)(fk + o + 4));
  const int kp = tid >> 4, d4 = tid & 15;
  const size_t ov = (size_t)(k0 + 2 * kp) * 512 + d4 * 4;
  a[0] = bflo(g.v0[0]); a[1] = bfhi(g.v0[0]); a[2] = bflo(g.v0[1]); a[3] = bfhi(g.v0[1]);
  b[0] = bflo(g.v1[0]); b[1] = bfhi(g.v1[0]); b[2] = bflo(g.v1[1]); b[3] = bfhi(g.v1[1]);
  __builtin_nontemporal_store(a, (f32x4*)(fv + ov)); __builtin_nontemporal_store(b, (f32x4*)(fv + ov + 512));
}
DI void lds_frags(const u16* stage, int sub, const bf16x8 (&qf)[4], int r, int h, f32x16& st, bf16x8 (&vf)[2][2]) {
#pragma unroll
  for (int i = 0; i < 16; ++i) st[i] = 0.f;
  const u16* kp = stage + (32 * sub + r) * AT_KS + 8 * h;
#pragma unroll
  for (int ks = 0; ks < 4; ++ks) {
    const bf16x8 kf = *(const bf16x8*)(kp + 16 * ks);
    st = MFMA32(kf, qf[ks], st);
  }
#pragma unroll
  for (int db = 0; db < 2; ++db)
#pragma unroll
    for (int s = 0; s < 2; ++s) vf[db][s] = ldv8(stage + 64 * AT_KS + (32 * db + r) * AT_VS + 32 * sub + 16 * s + 4 * h);
}

DI void lds_frags2(const u16* stage, const bf16x8 (&qf)[4], int r, int h, f32x16& st0, f32x16& st1,
                   bf16x8 (&vf0)[2][2], bf16x8 (&vf1)[2][2]) {
#pragma unroll
  for (int i = 0; i < 16; ++i) { st0[i] = 0.f; st1[i] = 0.f; }
  const u16* kp = stage + r * AT_KS + 8 * h;
#pragma unroll
  for (int ks = 0; ks < 4; ++ks) {
    const bf16x8 k0f = *(const bf16x8*)(kp + 16 * ks);
    const bf16x8 k1f = *(const bf16x8*)(kp + 32 * AT_KS + 16 * ks);
    st0 = MFMA32(k0f, qf[ks], st0);
    st1 = MFMA32(k1f, qf[ks], st1);
  }
#pragma unroll
  for (int db = 0; db < 2; ++db)
#pragma unroll
    for (int s = 0; s < 2; ++s) {
      vf0[db][s] = ldv8(stage + 64 * AT_KS + (32 * db + r) * AT_VS + 16 * s + 4 * h);
      vf1[db][s] = ldv8(stage + 64 * AT_KS + (32 * db + r) * AT_VS + 32 + 16 * s + 4 * h);
    }
}
DI void band_step64(const f32x16& st0, const f32x16& st1, const bf16x8 (&vf0)[2][2], const bf16x8 (&vf1)[2][2],
                    const float* bias, float b0, int relmax, int relc, int h, f32x16& o0, f32x16& o1, float& m, float& l) {
  float sa[16], sb[16];
  if (relmax <= -128) {
#pragma unroll
    for (int i = 0; i < 16; ++i) sa[i] = st0[i] + b0;
  } else {
#pragma unroll
    for (int i = 0; i < 16; ++i) sa[i] = st0[i] + bias[min(max(relc + crow(i, h), -128), 128) + 128];
  }
  if (relmax + 32 <= -128) {
#pragma unroll
    for (int i = 0; i < 16; ++i) sb[i] = st1[i] + b0;
  } else {
#pragma unroll
    for (int i = 0; i < 16; ++i) sb[i] = st1[i] + bias[min(max(relc + 32 + crow(i, h), -128), 128) + 128];
  }
  float mt = fmaxf(sa[0], sb[0]);
#pragma unroll
  for (int i = 1; i < 16; ++i) mt = fmaxf(fmaxf(mt, sa[i]), sb[i]);
  mt = fmaxf(mt, __shfl_xor(mt, 32));
  const float mnew = fmaxf(m, mt);
  const float alpha = ex2(m - mnew);
  m = mnew;
  const f2_t mn = {mnew, mnew};
  f2_t ps2 = {0.f, 0.f};
#pragma unroll
  for (int p = 0; p < 8; ++p) {
    const f2_t da = (f2_t){sa[2 * p], sa[2 * p + 1]} - mn, db = (f2_t){sb[2 * p], sb[2 * p + 1]} - mn;
    sa[2 * p] = ex2(da.x); sa[2 * p + 1] = ex2(da.y); sb[2 * p] = ex2(db.x); sb[2 * p + 1] = ex2(db.y);
    ps2 += (f2_t){sa[2 * p], sa[2 * p + 1]} + (f2_t){sb[2 * p], sb[2 * p + 1]};
  }
  l = l * alpha + (ps2.x + ps2.y);
  o0 = o0 * alpha; o1 = o1 * alpha;
  const bf16x8 a0 = pack8(sa), a1 = pack8(sa + 8), b0w = pack8(sb), b1w = pack8(sb + 8);
  o0 = MFMA32(vf0[0][0], a0, o0);
  o1 = MFMA32(vf0[1][0], a0, o1);
  o0 = MFMA32(vf0[0][1], a1, o0);
  o1 = MFMA32(vf0[1][1], a1, o1);
  o0 = MFMA32(vf1[0][0], b0w, o0);
  o1 = MFMA32(vf1[1][0], b0w, o1);
  o0 = MFMA32(vf1[0][1], b1w, o0);
  o1 = MFMA32(vf1[1][1], b1w, o1);
}

DI void sbp_unit(const u16* __restrict__ Qb, const u16* __restrict__ Kb, const u16* __restrict__ VT, int qblk,
                 const u16* Gp, u16* Mp, u16* sm, float* fk, float* fv) {
  const int tid = tid_opaque(), lane = tid & 63, wave = tid >> 6, r = lane & 31, h = lane >> 5;
  const int q0w = qblk * 256 + 32 * wave;
  bf16x8 qf[4];
#pragma unroll
  for (int ks = 0; ks < 4; ++ks) qf[ks] = *(const bf16x8*)(Qb + (size_t)(q0w + r) * 64 + 16 * ks + 8 * h);
  bf16x8 tf[2];
  make_tf(tf, r, h);
  f32x16 o0, o1;
#pragma unroll
  for (int i = 0; i < 16; ++i) { o0[i] = 0.f; o1[i] = 0.f; }
  float carry = 0.f;
  int done = 0;
  const int qpos = q0w + r;
  const int t_hi = qblk * 4 + 3;
  KvRegs gA, gB;
  {
    const KvRegs g = kv_load(Kb, VT, 2048, t_hi * 64, tid);
    gA = kv_load(Kb, VT, 2048, max(t_hi - 1, 0) * 64, tid);
    kv_store(sm, g, tid);
    kv_out(g, fk, fv, t_hi * 64, tid);
  }
  __syncthreads();
  int cur = 0;
  for (int t = t_hi;; --t) {
    gB = kv_load(Kb, VT, 2048, max(t - 2, 0) * 64, tid);
    const u16* stage = sm + cur * AT_STAGE;
    if (!done) {
#pragma unroll
      for (int sub = 1; sub >= 0; --sub) {
        const int k0 = t * 64 + sub * 32;
        if (k0 < q0w + 31) {
          f32x16 st; bf16x8 vf[2][2];
          lds_frags(stage, sub, qf, r, h, st, vf);
          if (k0 + 31 < q0w) sb_step<false>(st, vf, tf, k0, qpos, h, o0, o1, carry);
          else sb_step<true>(st, vf, tf, k0, qpos, h, o0, o1, carry);
        }
      }
      done = __all(carry < SB_EXIT) ? 1 : 0;
    }
    if (t == 0) break;
    kv_store(sm + (cur ^ 1) * AT_STAGE, gA, tid);
    if (t - 1 >= qblk * 4) kv_out(gA, fk, fv, (t - 1) * 64, tid);
    int* fl = (int*)((unsigned char*)sm + AT_BIAS_OFF + 1056) + (t & 1) * 8;
    if (lane == 0) fl[wave] = done;
    __syncthreads();
    {
      const int4 fa = *(const int4*)fl, fb = *(const int4*)(fl + 4);
      if ((fa.x & fa.y & fa.z & fa.w & fb.x & fb.y & fb.z & fb.w) != 0) break;
    }
    gA = gB;
    cur ^= 1;
  }
  attn_store(o0, o1, 1.0f, Gp + (size_t)(32 * wave) * 1024, Mp + (size_t)(32 * wave) * 1024, r, h);
}

DI void bp_unit(const u16* __restrict__ Qb, const u16* __restrict__ Kb, const u16* __restrict__ VT, int qblk,
                const float* __restrict__ bias_g, const u16* Gp, u16* Mp, u16* sm, float* fk, float* fv) {
  const int tid = tid_opaque(), lane = tid & 63, wave = tid >> 6, r = lane & 31, h = lane >> 5;
  const int q0w = qblk * 256 + 32 * wave;
  const int cw = qblk * 4 + (wave >> 1);
  float* sbias = (float*)((unsigned char*)sm + AT_BIAS_OFF);
  if (tid < 257) sbias[tid] = bias_g[tid] * LOG2E;
  bf16x8 qf[4];
#pragma unroll
  for (int ks = 0; ks < 4; ++ks) qf[ks] = *(const bf16x8*)(Qb + (size_t)(q0w + r) * 64 + 16 * ks + 8 * h);
  f32x16 o0, o1;
#pragma unroll
  for (int i = 0; i < 16; ++i) { o0[i] = 0.f; o1[i] = 0.f; }
  float m = -1e30f, l = 0.f;
  const int t_hi = qblk * 4 + 3, t_lo = max(0, qblk * 4 - 8);
  KvRegs gA, gB;
  {
    const KvRegs g = kv_load(Kb, VT, 2048, t_hi * 64, tid);
    gA = kv_load(Kb, VT, 2048, max(t_hi - 1, t_lo) * 64, tid);
    kv_store(sm, g, tid);
    if (qblk >= 6) kv_out(g, fk, fv, t_hi * 64 - 1536, tid);
  }
  __syncthreads();
  const float b0 = sbias[0];
  int cur = 0;
  for (int t = t_hi;; --t) {
    gB = kv_load(Kb, VT, 2048, max(t - 2, t_lo) * 64, tid);
    const u16* stage = sm + cur * AT_STAGE;
    if (t <= cw && t >= cw - 8) {
      const int k0 = t * 64;
      f32x16 st0, st1; bf16x8 vf0[2][2], vf1[2][2];
      lds_frags2(stage, qf, r, h, st0, st1, vf0, vf1);
      band_step64(st0, st1, vf0, vf1, sbias, b0, k0 + 31 - q0w, k0 - q0w - r, h, o0, o1, m, l);
    }
    if (t == t_lo) break;
    kv_store(sm + (cur ^ 1) * AT_STAGE, gA, tid);
    if (qblk >= 6 && t - 1 >= qblk * 4) kv_out(gA, fk, fv, (t - 1) * 64 - 1536, tid);
    __syncthreads();
    gA = gB;
    cur ^= 1;
  }
  l += __shfl_xor(l, 32);
  attn_store(o0, o1, 1.0f / l, Gp + (size_t)(32 * wave) * 1024, Mp + (size_t)(32 * wave) * 1024, r, h);
}

constexpr int N_UNITS = 32 + 1024 + 1024;

DI void phase2(const Params& p, int layer, const u16* Gbuf, u16* MIX, u16* sm, int cslot = 0) {
  unsigned char* ws = p.ws;
  int* ctr = (int*)(ws + OFF_CTR) + layer + cslot;
  int* s_unit = (int*)((unsigned char*)sm + AT_BIAS_OFF + 257 * 4 + 12);
  for (;;) {
    __syncthreads();
    if (threadIdx.x == 0) *s_unit = atomicAdd(ctr, 1);
    __syncthreads();
    const int u = *s_unit;
    if (u >= N_UNITS) break;
    if (u < 32) {
      const int wave = tid_opaque() >> 6;
      const int item = u * 8 + wave;
      if (item < 128) {
        const int bh = item, b = bh >> 3, hd = bh & 7;
        const size_t row0 = (size_t)MP + b * 32;
        sb_item((const u16*)(ws + OFF_QBS) + (size_t)bh * 32 * 64,
                (const u16*)(ws + OFF_KBS) + ((size_t)layer * 128 + bh) * 1056 * 64,
                (const u16*)(ws + OFF_VBST) + ((size_t)layer * 128 + bh) * 64 * 1056, 1056,
                1024, 33, Gbuf + row0 * 1024 + 512 + hd * 64, MIX + row0 * 1024 + 512 + hd * 64);
      } else {
        const int bh = item - 128, b = bh >> 3, hd = bh & 7;
        const size_t row0 = (size_t)MP + b * 32;
        band_item((const u16*)(ws + OFF_QAS) + (size_t)bh * 32 * 64,
                  (const u16*)(ws + OFF_KAS) + ((size_t)layer * 128 + bh) * 544 * 64,
                  (const u16*)(ws + OFF_VAST) + ((size_t)layer * 128 + bh) * 64 * 544, 544,
                  0, 17, -512, p.relb + (size_t)(layer * 8 + hd) * 257,
                  Gbuf + row0 * 1024 + hd * 64, MIX + row0 * 1024 + hd * 64);
      }
    } else if (u < 32 + 1024) {
      const int j = u - 32, bh = j >> 3, qblk = 7 - (j & 7), b = bh >> 3, hd = bh & 7;
      const size_t row0 = (size_t)b * 2048 + qblk * 256;
      sbp_unit((const u16*)(ws + OFF_QB) + (size_t)bh * 2048 * 64, (const u16*)(ws + OFF_KB) + (size_t)bh * 2048 * 64,
               (const u16*)(ws + OFF_VBT) + (size_t)bh * 64 * 2048, qblk,
               Gbuf + row0 * 1024 + 512 + hd * 64, MIX + row0 * 1024 + 512 + hd * 64, sm,
               p.out + O_BKP + ((size_t)(layer * 16 + b) * 2048) * 512 + hd * 64, p.out + O_BVP + ((size_t)(layer * 16 + b) * 2048) * 512 + hd * 64);
    } else {
      const int j = u - 32 - 1024, bh = j & 127, qblk = 7 - (j >> 7), b = bh >> 3, hd = bh & 7;
      const size_t row0 = (size_t)b * 2048 + qblk * 256;
      bp_unit((const u16*)(ws + OFF_QA) + (size_t)bh * 2048 * 64, (const u16*)(ws + OFF_KA) + (size_t)bh * 2048 * 64,
              (const u16*)(ws + OFF_VAT) + (size_t)bh * 64 * 2048, qblk, p.relb + (size_t)(layer * 8 + hd) * 257,
              Gbuf + row0 * 1024 + hd * 64, MIX + row0 * 1024 + hd * 64, sm,
              p.out + O_AKP + ((size_t)(layer * 16 + b) * 512) * 512 + hd * 64, p.out + O_AVP + ((size_t)(layer * 16 + b) * 512) * 512 + hd * 64);
    }
  }
}

DI void phase4(const Params& p, int layer, const u16* Y, u16* H1B) {
  const int tid = tid_opaque(), lane = tid & 63;
  const int gw = (blockIdx.x * NTHR + tid) >> 6, nw = (gridDim.x * NTHR) >> 6;
  const float* gp = p.gpost + layer * 1024;
  for (int row = gw; row < MT; row += nw) {
    const u16* yr = Y + (size_t)row * 1024;
    float yf[16];
    float ss = 0.f;
#pragma unroll
    for (int j = 0; j < 2; ++j) {
      const uint4 u = *(const uint4*)(yr + 8 * lane + 512 * j);
      yf[8 * j + 0] = bflo(u.x); yf[8 * j + 1] = bfhi(u.x); yf[8 * j + 2] = bflo(u.y); yf[8 * j + 3] = bfhi(u.y);
      yf[8 * j + 4] = bflo(u.z); yf[8 * j + 5] = bfhi(u.z); yf[8 * j + 6] = bflo(u.w); yf[8 * j + 7] = bfhi(u.w);
    }
#pragma unroll
    for (int i = 0; i < 16; ++i) ss += yf[i] * yf[i];
#pragma unroll
    for (int m = 32; m >= 1; m >>= 1) ss += __shfl_xor(ss, m);
    const float rs = rsqrtf(ss * (1.0f / 1024.0f) + EPS);
    const float* hs;
    if (layer == 0) hs = row < MP ? p.xp + (size_t)row * 1024 : p.xs + (size_t)(row - MP) * 1024;
    else hs = p.out + (size_t)row * 1024;
#pragma unroll
    for (int j = 0; j < 2; ++j) {
      const int c = 8 * lane + 512 * j;
      const float4 a = *(const float4*)(hs + c), b = *(const float4*)(hs + c + 4);
      const float4 ga = *(const float4*)(gp + c), gb = *(const float4*)(gp + c + 4);
      float4 oa, ob;
      oa.x = a.x + yf[8 * j + 0] * rs * ga.x; oa.y = a.y + yf[8 * j + 1] * rs * ga.y;
      oa.z = a.z + yf[8 * j + 2] * rs * ga.z; oa.w = a.w + yf[8 * j + 3] * rs * ga.w;
      ob.x = b.x + yf[8 * j + 4] * rs * gb.x; ob.y = b.y + yf[8 * j + 5] * rs * gb.y;
      ob.z = b.z + yf[8 * j + 6] * rs * gb.z; ob.w = b.w + yf[8 * j + 7] * rs * gb.w;
      uint4 o;
      o.x = pack2(oa.x, oa.y); o.y = pack2(oa.z, oa.w); o.z = pack2(ob.x, ob.y); o.w = pack2(ob.z, ob.w);
      *(uint4*)(H1B + (size_t)row * 1024 + c) = o;
    }
  }
}

DI void p5_tile(const Params& p, int layer, int mt, int nt, int ks0, u16* sA, u16* sB, const u16* H1B, u16* HBN) {
  const int m0 = mt * 256, n0 = nt * 128;
  unsigned char* ws = p.ws;
  f32x16 acc[4][1];
  gemm_mainloop<1>((const u16*)(ws + OFF_PB) + ((size_t)layer * MT + m0) * 256, 256,
                   (const u16*)(ws + OFF_WPLE) + ((size_t)layer * 1024 + n0) * 256, 256, 256, ks0, sA, sB, acc);
  unsigned pl[4][8];
#pragma unroll
  for (int rb = 0; rb < 4; ++rb)
#pragma unroll
    for (int j = 0; j < 8; ++j) pl[rb][j] = pack2(acc[rb][0][2 * j], acc[rb][0][2 * j + 1]);
  gemm_mainloop<1>(H1B + (size_t)m0 * 1024, 1024, (const u16*)(ws + OFF_WGATE) + ((size_t)layer * 1024 + n0) * 1024, 1024, 1024, ks0, sA, sB, acc);
  int tl = tid_opaque();
  const int lane = tl & 63, wave = tl >> 6, wm = wave >> 2, wn = wave & 3, r = lane & 31, h = lane >> 5;
  const int col = n0 + 32 * wn + r;
  __syncthreads();
  float* st = (float*)sA + wave * (32 * 36);
#pragma unroll 1
  for (int rb = 0; rb < 4; ++rb) {
    const int row0 = m0 + 128 * wm + 32 * rb;
#pragma unroll
    for (int i = 0; i < 16; ++i) {
      const int t = crow(i, h);
      float* hp = p.out + (size_t)(row0 + t) * 1024 + col;
      const float h1 = *hp;
      const unsigned plw = rb == 0 ? pl[0][i >> 1] : rb == 1 ? pl[1][i >> 1] : rb == 2 ? pl[2][i >> 1] : pl[3][i >> 1];
      const float pv = (i & 1) ? bfhi(plw) : bflo(plw);
      const float a = rb == 0 ? acc[0][0][i] : rb == 1 ? acc[1][0][i] : rb == 2 ? acc[2][0][i] : acc[3][0][i];
      const float g = 1.0f / (1.0f + __expf(-a));
      const float h2 = h1 + g * pv;
      *hp = h2;
      st[t * 36 + r] = h2;
    }
    if (layer == 0) {
#pragma unroll
      for (int j = 0; j < 4; ++j) {
        const int c = lane + 64 * j, t = c >> 3, c4 = (c & 7) * 4;
        const float4 x = *(const float4*)(st + t * 36 + c4);
        uint2 o; o.x = pack2(x.x, x.y); o.y = pack2(x.z, x.w);
        *(uint2*)(HBN + (size_t)(row0 + t) * 1024 + n0 + 32 * wn + c4) = o;
        float ss = x.x * x.x + x.y * x.y + x.z * x.z + x.w * x.w;
        ss += __shfl_xor(ss, 1); ss += __shfl_xor(ss, 2); ss += __shfl_xor(ss, 4);
        if ((c & 7) == 0) ((float*)(ws + OFF_PSUM))[(size_t)(row0 + t) * 32 + nt * 4 + wn] = ss;
      }
    }
  }
}

__global__ void __launch_bounds__(NTHR, 2) mega(Params p, int ph_begin, int ph_end) {
  extern __shared__ __attribute__((aligned(16))) unsigned char smem[];
  u16* sA = (u16*)smem;
  PG8_LAS unsigned char* lds3 = (PG8_LAS unsigned char*)smem;
  u16* sB = sA + 256 * LDT;
  float* rstd_s = (float*)(smem + 2 * (2 * 256 * LDT * 2));
  unsigned char* ws = p.ws;
  __shared__ uint4 xb_words;
  if (threadIdx.x == 0) xb_words = make_uint4(0u, 0u, 0u, 0u);
  __syncthreads();
  XcdBarrier xb = xcd_barrier_post((unsigned*)(ws + OFF_BAR), (volatile LAS unsigned*)&xb_words);
  if (ph_end < 0) cg::this_grid().sync();
  int xx = blockIdx.x & 7, xi = blockIdx.x >> 3;
  int ks0 = (xi & 7) + (xi >> 3);
#define PHASE_GATE(PH) if ((PH) >= ph_begin && (PH) < ph_end) { if ((PH) > ph_begin) xcd_barrier(xb);
  PHASE_GATE(0) phase0(p, (float*)smem); }
#if PROBE_DUP == 10
  phase0(p, (float*)smem);
#endif
#pragma unroll 1
  for (int layer = 0; layer < 2; ++layer) {
    asm volatile("" : "+s"(layer));
    u16* RA = (u16*)(ws + ((layer & 1) ? OFF_R1 : OFF_R0));
    u16* RB = (u16*)(ws + ((layer & 1) ? OFF_R0 : OFF_R1));
    const int pb = 1 + 5 * layer;
    if (layer > 0 && (pb + 0) >= ph_begin && (pb + 0) < ph_end) {
      xcd_barrier(xb);
      const float* ps = (const float*)(ws + OFF_PSUM);
      float* rg = (float*)(ws + OFF_RSTD);
      for (int row = blockIdx.x * NTHR + tid_opaque(); row < MT; row += gridDim.x * NTHR) {
        const float4* q4 = (const float4*)(ps + (size_t)row * 32);
        float sm = 0.f;
#pragma unroll
        for (int j = 0; j < 4; ++j) { const float4 v = q4[j]; sm += v.x + v.y + v.z + v.w; }
        rg[row] = rsqrtf(sm * (1.0f / 1024.0f) + EPS);
      }
    }
    PHASE_GATE(pb + 0)
      pg8::StaticOrder S; S.init(MT, 4096, (int)gridDim.x, (int)blockIdx.x);
      pg8::Gemm g; g.A = RA; g.Bt = (const u16*)(ws + OFF_WIN) + (size_t)layer * 4096 * 1024; g.M = MT; g.N = 4096; g.K = 1024;
      EpiP1 E; E.pp = &p; E.layer = layer; E.Gbuf = RB;
      pg8::gemm_phase(lds3, g, S, E);
      if (blockIdx.x >= 32) cache_convert(p, layer, (int)blockIdx.x - 32, (int)gridDim.x - 32, (float*)smem);
#if PROBE_DUP == 8
      xcd_barrier(xb);
      pg8::gemm_phase(lds3, g, S, E);
#endif
    }
    PHASE_GATE(pb + 1) phase2(p, layer, RB, RA, sA); }
#if PROBE_DUP == 2
    xcd_barrier(xb); phase2(p, layer, RB, RA, sA, 2);
#endif

    PHASE_GATE(pb + 2)
      pg8::StaticOrder S; S.init(MT, 1024, (int)gridDim.x, (int)blockIdx.x);
      pg8::Gemm g; g.A = RA; g.Bt = (const u16*)(ws + OFF_WOUT) + (size_t)layer * 1024 * 1024; g.M = MT; g.N = 1024; g.K = 1024;
      EpiP3 E; E.Y = RB;
      pg8::gemm_phase(lds3, g, S, E);
      pg8::Gemm g2; g2.A = (const u16*)(ws + OFF_PB) + (size_t)layer * MT * 256; g2.Bt = (const u16*)(ws + OFF_WPLE) + (size_t)layer * 1024 * 256;
      g2.M = MT; g2.N = 1024; g2.K = 256;
      EpiP3 E2; E2.Y = (u16*)(ws + OFF_QA);
      if (blockIdx.x >= 8) {
        pg8::StaticOrder S2; S2.init(MT, 1024, (int)gridDim.x - 8, (int)blockIdx.x - 8);
        pg8::gemm_phase(lds3, g2, S2, E2);
      }
    }
    PHASE_GATE(pb + 3) phase4(p, layer, RB, RA); }
#if PROBE_DUP == 5
    if (layer == 0) { xcd_barrier(xb); phase4(p, layer, RB, RA); xcd_barrier(xb); phase4(p, layer, RB, RA); }
#endif
    PHASE_GATE(pb + 4)
      pg8::StaticOrder S; S.init(MT, 1024, (int)gridDim.x, (int)blockIdx.x);
      pg8::Gemm g; g.A = RA; g.Bt = (const u16*)(ws + OFF_WGATE) + (size_t)layer * 1024 * 1024; g.M = MT; g.N = 1024; g.K = 1024;
      EpiP5 E; E.out = p.out; E.PLE = (const u16*)(ws + OFF_QA); E.H1B = RA; E.HBN = RB; E.psum = (float*)(ws + OFF_PSUM); E.layer = layer;
      pg8::gemm_phase(lds3, g, S, E);
    }
  }
}

extern "C" void kernel_launch(void* const* d_in, const int* in_sizes, int n_in, void* d_out, int out_size,
                              void* d_ws, size_t ws_size, hipStream_t stream) {
  Params p{};
  p.xp = (const float*)d_in[0]; p.xs = (const float*)d_in[1]; p.pp = (const float*)d_in[2]; p.ps = (const float*)d_in[3];
  p.cak = (const float*)d_in[4]; p.cav = (const float*)d_in[5]; p.cbk = (const float*)d_in[6]; p.cbv = (const float*)d_in[7];
  p.gpre = (const float*)d_in[8]; p.win = (const float*)d_in[9]; p.relb = (const float*)d_in[10]; p.wout = (const float*)d_in[11];
  p.gpost = (const float*)d_in[12]; p.wple = (const float*)d_in[13]; p.wgate = (const float*)d_in[14];
  p.out = (float*)d_out;
  p.ws = (unsigned char*)d_ws;
  static int grid_blocks = 0;
  if (!grid_blocks) {
    int dev = 0, cus = 0, per_cu = 0;
    (void)hipGetDevice(&dev);
    (void)hipDeviceGetAttribute(&cus, hipDeviceAttributeMultiprocessorCount, dev);
    if (hipFuncSetAttribute((const void*)mega, hipFuncAttributeMaxDynamicSharedMemorySize, SMEM_BYTES) != hipSuccess)
      fprintf(stderr, "hipFuncSetAttribute(MaxDynamicSharedMemorySize=%d) failed\n", SMEM_BYTES);
    (void)hipOccupancyMaxActiveBlocksPerMultiprocessor(&per_cu, mega, NTHR, SMEM_BYTES);
    if (per_cu < 1) per_cu = 1;
    if (per_cu > 1) per_cu = 1;
    grid_blocks = 256;
    if (cus * per_cu < 256) fprintf(stderr, "device too small for a 256-workgroup cooperative grid\n");
  }
#if MK_COOP
  hipMemsetAsync((unsigned char*)d_ws + OFF_BAR, 0, (size_t)XCD_BAR_WORDS * 4, stream);
  int pb = 0, pe = 11;
  void* args[] = {&p, &pb, &pe};
  hipError_t e = hipLaunchCooperativeKernel((void*)mega, dim3(grid_blocks), dim3(NTHR), args, SMEM_BYTES, stream);
  if (e != hipSuccess) fprintf(stderr, "cooperative launch failed: %s (grid %d)\n", hipGetErrorString(e), grid_blocks);
#else
  for (int ph = 0; ph < 11; ++ph) mega<<<dim3(grid_blocks), dim3(NTHR), SMEM_BYTES, stream>>>(p, ph, ph + 1);
#endif
}
```
